# Optimizing an MI355X kernel written in HIP

```python
import math
import jax, jax.numpy as jnp
from jax import lax
import numpy as np

D_MODEL = 1024
BATCH = 8
SEQ = 4096
DEPTH = 4

GRID_W = 64
CTX_LEN = 256
N_MIXERS = 3
N_LAYERS_A = (DEPTH + 2) // 3
N_LAYERS_B = (DEPTH + 1) // 3
N_LAYERS_C = DEPTH // 3
Q_BLOCK = 128
ROPE_BASE = 10000.0
EPS = 1e-6

MLA_HEADS = 16
MLA_Q_LORA = 512
MLA_KV_LORA = 256
MLA_NOPE = 64
MLA_ROPE = 32
MLA_V = 64
MLA_QK = MLA_NOPE + MLA_ROPE
MLA_DOWN = MLA_Q_LORA + MLA_KV_LORA + MLA_ROPE

DIFF_HEADS = 8
DIFF_HEAD_DIM = 64
DIFF_V_DIM = 2 * DIFF_HEAD_DIM

SG_CHUNK = 128
SG_WIDTH = 2 * D_MODEL
SG_GROUPS = 8
SG_GROUP_DIM = SG_WIDTH // SG_GROUPS

N_EXPERTS = 16
EXPERT_FF = D_MODEL
CAPACITY_FACTOR = 2

kernel_name = "hybrid_mla_diff_chunkmlp_ec_moe_dit"


def rms_norm(x, g):
    xf = x.astype(jnp.float32)
    y = xf * lax.rsqrt(jnp.mean(xf * xf, axis=-1, keepdims=True) + EPS)
    return (y * g).astype(x.dtype)


def layer_norm(x, g, b):
    xf = x.astype(jnp.float32)
    mu = jnp.mean(xf, axis=-1, keepdims=True)
    var = jnp.mean(jnp.square(xf - mu), axis=-1, keepdims=True)
    return ((xf - mu) * lax.rsqrt(var + EPS) * g + b).astype(x.dtype)


def modulate(h, shift, scale):
    return h * (1 + scale) + shift


def axial_rope(n_tokens, rot_dim):
    n_rows = n_tokens // GRID_W
    rows = jnp.repeat(jnp.arange(n_rows, dtype=jnp.float32), GRID_W)
    cols = jnp.tile(jnp.arange(GRID_W, dtype=jnp.float32), n_rows)
    n_freq = rot_dim // 4
    inv_freq = ROPE_BASE ** (-jnp.arange(n_freq, dtype=jnp.float32) / n_freq)
    ang = jnp.concatenate([rows[:, None] * inv_freq, cols[:, None] * inv_freq], axis=-1)
    return jnp.cos(ang), jnp.sin(ang)


def apply_rope(x, cos, sin):
    half = x.shape[-1] // 2
    x1, x2 = x[..., :half], x[..., half:]
    return jnp.concatenate([x1 * cos - x2 * sin, x1 * sin + x2 * cos], axis=-1)


def merge_heads(o):
    b, h, n, d = o.shape
    return o.transpose(0, 2, 1, 3).reshape(b, n, h * d)


def block_softmax_attention(q, k, v):
    b, h, n, dk = q.shape
    nb = n // Q_BLOCK
    scale = dk ** -0.5
    qb = jnp.moveaxis(q.reshape(b, h, nb, Q_BLOCK, dk), 2, 0)

    def one(qi):
        p = jax.nn.softmax(jnp.einsum('bhqd,bhkd->bhqk', qi, k) * scale, axis=-1)
        return jnp.einsum('bhqk,bhkd->bhqd', p.astype(v.dtype), v)

    out = lax.map(one, qb)
    return jnp.moveaxis(out, 0, 2).reshape(b, h, n, -1)


def block_diff_attention(q, k, v, lam):
    b, h, _, n, dk = q.shape
    nb = n // Q_BLOCK
    scale = dk ** -0.5
    qb = jnp.moveaxis(q.reshape(b, h, 2, nb, Q_BLOCK, dk), 3, 0)

    def one(qi):
        p = jax.nn.softmax(jnp.einsum('bhcqd,bhckd->bhcqk', qi, k) * scale, axis=-1)
        a = p[:, :, 0] - lam * p[:, :, 1]
        return jnp.einsum('bhqk,bhkd->bhqd', a.astype(v.dtype), v)

    out = lax.map(one, qb)
    return jnp.moveaxis(out, 0, 2).reshape(b, h, n, -1)


def mla_project_q(down, q_norm_g, w_uq, qn_g):
    b, n, _ = down.shape
    cq = rms_norm(down[..., :MLA_Q_LORA], q_norm_g)
    q = (cq @ w_uq).reshape(b, n, MLA_HEADS, MLA_QK)
    return rms_norm(q, qn_g).astype(jnp.float32).transpose(0, 2, 1, 3)


def mla_project_kv(down, kv_norm_g, w_ukv, kn_g):
    b, n, _ = down.shape
    ckv = rms_norm(down[..., MLA_Q_LORA:MLA_Q_LORA + MLA_KV_LORA], kv_norm_g)
    k_rope = down[..., MLA_Q_LORA + MLA_KV_LORA:]
    kv = (ckv @ w_ukv).reshape(b, n, MLA_HEADS, MLA_NOPE + MLA_V)
    k_nope, v = kv[..., :MLA_NOPE], kv[..., MLA_NOPE:]
    k = jnp.concatenate([k_nope, jnp.broadcast_to(k_rope[:, :, None, :], (b, n, MLA_HEADS, MLA_ROPE))], axis=-1)
    k = rms_norm(k, kn_g).astype(jnp.float32)
    return k.transpose(0, 2, 1, 3), v.transpose(0, 2, 1, 3)


def rope_tail(t, cos, sin):
    return jnp.concatenate([t[..., :MLA_NOPE], apply_rope(t[..., MLA_NOPE:], cos, sin)], axis=-1)


def mla_mixer(h_lat, h_ctx, w_in, q_norm_g, w_uq, kv_norm_g, w_ukv, qn_g, kn_g, w_out, cos, sin, need_ctx_out):
    d_lat = h_lat @ w_in
    d_ctx = h_ctx @ w_in
    q_lat = rope_tail(mla_project_q(d_lat, q_norm_g, w_uq, qn_g), cos, sin)
    k_lat, v_lat = mla_project_kv(d_lat, kv_norm_g, w_ukv, kn_g)
    k_lat = rope_tail(k_lat, cos, sin)
    k_ctx, v_ctx = mla_project_kv(d_ctx, kv_norm_g, w_ukv, kn_g)
    k_all = jnp.concatenate([k_ctx, k_lat], axis=2)
    v_all = jnp.concatenate([v_ctx, v_lat], axis=2)
    y_lat = merge_heads(block_softmax_attention(q_lat, k_all, v_all)) @ w_out
    y_ctx = None
    if need_ctx_out:
        q_ctx = mla_project_q(d_ctx, q_norm_g, w_uq, qn_g)
        y_ctx = merge_heads(block_softmax_attention(q_ctx, k_ctx, v_ctx)) @ w_out
    return y_lat, y_ctx


def diff_heads_qk(t, g):
    b, n, _ = t.shape
    t = rms_norm(t.reshape(b, n, DIFF_HEADS, 2, DIFF_HEAD_DIM), g)
    return t.astype(jnp.float32).transpose(0, 2, 3, 1, 4)


def diff_heads_v(t):
    b, n, _ = t.shape
    return t.reshape(b, n, DIFF_HEADS, DIFF_V_DIM).transpose(0, 2, 1, 3)


def diff_mixer(h_lat, h_ctx, w_in, qn_g, kn_g, lq1, lk1, lq2, lk2, sub_g, w_out, lam_init, cos, sin, need_ctx_out):
    D = D_MODEL
    qkv_lat = h_lat @ w_in
    q_lat = apply_rope(diff_heads_qk(qkv_lat[..., :D], qn_g), cos, sin)
    k_lat = apply_rope(diff_heads_qk(qkv_lat[..., D:2 * D], kn_g), cos, sin)
    v_lat = diff_heads_v(qkv_lat[..., 2 * D:])
    if need_ctx_out:
        qkv_ctx = h_ctx @ w_in
        kv_ctx = qkv_ctx[..., D:]
    else:
        kv_ctx = h_ctx @ w_in[:, D:]
    k_ctx = diff_heads_qk(kv_ctx[..., :D], kn_g)
    v_ctx = diff_heads_v(kv_ctx[..., D:])
    lam = (jnp.exp(jnp.sum(lq1.astype(jnp.float32) * lk1.astype(jnp.float32)))
           - jnp.exp(jnp.sum(lq2.astype(jnp.float32) * lk2.astype(jnp.float32))) + lam_init)

    def finish(o):
        return merge_heads(rms_norm(o, sub_g) * (1.0 - lam_init)) @ w_out

    k_all = jnp.concatenate([k_ctx, k_lat], axis=3)
    v_all = jnp.concatenate([v_ctx, v_lat], axis=2)
    y_lat = finish(block_diff_attention(q_lat, k_all, v_all, lam))
    y_ctx = None
    if need_ctx_out:
        q_ctx = diff_heads_qk(qkv_ctx[..., :D], qn_g)
        y_ctx = finish(block_diff_attention(q_ctx, k_ctx, v_ctx, lam))
    return y_lat, y_ctx


def chunk_gate(h, w_in, ln_g, ln_b, w_s, b_s, w_out):
    b, n, _ = h.shape
    z = jax.nn.gelu(h @ w_in)
    u, v = z[..., :SG_WIDTH], z[..., SG_WIDTH:]
    v = layer_norm(v, ln_g, ln_b).reshape(b, n // SG_CHUNK, SG_CHUNK, SG_GROUPS, SG_GROUP_DIM)
    v = jnp.einsum('gpq,bnqgc->bnpgc', w_s, v) + b_s.T[None, None, :, :, None]
    return (u * v.reshape(b, n, SG_WIDTH)) @ w_out


def chunk_mixer(h_lat, h_ctx, w_in, ln_g, ln_b, w_s, b_s, w_out, need_ctx_out):
    y_lat = chunk_gate(h_lat, w_in, ln_g, ln_b, w_s, b_s, w_out)
    y_ctx = chunk_gate(h_ctx, w_in, ln_g, ln_b, w_s, b_s, w_out) if need_ctx_out else None
    return y_lat, y_ctx


def ec_moe(h, router, w_gate, w_up, w_down):
    b, n, d = h.shape
    cap = CAPACITY_FACTOR * n // N_EXPERTS
    aff = jax.nn.softmax(jnp.einsum('bnd,de->bne', h, router).astype(jnp.float32), axis=-1)
    gates, idx = lax.top_k(aff.transpose(0, 2, 1), cap)
    xg = jax.vmap(lambda hb, ib: hb[ib])(h, idx)
    hid = jax.nn.silu(jnp.einsum('becd,edf->becf', xg, w_gate)) * jnp.einsum('becd,edf->becf', xg, w_up)
    y = jnp.einsum('becf,efd->becd', hid, w_down) * gates.astype(h.dtype)[..., None]
    return jax.vmap(lambda yb, ib: jnp.zeros((n, d), yb.dtype).at[ib.reshape(-1)].add(yb.reshape(-1, d)))(y, idx)


def setup_inputs(seed: int = 0) -> dict:
    key = jax.random.key(seed)
    ks = iter(jax.random.split(key, 64))
    D = D_MODEL

    def nrm(shape, scale=1.0):
        return jax.random.normal(next(ks), shape, jnp.float32) * scale

    def gain(shape):
        return 1.0 + nrm(shape, 0.05)

    return {
        "x": nrm((BATCH, SEQ, D)),
        "c": nrm((BATCH, D)),
        "ctx": nrm((BATCH, CTX_LEN, D)),
        "c_ctx": nrm((D,)),
        "ada_w": nrm((DEPTH, D, 6 * D), 0.5 * D ** -0.5),
        "ada_b": nrm((DEPTH, 6 * D), 0.02),
        "norm_mix_g": gain((DEPTH, D)),
        "norm_ffn_g": gain((DEPTH, D)),
        "mla_w_in": nrm((N_LAYERS_A, D, MLA_DOWN), D ** -0.5),
        "mla_q_norm_g": gain((N_LAYERS_A, MLA_Q_LORA)),
        "mla_w_uq": nrm((N_LAYERS_A, MLA_Q_LORA, MLA_HEADS * MLA_QK), MLA_Q_LORA ** -0.5),
        "mla_kv_norm_g": gain((N_LAYERS_A, MLA_KV_LORA)),
        "mla_w_ukv": nrm((N_LAYERS_A, MLA_KV_LORA, MLA_HEADS * (MLA_NOPE + MLA_V)), MLA_KV_LORA ** -0.5),
        "mla_qn_g": gain((N_LAYERS_A, MLA_QK)),
        "mla_kn_g": gain((N_LAYERS_A, MLA_QK)),
        "mla_w_out": nrm((N_LAYERS_A, MLA_HEADS * MLA_V, D), (MLA_HEADS * MLA_V) ** -0.5),
        "diff_w_in": nrm((N_LAYERS_B, D, 3 * D), D ** -0.5),
        "diff_qn_g": gain((N_LAYERS_B, DIFF_HEAD_DIM)),
        "diff_kn_g": gain((N_LAYERS_B, DIFF_HEAD_DIM)),
        "diff_lambda_q1": nrm((N_LAYERS_B, DIFF_HEAD_DIM), 0.1),
        "diff_lambda_k1": nrm((N_LAYERS_B, DIFF_HEAD_DIM), 0.1),
        "diff_lambda_q2": nrm((N_LAYERS_B, DIFF_HEAD_DIM), 0.1),
        "diff_lambda_k2": nrm((N_LAYERS_B, DIFF_HEAD_DIM), 0.1),
        "diff_sub_g": gain((N_LAYERS_B, DIFF_V_DIM)),
        "diff_w_out": nrm((N_LAYERS_B, D, D), D ** -0.5),
        "sg_w_in": nrm((N_LAYERS_C, D, 2 * SG_WIDTH), D ** -0.5),
        "sg_ln_g": gain((N_LAYERS_C, SG_WIDTH)),
        "sg_ln_b": nrm((N_LAYERS_C, SG_WIDTH), 0.02),
        "sg_w_s": nrm((N_LAYERS_C, SG_GROUPS, SG_CHUNK, SG_CHUNK), SG_CHUNK ** -0.5),
        "sg_b_s": 1.0 + nrm((N_LAYERS_C, SG_GROUPS, SG_CHUNK), 0.05),
        "sg_w_out": nrm((N_LAYERS_C, SG_WIDTH, D), SG_WIDTH ** -0.5),
        "moe_router": nrm((DEPTH, D, N_EXPERTS), D ** -0.5),
        "moe_w_gate": nrm((DEPTH, N_EXPERTS, D, EXPERT_FF), D ** -0.5),
        "moe_w_up": nrm((DEPTH, N_EXPERTS, D, EXPERT_FF), D ** -0.5),
        "moe_w_down": nrm((DEPTH, N_EXPERTS, EXPERT_FF, D), EXPERT_FF ** -0.5),
    }


def reference(x, c, ctx, c_ctx, ada_w, ada_b, norm_mix_g, norm_ffn_g,
              mla_w_in, mla_q_norm_g, mla_w_uq, mla_kv_norm_g, mla_w_ukv, mla_qn_g, mla_kn_g, mla_w_out,
              diff_w_in, diff_qn_g, diff_kn_g, diff_lambda_q1, diff_lambda_k1, diff_lambda_q2, diff_lambda_k2,
              diff_sub_g, diff_w_out,
              sg_w_in, sg_ln_g, sg_ln_b, sg_w_s, sg_b_s, sg_w_out,
              moe_router, moe_w_gate, moe_w_up, moe_w_down):
    n_lat = x.shape[1]
    cos_a, sin_a = axial_rope(n_lat, MLA_ROPE)
    cos_b, sin_b = axial_rope(n_lat, DIFF_HEAD_DIM)
    x_lat, x_ctx = x, ctx
    silu_c = jax.nn.silu(c)
    silu_cc = jax.nn.silu(c_ctx)[None]
    for i in range(DEPTH):
        kind = i % N_MIXERS
        j = i // N_MIXERS
        last = i == DEPTH - 1
        need_ctx_out = not last
        need_ctx_in = not (last and kind == 2)
        sh1, sc1, g1, sh2, sc2, g2 = jnp.split((silu_c @ ada_w[i] + ada_b[i])[:, None, :], 6, axis=-1)
        h_lat = modulate(rms_norm(x_lat, norm_mix_g[i]), sh1, sc1)
        h_ctx = None
        if need_ctx_in:
            csh1, csc1, cg1, csh2, csc2, cg2 = jnp.split((silu_cc @ ada_w[i] + ada_b[i])[:, None, :], 6, axis=-1)
            h_ctx = modulate(rms_norm(x_ctx, norm_mix_g[i]), csh1, csc1)
        if kind == 0:
            y_lat, y_ctx = mla_mixer(h_lat, h_ctx, mla_w_in[j], mla_q_norm_g[j], mla_w_uq[j], mla_kv_norm_g[j],
                                     mla_w_ukv[j], mla_qn_g[j], mla_kn_g[j], mla_w_out[j], cos_a, sin_a, need_ctx_out)
        elif kind == 1:
            lam_init = 0.8 - 0.6 * math.exp(-0.3 * i)
            y_lat, y_ctx = diff_mixer(h_lat, h_ctx, diff_w_in[j], diff_qn_g[j], diff_kn_g[j],
                                      diff_lambda_q1[j], diff_lambda_k1[j], diff_lambda_q2[j], diff_lambda_k2[j],
                                      diff_sub_g[j], diff_w_out[j], lam_init, cos_b, sin_b, need_ctx_out)
        else:
            y_lat, y_ctx = chunk_mixer(h_lat, h_ctx, sg_w_in[j], sg_ln_g[j], sg_ln_b[j], sg_w_s[j], sg_b_s[j],
                                       sg_w_out[j], need_ctx_out)
        x_lat = x_lat + g1 * y_lat
        x_lat = x_lat + g2 * ec_moe(modulate(rms_norm(x_lat, norm_ffn_g[i]), sh2, sc2),
                                    moe_router[i], moe_w_gate[i], moe_w_up[i], moe_w_down[i])
        if need_ctx_out:
            x_ctx = x_ctx + cg1 * y_ctx
            x_ctx = x_ctx + cg2 * ec_moe(modulate(rms_norm(x_ctx, norm_ffn_g[i]), csh2, csc2),
                                        moe_router[i], moe_w_gate[i], moe_w_up[i], moe_w_down[i])
    return x_lat
```

```cpp
#include <hip/hip_runtime.h>
#include <cstdio>
#include <cstdint>

#ifndef MK_PER_PHASE
#define MK_PER_PHASE 0
#endif

constexpr int D = 1024, NB = 8, SEQ = 4096, CTXL = 256, NLAT = NB * SEQ, NCTX = NB * CTXL, MROWS = NLAT + NCTX;
constexpr int NKEYS = CTXL + SEQ;
constexpr int NE = 16, CAP_LAT = 512, CAP_CTX = 32, EROWS = NB * CAP_LAT + NB * CAP_CTX, MOE_ROWS = NE * EROWS;
constexpr int DEPTH = 4;
constexpr float EPS = 1e-6f;
constexpr int NWAVES = 8, NTHREADS = 512;

constexpr size_t MiB = 1u << 20;
constexpr size_t WS_CTL = 0, CTL_ZERO_BYTES = 1 * MiB;
constexpr size_t WS_MOD = 1 * MiB;
constexpr size_t WS_ROPEA = 2 * MiB;
constexpr size_t WS_ROPEB = 2 * MiB + 512 * 1024;
constexpr size_t WS_WNM = 4 * MiB;
constexpr size_t MLA_W_STRIDE = 7 * MiB, MLA_WIN = 0, MLA_WUQ = 2 * MiB, MLA_WUKV = 3 * MiB + 512 * 1024, MLA_WOUT = 4 * MiB + 512 * 1024;
constexpr size_t WS_DIFF_WIN = 18 * MiB, WS_DIFF_WOUT = 24 * MiB;
constexpr size_t WS_SG_WIN = 26 * MiB, WS_SG_WOUT = 34 * MiB, WS_SG_WS = 38 * MiB;
constexpr size_t WS_WGU = 40 * MiB, WS_WDN = 104 * MiB;
constexpr size_t WS_XCTX = 136 * MiB;
constexpr size_t WS_H = 144 * MiB;
constexpr size_t WS_AFF = 212 * MiB;
constexpr size_t WS_SLOT = 215 * MiB;
constexpr size_t WS_GATE = 218 * MiB;
constexpr size_t WS_RQ = 219 * MiB;
constexpr size_t WS_R = 220 * MiB;
constexpr size_t WS_XB = WS_R + 640 * MiB;
constexpr size_t WS_END = WS_XB + 68 * MiB;
constexpr size_t R_DOWN = WS_R, R_CQN = WS_R + 68 * MiB, R_CKVN = WS_R + 102 * MiB, R_QPRE = WS_R + 120 * MiB, R_KVPRE = WS_R + 222 * MiB;
constexpr size_t R_MQ = WS_R + 358 * MiB, R_MQC = WS_R + 454 * MiB, R_MK = WS_R + 460 * MiB, R_MV = WS_R + 562 * MiB, R_AO = WS_R;
constexpr size_t R_QKV = WS_R, R_DQ = WS_R + 204 * MiB, R_DQC = WS_R + 268 * MiB, R_DK = WS_R + 272 * MiB, R_OB = WS_R + 340 * MiB, R_DAO = WS_R + 476 * MiB;
constexpr size_t R_Z = WS_R, R_VNT = WS_R + 272 * MiB, R_UV = WS_R + 408 * MiB;
constexpr size_t R_XG = WS_R, R_HID = WS_R + 136 * MiB, R_YB = WS_R + 272 * MiB;

constexpr int RING_BYTES = 131072;
constexpr int LDS_BYTES = 147456;
constexpr int MISC_OFF = LDS_BYTES - 512;

#define GAS __attribute__((address_space(1)))
#define LAS __attribute__((address_space(3)))
typedef unsigned short bf16;
typedef unsigned v4u __attribute__((ext_vector_type(4)));
typedef unsigned v2u __attribute__((ext_vector_type(2)));
typedef float f32x4 __attribute__((ext_vector_type(4)));
typedef float f32x2 __attribute__((ext_vector_type(2)));
typedef GAS unsigned gu32;
#define RLX_AGENT __ATOMIC_RELAXED, __HIP_MEMORY_SCOPE_AGENT
#define LDS_WAIT() asm volatile("s_waitcnt lgkmcnt(0)" ::: "memory")
#define VM_WAIT() asm volatile("s_waitcnt vmcnt(0)" ::: "memory")
__device__ __forceinline__ unsigned f2bf(float f) { unsigned u = __builtin_bit_cast(unsigned, f); return (u + 0x7fffu + ((u >> 16) & 1u)) >> 16; }
__device__ __forceinline__ unsigned pk2(float lo, float hi) { return f2bf(lo) | (f2bf(hi) << 16); }
__device__ __forceinline__ float bflo(unsigned w) { return __builtin_bit_cast(float, w << 16); }
__device__ __forceinline__ float bfhi(unsigned w) { return __builtin_bit_cast(float, w & 0xffff0000u); }
template <int M> __device__ __forceinline__ float shx(float v) {
    static_assert(M == 1 || M == 2 || M == 4 || M == 8 || M == 16, "shx: xor mask inside a 32-lane group");
    return __builtin_bit_cast(float, __builtin_amdgcn_ds_swizzle(__builtin_bit_cast(int, v), (M << 10) | 0x1f));
}
__device__ __forceinline__ float wave_sum(float v) {
    v += shx<1>(v); v += shx<2>(v); v += shx<4>(v); v += shx<8>(v); v += shx<16>(v);
    const unsigned a = __builtin_bit_cast(unsigned, v);
    const auto rr = __builtin_amdgcn_permlane32_swap(a, a, false, false);
    const unsigned r0 = rr[0], r1 = rr[1];
    return __uint_as_float(r0) + __uint_as_float(r1);
}
__device__ __forceinline__ int hw_lane() { int l; asm volatile("v_mbcnt_lo_u32_b32 %0, -1, 0\n\tv_mbcnt_hi_u32_b32 %0, -1, %0" : "=v"(l)); return l; }
__device__ __forceinline__ float fast_rcp(float x) { return __builtin_amdgcn_rcpf(x); }
__device__ __forceinline__ float silu_f(float x) { return x * fast_rcp(1.0f + __builtin_amdgcn_exp2f(-1.4426950408889634f * x)); }
__device__ __forceinline__ float gelu_tanh_f(float x) { const float u2 = 1.5957691216057308f * (x + 0.044715f * x * x * x); return x * fast_rcp(1.0f + __builtin_amdgcn_exp2f(-1.4426950408889634f * u2)); }

namespace pg8 {
#define PG8_LAS __attribute__((address_space(3)))
typedef unsigned short bf16_t;
typedef short bf16x8 __attribute__((ext_vector_type(8)));
typedef float f32x4 __attribute__((ext_vector_type(4)));
typedef unsigned u32x4 __attribute__((ext_vector_type(4)));
constexpr int BM = 256, BK = 64, HALF = 128, HTB = HALF * BK * 2  , STAGE_BYTES = 8 * HTB, NXCD = 8, WGM = 8;

__host__ __device__ __forceinline__ int lds_byte(int r, int c) { const int st = (r >> 4) * 2 + (c >> 5), rr = r & 15, cc = c & 31, ob = rr * 64 + cc * 2; return st * 1024 + (ob ^ (((ob >> 9) & 1) << 5)); }
__host__ __device__ __forceinline__ void stage_rc(int b, int& R, int& C) { const int st = b / 1024, sb = b % 1024, swz = sb ^ (((sb >> 9) & 1) << 5); R = (st >> 1) * 16 + swz / 64; C = (st & 1) * 32 + (swz % 64) / 2; }
__host__ __device__ __forceinline__ int perm32(int rho) { const int n = rho >> 4, i = rho & 15; return 8 * (i >> 2) + 4 * n + (i & 3); }

struct Unit { int pm, pn; };
struct Gemm { const bf16_t* A; const bf16_t* Bt; int M, N, K; int lda = 0; };

struct StaticOrder {
    int nM, nN, nwg, G, c;
    __host__ __device__ void init(int M, int N, int G_, int c_) { nM = M / BM; nN = N / BM; nwg = nM * nN; G = G_; c = c_; }
    __host__ __device__ bool next(int i, Unit& u) const {
        const long L = (long)i * G + c; if (L >= nwg) return false;
        int wgid = (int)L; { const int q = nwg / NXCD, r = nwg % NXCD, xcd = wgid % NXCD, off = wgid / NXCD; wgid = (xcd < r ? xcd * (q + 1) : r * (q + 1) + (xcd - r) * q) + off; }
        const int nig = WGM * nN, gid = wgid / nig, fm = gid * WGM, gsz = (nM - fm) < WGM ? (nM - fm) : WGM;
        u.pm = fm + ((wgid % nig) % gsz); u.pn = (wgid % nig) / gsz; return true;
    }
    __device__ __forceinline__ void a_ready(const Unit&) const {}
    __device__ __forceinline__ void done(const Unit&) const {}
};

__device__ __forceinline__ unsigned cvt_pk_bf16(float lo, float hi) { unsigned r; asm volatile("v_cvt_pk_bf16_f32 %0, %1, %2" : "=v"(r) : "v"(lo), "v"(hi)); return r; }
typedef float f32x2 __attribute__((ext_vector_type(2)));

template <int ACT> struct EpiStore {
    static constexpr bool PERM = true, AFTER_DRAIN = false;
    bf16_t* O; int ldc;
    __device__ __forceinline__ void operator()(const f32x4 (&acc)[2][2][4][2], const Unit& u, int wr, int wc, int fr, int fq) const {
        const int row0 = u.pm * BM + wr * 64 + fr, col0 = u.pn * BM + wc * 32 + 8 * fq;
#pragma unroll
        for (int ai = 0; ai < 2; ++ai)
#pragma unroll
            for (int m = 0; m < 4; ++m) { bf16_t* rowp = O + (size_t)(row0 + ai * HALF + m * 16) * ldc + col0;
#pragma unroll
                for (int bj = 0; bj < 2; ++bj) { f32x4 v0 = acc[ai][bj][m][0], v1 = acc[ai][bj][m][1];
                    if (ACT == 1) {
#pragma unroll
                        for (int i = 0; i < 4; ++i) { v0[i] = gelu_tanh_f(v0[i]); v1[i] = gelu_tanh_f(v1[i]); } }
                    u32x4 w; w.x = cvt_pk_bf16(v0[0], v0[1]); w.y = cvt_pk_bf16(v0[2], v0[3]); w.z = cvt_pk_bf16(v1[0], v1[1]); w.w = cvt_pk_bf16(v1[2], v1[3]);
                    *(u32x4*)(rowp + bj * HALF) = w; } }
    }
};
struct EpiResid {
    static constexpr bool PERM = true, AFTER_DRAIN = false;
    bf16_t* xb; const float* gmod; float mul;
    __device__ __forceinline__ void operator()(const f32x4 (&acc)[2][2][4][2], const Unit& u, int wr, int wc, int fr, int fq) const {
        const int rr = u.pm < 128 ? (u.pm >> 4) : 8;
        bf16_t* xbase = xb + (size_t)u.pm * BM * 1024;
        const int col0 = u.pn * BM + wc * 32 + 8 * fq;
        f32x4 gv[2][2];
#pragma unroll
        for (int bj = 0; bj < 2; ++bj)
#pragma unroll
            for (int n = 0; n < 2; ++n) gv[bj][n] = *(const f32x4*)(gmod + rr * 6144 + col0 + bj * HALF + 4 * n) * mul;
#pragma unroll
        for (int ai = 0; ai < 2; ++ai)
#pragma unroll
            for (int m = 0; m < 4; ++m) { bf16_t* rowp = xbase + (size_t)(ai * HALF + wr * 64 + m * 16 + fr) * 1024 + col0;
#pragma unroll
                for (int bj = 0; bj < 2; ++bj) { u32x4* p = (u32x4*)(rowp + bj * HALF); const u32x4 w = *p;
                    const f32x4 x0 = (f32x4){__builtin_bit_cast(float, w.x << 16), __builtin_bit_cast(float, w.x & 0xffff0000u), __builtin_bit_cast(float, w.y << 16), __builtin_bit_cast(float, w.y & 0xffff0000u)};
                    const f32x4 x1 = (f32x4){__builtin_bit_cast(float, w.z << 16), __builtin_bit_cast(float, w.z & 0xffff0000u), __builtin_bit_cast(float, w.w << 16), __builtin_bit_cast(float, w.w & 0xffff0000u)};
                    const f32x4 o0 = x0 + gv[bj][0] * acc[ai][bj][m][0], o1 = x1 + gv[bj][1] * acc[ai][bj][m][1];
                    u32x4 r; r.x = cvt_pk_bf16(o0[0], o0[1]); r.y = cvt_pk_bf16(o0[2], o0[3]); r.z = cvt_pk_bf16(o1[0], o1[1]); r.w = cvt_pk_bf16(o1[2], o1[3]); *p = r; } }
    }
};
struct EpiSwiGLU {
    static constexpr bool PERM = true, AFTER_DRAIN = false;
    bf16_t* O; int nct;
    __device__ __forceinline__ void operator()(const f32x4 (&acc)[2][2][4][2], const Unit& u, int wr, int wc, int fr, int fq) const {
        const int row0 = u.pm * BM + wr * 64 + fr, col0 = (u.pn % nct) * HALF + wc * 32 + 8 * fq;
#pragma unroll
        for (int ai = 0; ai < 2; ++ai)
#pragma unroll
            for (int m = 0; m < 4; ++m) { bf16_t* rowp = O + (size_t)(row0 + ai * HALF + m * 16) * 1024 + col0;
                f32x4 v0, v1;
#pragma unroll
                for (int i = 0; i < 4; ++i) { v0[i] = silu_f(acc[ai][0][m][0][i]) * acc[ai][1][m][0][i]; v1[i] = silu_f(acc[ai][0][m][1][i]) * acc[ai][1][m][1][i]; }
                u32x4 w; w.x = cvt_pk_bf16(v0[0], v0[1]); w.y = cvt_pk_bf16(v0[2], v0[3]); w.z = cvt_pk_bf16(v1[0], v1[1]); w.w = cvt_pk_bf16(v1[2], v1[3]);
                *(u32x4*)rowp = w; }
    }
};
struct EpiMoeDown {
    static constexpr bool PERM = true, AFTER_DRAIN = false;
    bf16_t* O; const float* gate;
    __device__ __forceinline__ void operator()(const f32x4 (&acc)[2][2][4][2], const Unit& u, int wr, int wc, int fr, int fq) const {
        const int row0 = u.pm * BM + wr * 64 + fr, col0 = (u.pn & 3) * BM + wc * 32 + 8 * fq;
#pragma unroll
        for (int ai = 0; ai < 2; ++ai)
#pragma unroll
            for (int m = 0; m < 4; ++m) { const int row = row0 + ai * HALF + m * 16; const float gt = gate[row]; bf16_t* rowp = O + (size_t)row * 1024 + col0;
#pragma unroll
                for (int bj = 0; bj < 2; ++bj) { const f32x4 v0 = acc[ai][bj][m][0] * gt, v1 = acc[ai][bj][m][1] * gt;
                    u32x4 w; w.x = cvt_pk_bf16(v0[0], v0[1]); w.y = cvt_pk_bf16(v0[2], v0[3]); w.z = cvt_pk_bf16(v1[0], v1[1]); w.w = cvt_pk_bf16(v1[2], v1[3]);
                    *(u32x4*)(rowp + bj * HALF) = w; } }
    }
};
struct EpiSpatial {
    static constexpr bool PERM = true, AFTER_DRAIN = false;
    bf16_t* UV; const bf16_t* Z; const float* bs;
    __device__ __forceinline__ void operator()(const f32x4 (&acc)[2][2][4][2], const Unit& u, int wr, int wc, int fr, int fq) const {
        const int g = u.pm, chunk = u.pn >> 3;
#pragma unroll
        for (int m = 0; m < 4; ++m) { const int p = wr * 64 + m * 16 + fr; const float b = bs[g * 128 + p]; const size_t tok = (size_t)chunk * 128 + p;
#pragma unroll
            for (int bj = 0; bj < 2; ++bj) { const int ch = g * 256 + bj * HALF + wc * 32 + 8 * fq;
                const u32x4 uw = *(const u32x4*)(Z + tok * 4096 + ch);
                const f32x4 a0 = acc[0][bj][m][0] + b, a1 = acc[0][bj][m][1] + b;
                u32x4 w;
                w.x = cvt_pk_bf16(a0[0] * __builtin_bit_cast(float, uw.x << 16), a0[1] * __builtin_bit_cast(float, uw.x & 0xffff0000u));
                w.y = cvt_pk_bf16(a0[2] * __builtin_bit_cast(float, uw.y << 16), a0[3] * __builtin_bit_cast(float, uw.y & 0xffff0000u));
                w.z = cvt_pk_bf16(a1[0] * __builtin_bit_cast(float, uw.z << 16), a1[1] * __builtin_bit_cast(float, uw.z & 0xffff0000u));
                w.w = cvt_pk_bf16(a1[2] * __builtin_bit_cast(float, uw.w << 16), a1[3] * __builtin_bit_cast(float, uw.w & 0xffff0000u));
                *(u32x4*)(UV + tok * 2048 + ch) = w; } }
    }
};
struct MoeOrder {
    int nrt, nct, nwg, G, c;
    __device__ void init(int nrt_, int nct_, int G_, int c_) { nrt = nrt_; nct = nct_; nwg = 16 * nrt * nct; G = G_; c = c_; }
    __device__ bool next(int i, Unit& u) const {
        const int L = i * G + c; if (L >= nwg) return false;
        const int per = nrt * nct, e = L / per, r = L % per, j = r / nrt, rt = r % nrt;
        u.pm = e * 17 + rt; u.pn = e * nct + j; return true;
    }
    __device__ __forceinline__ void a_ready(const Unit&) const {}
    __device__ __forceinline__ void done(const Unit&) const {}
};
struct SpatialOrder {
    int nwg, G, c;
    __device__ void init(int nblocks, int G_, int c_) { nwg = nblocks; G = G_; c = c_; }
    __device__ bool next(int i, Unit& u) const { const int L = i * G + c; if (L >= nwg) return false; u.pm = L & 7; u.pn = L; return true; }
    __device__ __forceinline__ void a_ready(const Unit&) const {}
    __device__ __forceinline__ void done(const Unit&) const {}
};
template <class Epi, class Sched, bool ALIGN_EPI = false, bool SP2 = false, bool GATHER = false>
__device__ __forceinline__ void gemm_phase(PG8_LAS unsigned char* lds, const Gemm g, const Sched& S, const Epi& E, int tid_in, const int* rowsrc = nullptr, PG8_LAS int* idx_lds = nullptr) {
    int tid_ = tid_in; asm volatile("" : "+v"(tid_));
    const int tid = tid_, wid = __builtin_amdgcn_readfirstlane(tid >> 6), lane = tid & 63, wr = wid >> 2, wc = wid & 3, fr = lane & 15, fq = lane >> 4;
    const int K = g.K, nt = K / BK, LDA = g.lda ? g.lda : g.K;
    unsigned voffA[2], voffB[2];
#pragma unroll
    for (int i = 0; i < 2; ++i) { int R, C; stage_rc(tid * 16 + i * 8192, R, C); const int Rb = Epi::PERM ? ((R & ~31) + perm32(R & 31)) : R;
        voffA[i] = (unsigned)(R * LDA + C) * 2u; voffB[i] = (unsigned)(Rb * K + C) * 2u; }
    const size_t kstep = (size_t)(BK * 2);
    const size_t hstep = (size_t)HALF * K * 2;
    const size_t tstep = 2 * hstep;
    const size_t hstepA = GATHER ? 0 : (size_t)HALF * LDA * 2, tstepA = 2 * hstepA;
    unsigned gA[2][2], gN[2][2], gS[2][2];
    int gR[2], gC[2];
    if constexpr (GATHER) {
#pragma unroll
        for (int i = 0; i < 2; ++i) { int R, C; stage_rc(tid * 16 + i * 8192, R, C); gR[i] = R; gC[i] = C * 2; }
        Unit u_; for (int i = 0; S.next(i, u_); ++i) if (tid < 256) idx_lds[i * 256 + tid] = rowsrc[u_.pm * BM + tid];
        asm volatile("s_waitcnt vmcnt(0) lgkmcnt(0)" ::: "memory"); __builtin_amdgcn_s_barrier(); asm volatile("" ::: "memory");
    }
#define PG8_GOFF(dst, unit_i) do { _Pragma("unroll") for (int h_ = 0; h_ < 2; ++h_) _Pragma("unroll") for (int i_ = 0; i_ < 2; ++i_) \
        dst[h_][i_] = (unsigned)idx_lds[(unit_i) * 256 + h_ * HALF + gR[i_]] * (unsigned)(LDA * 2) + (unsigned)gC[i_]; } while (0)
#define PG8_OA(h) (GATHER ? gA[h] : voffA)
#define PG8_OS(h) (GATHER ? gS[h] : voffA)
    const unsigned ldsw = (unsigned)wid * 1024u;
    const int aoff = lds_byte(wr * 64 + fr, fq * 8), boff = lds_byte(wc * 32 + fr, fq * 8);
#define PG8_SA(b, h) (((b) * 2 + (h)) * HTB)
#define PG8_SB(b, h) ((4 + (b) * 2 + (h)) * HTB)
#define PG8_STAGE(bufoff, gbase, voff) do { _Pragma("unroll") for (int _i = 0; _i < 2; ++_i) \
        __builtin_amdgcn_global_load_lds((const unsigned*)((const char*)(gbase) + (voff)[_i]), (PG8_LAS unsigned*)(lds + (bufoff) + ldsw + _i * 8192), 16, 0, 0); } while (0)
#define PG8_LDA(dst, b, h) do { _Pragma("unroll") for (int m = 0; m < 4; ++m) _Pragma("unroll") for (int k = 0; k < 2; ++k) dst[m][k] = *(const PG8_LAS bf16x8*)(lds + PG8_SA(b, h) + aoff + m * 2048 + k * 1024); } while (0)
#define PG8_LDB(dst, b, h) do { _Pragma("unroll") for (int n = 0; n < 2; ++n) _Pragma("unroll") for (int k = 0; k < 2; ++k) dst[n][k] = *(const PG8_LAS bf16x8*)(lds + PG8_SB(b, h) + boff + n * 2048 + k * 1024); } while (0)
#define PG8_MMA(ai, bj, At, Bt) do { __builtin_amdgcn_s_setprio(1); _Pragma("unroll") for (int m = 0; m < 4; ++m) _Pragma("unroll") for (int n = 0; n < 2; ++n) _Pragma("unroll") for (int k = 0; k < 2; ++k) \
        acc[ai][bj][m][n] = __builtin_amdgcn_mfma_f32_16x16x32_bf16(Bt[n][k], At[m][k], acc[ai][bj][m][n], 0, 0, 0); __builtin_amdgcn_s_setprio(0); } while (0)
#define PG8_WAIT_V(n) asm volatile("s_waitcnt vmcnt(" #n ")" ::: "memory")
#define PG8_WAIT_L(n) asm volatile("s_waitcnt lgkmcnt(" #n ")" ::: "memory")
#define PG8_BAR __builtin_amdgcn_s_barrier()
#define PG8_SCHED __builtin_amdgcn_sched_barrier(0)
    Unit cur, nxt; int ui = 0;
    if (!S.next(0, cur)) return;
    if constexpr (GATHER) { PG8_GOFF(gA, 0); }
    f32x4 acc[2][2][4][2];
#pragma unroll
    for (int a = 0; a < 2; ++a)
#pragma unroll
        for (int b = 0; b < 2; ++b)
#pragma unroll
            for (int m = 0; m < 4; ++m)
#pragma unroll
                for (int n = 0; n < 2; ++n) acc[a][b][m][n] = (f32x4){0.f, 0.f, 0.f, 0.f};
    bf16x8 At[4][2], B0[2][2], B1[2][2];
    const char* cA = (const char*)g.A + (size_t)cur.pm * tstepA; const char* cB = (const char*)g.Bt + (size_t)cur.pn * tstep;
    S.a_ready(cur);
    if constexpr (SP2) {
        PG8_STAGE(PG8_SB(0, 0), cB, voffB); PG8_STAGE(PG8_SB(0, 1), cB + hstep, voffB); PG8_STAGE(PG8_SA(0, 0), cA, PG8_OA(0)); PG8_STAGE(PG8_SA(0, 1), cA + hstepA, PG8_OA(1));
        if (wr == 1) PG8_BAR;
        PG8_WAIT_V(2); PG8_BAR;
        PG8_STAGE(PG8_SB(1, 0), cB + kstep, voffB); PG8_STAGE(PG8_SA(1, 0), cA + kstep, PG8_OA(0)); PG8_STAGE(PG8_SB(1, 1), cB + hstep + kstep, voffB);
        PG8_WAIT_V(6); PG8_BAR;
    } else {
        PG8_STAGE(PG8_SB(0, 0), cB, voffB); PG8_STAGE(PG8_SA(0, 0), cA, PG8_OA(0)); PG8_STAGE(PG8_SB(0, 1), cB + hstep, voffB); PG8_STAGE(PG8_SA(0, 1), cA + hstepA, PG8_OA(1));
        if (wr == 1) PG8_BAR;
        PG8_WAIT_V(4); PG8_BAR;
        PG8_STAGE(PG8_SB(1, 0), cB + kstep, voffB); PG8_STAGE(PG8_SA(1, 0), cA + kstep, PG8_OA(0)); PG8_STAGE(PG8_SB(1, 1), cB + hstep + kstep, voffB);
        PG8_WAIT_V(6); PG8_BAR;
    }
    for (;;) {
        const bool has_next = S.next(ui + 1, nxt);
        if constexpr (GATHER) { if (has_next) { PG8_GOFF(gN, ui + 1); } else {
#pragma unroll
            for (int h_ = 0; h_ < 2; ++h_) { gN[h_][0] = gA[h_][0]; gN[h_][1] = gA[h_][1]; } } }
        const char* nA = has_next ? (const char*)g.A + (size_t)nxt.pm * tstepA : cA; const char* nB = has_next ? (const char*)g.Bt + (size_t)nxt.pn * tstep : cB;
        for (int t = 0; t < nt; t += 2) {
            const bool last = (t == nt - 2);
            if constexpr (GATHER) {
#pragma unroll
                for (int h_ = 0; h_ < 2; ++h_) { gS[h_][0] = last ? gN[h_][0] : gA[h_][0]; gS[h_][1] = last ? gN[h_][1] : gA[h_][1]; } }
            const char* a1 = cA + (size_t)(t + 1) * kstep;
            const char* a2 = last ? nA : cA + (size_t)(t + 2) * kstep; const char* b2 = last ? nB : cB + (size_t)(t + 2) * kstep;
            const char* a3 = a2 + kstep; const char* b3 = b2 + kstep;
            if (last && has_next) S.a_ready(nxt);
            if constexpr (SP2) {
            PG8_LDB(B0, 0, 0); PG8_LDB(B1, 0, 1); PG8_SCHED; PG8_LDA(At, 0, 0); PG8_STAGE(PG8_SA(1, 1), a1 + hstepA, PG8_OA(1));
            PG8_WAIT_V(8); PG8_WAIT_L(0); PG8_BAR; PG8_MMA(0, 0, At, B0); PG8_MMA(0, 1, At, B1); PG8_BAR; PG8_SCHED;
            PG8_LDA(At, 0, 1); PG8_STAGE(PG8_SB(0, 0), b2, voffB); PG8_STAGE(PG8_SB(0, 1), b2 + hstep, voffB); PG8_STAGE(PG8_SA(0, 0), a2, PG8_OS(0));
            PG8_WAIT_V(8); PG8_WAIT_L(0); PG8_BAR; PG8_MMA(1, 0, At, B0); PG8_MMA(1, 1, At, B1); PG8_BAR; PG8_SCHED;
            PG8_LDB(B0, 1, 0); PG8_LDB(B1, 1, 1); PG8_SCHED; PG8_LDA(At, 1, 0); PG8_STAGE(PG8_SA(0, 1), a2 + hstepA, PG8_OS(1));
            PG8_WAIT_V(8); PG8_WAIT_L(0); PG8_BAR; PG8_MMA(0, 0, At, B0); PG8_MMA(0, 1, At, B1); PG8_BAR; PG8_SCHED;
            PG8_LDA(At, 1, 1); PG8_STAGE(PG8_SB(1, 0), b3, voffB); PG8_STAGE(PG8_SB(1, 1), b3 + hstep, voffB); PG8_STAGE(PG8_SA(1, 0), a3, PG8_OS(0));
            PG8_WAIT_V(8); PG8_WAIT_L(0); PG8_BAR; PG8_MMA(1, 0, At, B0); PG8_MMA(1, 1, At, B1); PG8_BAR; PG8_SCHED;
            } else {
            PG8_LDB(B0, 0, 0); PG8_SCHED; PG8_LDA(At, 0, 0); PG8_STAGE(PG8_SA(1, 1), a1 + hstepA, PG8_OA(1));
            PG8_WAIT_L(8); PG8_BAR; PG8_WAIT_L(0); PG8_MMA(0, 0, At, B0); PG8_BAR; PG8_SCHED;
            PG8_LDB(B1, 0, 1); PG8_STAGE(PG8_SB(0, 0), b2, voffB);
            PG8_BAR; PG8_WAIT_L(0); PG8_MMA(0, 1, At, B1); PG8_BAR;
            PG8_LDA(At, 0, 1); PG8_STAGE(PG8_SA(0, 0), a2, PG8_OS(0));
            PG8_BAR; PG8_WAIT_L(0); PG8_MMA(1, 0, At, B0); PG8_BAR; PG8_SCHED;
            PG8_STAGE(PG8_SB(0, 1), b2 + hstep, voffB);
            PG8_WAIT_V(6); PG8_BAR; PG8_MMA(1, 1, At, B1); PG8_BAR;
            PG8_LDB(B0, 1, 0); PG8_SCHED; PG8_LDA(At, 1, 0); PG8_STAGE(PG8_SA(0, 1), a2 + hstepA, PG8_OS(1));
            PG8_WAIT_L(8); PG8_BAR; PG8_WAIT_L(0); PG8_MMA(0, 0, At, B0); PG8_BAR; PG8_SCHED;
            PG8_LDB(B1, 1, 1); PG8_STAGE(PG8_SB(1, 0), b3, voffB);
            PG8_BAR; PG8_WAIT_L(0); PG8_MMA(0, 1, At, B1); PG8_BAR;
            PG8_LDA(At, 1, 1); PG8_STAGE(PG8_SA(1, 0), a3, PG8_OS(0));
            PG8_BAR; PG8_WAIT_L(0); PG8_MMA(1, 0, At, B0); PG8_BAR; PG8_SCHED;
            PG8_STAGE(PG8_SB(1, 1), b3 + hstep, voffB);
            PG8_WAIT_V(6); PG8_BAR; PG8_MMA(1, 1, At, B1); PG8_BAR;
            }
        }
        if constexpr (ALIGN_EPI) { if (wr == 0) PG8_BAR; }
        if constexpr (!Epi::AFTER_DRAIN) { E(acc, cur, wr, wc, fr, fq); S.done(cur); }
        if (!has_next) break;
#pragma unroll
        for (int a = 0; a < 2; ++a)
#pragma unroll
            for (int b = 0; b < 2; ++b)
#pragma unroll
                for (int m = 0; m < 4; ++m)
#pragma unroll
                    for (int n = 0; n < 2; ++n) acc[a][b][m][n] = (f32x4){0.f, 0.f, 0.f, 0.f};
        cur = nxt; cA = nA; cB = nB; ++ui;
        if constexpr (GATHER) {
#pragma unroll
            for (int h_ = 0; h_ < 2; ++h_) { gA[h_][0] = gN[h_][0]; gA[h_][1] = gN[h_][1]; } }
        if constexpr (ALIGN_EPI) { if (wr == 1) PG8_BAR; }
    }
    PG8_WAIT_V(0);
    if constexpr (!ALIGN_EPI) { if (wr == 0) PG8_BAR; }
    PG8_BAR;
    if constexpr (Epi::AFTER_DRAIN) { E.fused(acc, cur, wr, wc, fr, fq, lds, wid, lane); S.done(cur); }
#undef PG8_SA
#undef PG8_GOFF
#undef PG8_OA
#undef PG8_OS
#undef PG8_SB
#undef PG8_STAGE
#undef PG8_LDA
#undef PG8_LDB
#undef PG8_MMA
#undef PG8_WAIT_V
#undef PG8_WAIT_L
#undef PG8_BAR
#undef PG8_SCHED
}
}

namespace att {
using bf16x8 = __attribute__((ext_vector_type(8))) short;
using s16x4  = __attribute__((ext_vector_type(4))) short;
using f32x16 = __attribute__((ext_vector_type(16))) float;
using u32x4  = __attribute__((ext_vector_type(4))) unsigned;
constexpr int NW = 8, QBLK = 32, KVBLK = 64, KROWB = 256;
constexpr float THR = 8.f;
#define ATT_KSWZ(row, colB) ((row) * 256 + ((colB) ^ (((row) & 7) << 4)))
#define ATT_SBAR() __builtin_amdgcn_sched_barrier(0)
__device__ __forceinline__ int crow(int r, int hi) { return (r & 3) + 8 * (r >> 2) + 4 * hi; }
__device__ __forceinline__ unsigned cvtpk(float lo, float hi) { unsigned r; asm volatile("v_cvt_pk_bf16_f32 %0, %1, %2" : "=v"(r) : "v"(lo), "v"(hi)); return r; }
template <int DK> struct Sc { static constexpr float SCALE = (DK == 96) ? 0.10206207261596575f : 0.125f; static constexpr float C = SCALE * 1.4426950408889634f; };

template <int DK, bool OFF>
__device__ __forceinline__ void partialSM(f32x16& p0, f32x16& p1, float negMC) {
  if constexpr (OFF) {
#pragma unroll
    for (int r = 0; r < 16; ++r) p0[r] += negMC;
#pragma unroll
    for (int r = 0; r < 16; ++r) p1[r] += negMC;
  }
#pragma unroll
  for (int r = 0; r < 16; ++r) p0[r] = __builtin_amdgcn_exp2f(p0[r]);
}
__device__ __forceinline__ void finishSM(f32x16& p0, f32x16& p1, float& l_reg, bf16x8& pa0, bf16x8& pa1, bf16x8& pa2, bf16x8& pa3) {
#pragma unroll
  for (int r = 0; r < 16; ++r) p1[r] = __builtin_amdgcn_exp2f(p1[r]);
  float ps = 0;
#pragma unroll
  for (int r = 0; r < 16; ++r) ps += p0[r];
#pragma unroll
  for (int r = 0; r < 16; ++r) ps += p1[r];
  l_reg += ps;
#define ATT_PK4(P, BASE, OUT) do { unsigned a0 = cvtpk(P[BASE + 0], P[BASE + 1]), a1 = cvtpk(P[BASE + 2], P[BASE + 3]);   \
    unsigned b0 = cvtpk(P[BASE + 4], P[BASE + 5]), b1 = cvtpk(P[BASE + 6], P[BASE + 7]);                              \
    auto r0 = __builtin_amdgcn_permlane32_swap(a0, b0, false, false); auto r1 = __builtin_amdgcn_permlane32_swap(a1, b1, false, false); \
    u32x4 w = {r0[0], r1[0], r0[1], r1[1]}; OUT = *reinterpret_cast<bf16x8*>(&w); } while (0)
  ATT_PK4(p0, 0, pa0); ATT_PK4(p0, 8, pa1); ATT_PK4(p1, 0, pa2); ATT_PK4(p1, 8, pa3);
#undef ATT_PK4
}
template <int DK>
__device__ __forceinline__ void qkt(f32x16& p0, f32x16& p1, const char* Ks, const bf16x8* qr, int r32, int hi) {
  p0 = f32x16{}; p1 = f32x16{};
#pragma unroll
  for (int d0 = 0; d0 < DK / 16; ++d0) { const int cb = (d0 * 16 + hi * 8) * 2;
    const bf16x8 b0 = *reinterpret_cast<const bf16x8*>(Ks + ATT_KSWZ(r32, cb));
    const bf16x8 b1 = *reinterpret_cast<const bf16x8*>(Ks + ATT_KSWZ(32 + r32, cb));
    p0 = __builtin_amdgcn_mfma_f32_32x32x16_bf16(b0, qr[d0], p0, 0, 0, 0);
    p1 = __builtin_amdgcn_mfma_f32_32x32x16_bf16(b1, qr[d0], p1, 0, 0, 0);
  }
}
template <int DV> __device__ __forceinline__ int v_st(int k, int c) { const int kk = (k & ~0xC) | ((k & 4) << 1) | ((k & 8) >> 1); return ((kk >> 3) * (DV / 32) + (c >> 5)) * 512 + ((kk & 7) * 32 + (c & 31)) * 2; }
__device__ __forceinline__ int v_rd_base(int lane) { return ((lane & 3) << 3) | (((lane >> 2) & 3) << 6) | (((lane >> 4) & 1) << 5) | (((lane >> 5) & 1) << 8); }
template <int DV> constexpr int v_rd_off(int d0, int ks, int half) { return d0 * 512 + ks * (2 * (DV / 32) * 512) + half * ((DV / 32) * 512); }
template <int OFF> __device__ __forceinline__ s16x4 tr_read(int vb) {
  s16x4 r; asm volatile("ds_read_b64_tr_b16 %0, %1 offset:%2" : "=&v"(r) : "v"(vb), "i"(OFF) : "memory"); return r;
}
template <int DV, int D0> __device__ __forceinline__ void pv_one(f32x16& od, int vb, bf16x8 pa0, bf16x8 pa1, bf16x8 pa2, bf16x8 pa3) {
  const s16x4 l0 = tr_read<v_rd_off<DV>(D0, 0, 0)>(vb), h0 = tr_read<v_rd_off<DV>(D0, 0, 1)>(vb), l1 = tr_read<v_rd_off<DV>(D0, 1, 0)>(vb), h1 = tr_read<v_rd_off<DV>(D0, 1, 1)>(vb);
  const s16x4 l2 = tr_read<v_rd_off<DV>(D0, 2, 0)>(vb), h2 = tr_read<v_rd_off<DV>(D0, 2, 1)>(vb), l3 = tr_read<v_rd_off<DV>(D0, 3, 0)>(vb), h3 = tr_read<v_rd_off<DV>(D0, 3, 1)>(vb);
  asm volatile("s_waitcnt lgkmcnt(0)" ::: "memory"); ATT_SBAR();
#define ATT_PK(L, H) (bf16x8){L[0], L[1], L[2], L[3], H[0], H[1], H[2], H[3]}
  od = __builtin_amdgcn_mfma_f32_32x32x16_bf16(pa0, ATT_PK(l0, h0), od, 0, 0, 0);
  od = __builtin_amdgcn_mfma_f32_32x32x16_bf16(pa1, ATT_PK(l1, h1), od, 0, 0, 0);
  od = __builtin_amdgcn_mfma_f32_32x32x16_bf16(pa2, ATT_PK(l2, h2), od, 0, 0, 0);
  od = __builtin_amdgcn_mfma_f32_32x32x16_bf16(pa3, ATT_PK(l3, h3), od, 0, 0, 0);
#undef ATT_PK
}
template <int DV> __device__ __forceinline__ void pv_all(f32x16* o, int vb, bf16x8 pa0, bf16x8 pa1, bf16x8 pa2, bf16x8 pa3) {
  pv_one<DV, 0>(o[0], vb, pa0, pa1, pa2, pa3); pv_one<DV, 1>(o[1], vb, pa0, pa1, pa2, pa3);
  if constexpr (DV == 128) { pv_one<DV, 2>(o[2], vb, pa0, pa1, pa2, pa3); pv_one<DV, 3>(o[3], vb, pa0, pa1, pa2, pa3); }
}
__device__ __forceinline__ float half_pair_sum(float v) { const unsigned a = __float_as_uint(v); auto rr = __builtin_amdgcn_permlane32_swap(a, a, false, false); const unsigned r0 = rr[0], r1 = rr[1]; return __uint_as_float(r0) + __uint_as_float(r1); }
__device__ __forceinline__ void unpack_bf8(const bf16x8 w, float* f) {
#pragma unroll
  for (int i = 0; i < 8; ++i) f[i] = __uint_as_float((unsigned)(unsigned short)w[i] << 16); }
__device__ __forceinline__ bf16x8 pack_bf8(const float* f) { u32x4 w = {cvtpk(f[0], f[1]), cvtpk(f[2], f[3]), cvtpk(f[4], f[5]), cvtpk(f[6], f[7])}; return *reinterpret_cast<bf16x8*>(&w); }
struct QLoadMLA {
  const bf16* qpre;
  const float* rq;
  const float* gq;
  const float* cosA;
  __device__ __forceinline__ void load(bf16x8 (&qr)[6], int r, int hi) const {
    const bf16* src = qpre + (long)r * 1536 + hi * 8; float v[6][8]; float ss = 0.f;
#pragma unroll
    for (int d0 = 0; d0 < 6; ++d0) { unpack_bf8(*reinterpret_cast<const bf16x8*>(src + d0 * 16), v[d0]);
#pragma unroll
      for (int j = 0; j < 8; ++j) ss += v[d0][j] * v[d0][j]; }
    ss = half_pair_sum(ss);
    const float rqv = rq[r], f = Sc<96>::C * rqv / sqrtf(rqv * rqv * ss * (1.0f / 96.0f) + EPS);
#pragma unroll
    for (int d0 = 0; d0 < 6; ++d0) { const f32x4 g0 = *(const f32x4*)(gq + d0 * 16 + hi * 8), g1 = *(const f32x4*)(gq + d0 * 16 + hi * 8 + 4);
#pragma unroll
      for (int j = 0; j < 4; ++j) { v[d0][j] *= f * g0[j]; v[d0][4 + j] *= f * g1[j]; } }
    if (cosA) { const float* c = cosA + (long)r * 16 + hi * 8; const float* sn = c + 4096 * 16;
#pragma unroll
      for (int j = 0; j < 8; ++j) { const float x1 = v[4][j], x2 = v[5][j], cs = c[j], si = sn[j]; v[4][j] = x1 * cs - x2 * si; v[5][j] = x1 * si + x2 * cs; } }
#pragma unroll
    for (int d0 = 0; d0 < 6; ++d0) qr[d0] = pack_bf8(v[d0]);
  }
};
struct QLoadPlain {
  const bf16* q; int ldq;
  template <int NQ> __device__ __forceinline__ void load(bf16x8 (&qr)[NQ], int r, int hi) const {
    const bf16* src = q + (long)r * ldq + hi * 8;
#pragma unroll
    for (int d0 = 0; d0 < NQ; ++d0) qr[d0] = *reinterpret_cast<const bf16x8*>(src + d0 * 16);
  }
};
template <int ND> struct OEpiGlobal {
  bf16* Ob; int ldo;
  __device__ __forceinline__ void store(const f32x16 (&o)[ND], const float (&rli)[16], int wid, int r32, int hi, int lane) const {
    bf16* Ow = Ob + (long)(wid * QBLK) * ldo;
#pragma unroll
    for (int r = 0; r < 16; ++r) { const int orow = crow(r, hi);
#pragma unroll
      for (int d0 = 0; d0 < ND; ++d0) Ow[(long)orow * ldo + d0 * 32 + r32] = (bf16)f2bf(o[d0][r] * rli[r]); }
  }
};
struct OEpiStash {
  unsigned short* st;
  __device__ __forceinline__ void store(const f32x16 (&o)[4], const float (&rli)[16], int wid, int r32, int hi, int lane) const {
    unsigned short* w = st + wid * 4096 + lane;
#pragma unroll
    for (int r = 0; r < 16; ++r)
#pragma unroll
      for (int d0 = 0; d0 < 4; ++d0) w[(r * 4 + d0) * 64] = (unsigned short)f2bf(o[d0][r] * rli[r]);
  }
};
struct OEpiDiffFinal {
  const unsigned short* st; bf16* Ob; int ldo; float lam; const float* g;
  float post;
  __device__ __forceinline__ void store(const f32x16 (&o)[4], const float (&rli)[16], int wid, int r32, int hi, int lane) const {
    const unsigned short* w = st + wid * 4096 + lane; bf16* Ow = Ob + (long)(wid * QBLK) * ldo;
    float gg[4];
#pragma unroll
    for (int d0 = 0; d0 < 4; ++d0) gg[d0] = g[d0 * 32 + r32] * post;
#pragma unroll
    for (int r = 0; r < 16; ++r) { float v[4]; float ss = 0.f;
#pragma unroll
      for (int d0 = 0; d0 < 4; ++d0) { const float o0 = __uint_as_float((unsigned)w[(r * 4 + d0) * 64] << 16); v[d0] = o0 - lam * __uint_as_float(f2bf(o[d0][r] * rli[r]) << 16); ss += v[d0] * v[d0]; }
      ss += shx<1>(ss); ss += shx<2>(ss); ss += shx<4>(ss); ss += shx<8>(ss); ss += shx<16>(ss);
      const float rn = 1.0f / sqrtf(ss * (1.0f / 128.0f) + EPS); const int orow = crow(r, hi);
#pragma unroll
      for (int d0 = 0; d0 < 4; ++d0) Ow[(long)orow * ldo + d0 * 32 + r32] = (bf16)f2bf(v[d0] * rn * gg[d0]); }
  }
};
template <int DK, int DV> struct Geo {
  static constexpr int SHM_V = KVBLK * DV * 2, SHM_K = KVBLK * KROWB, SHM = 2 * SHM_V + 2 * SHM_K + NW * 64 * 4;
  static constexpr int KCPR = DK / 8, VCPR = DV / 8;
  static constexpr int NKC = KVBLK * KCPR, NVC = KVBLK * VCPR;
  static constexpr int KN = (NKC + 511) / 512, VN = NVC / 512;
  static_assert(NVC % 512 == 0 && SHM <= 131072, "attention geometry");
};

template <int DK, int DV, int SD, bool OFF, class QLoader, class OEpi>
__device__ __forceinline__ void body(const QLoader& QL, const OEpi& OE, const bf16* __restrict__ K0, const bf16* __restrict__ K1, int ldk,
                                     const bf16* __restrict__ V0, const bf16* __restrict__ V1, int ldv, int nkeys, float negMC, char* lds, int tid_in) {
  using G = Geo<DK, DV>;
  constexpr int SHM_V = G::SHM_V, SHM_K = G::SHM_K, KN = G::KN, VN = G::VN, ND = DV / 32;
  int tid_ = tid_in; asm volatile("" : "+v"(tid_));
  const int tid = tid_, wid = tid >> 6, lane = tid & 63, r32 = lane & 31, hi = lane >> 5;
  char* V_lds = lds; char* K_lds = lds + 2 * SHM_V;
  float* ws = (float*)(lds + 2 * SHM_V + 2 * SHM_K) + wid * 64; float* li_l = ws;
  float l_reg = 0; f32x16 o[ND];
#pragma unroll
  for (int d = 0; d < ND; ++d) o[d] = f32x16{};
  bf16x8 qr[DK / 16];
  QL.load(qr, wid * QBLK + r32, hi);
  int kofs[KN], kdst[KN], vofs[VN], vdst[VN];
#pragma unroll
  for (int i = 0; i < KN; ++i) { const int c = tid + 512 * i, row = (c / G::KCPR) & 63, col = (c % G::KCPR) * 8; kofs[i] = (row * ldk + col) * 2; kdst[i] = ATT_KSWZ(row, col * 2); }
#pragma unroll
  for (int i = 0; i < VN; ++i) { const int c = tid + 512 * i, row = c / G::VCPR, col = (c % G::VCPR) * 8; vofs[i] = (row * ldv + col) * 2; vdst[i] = v_st<DV>(row, col); }
  const bool k_last_ok = (tid + 512 * (KN - 1)) < G::NKC;
  const int vb0 = (int)(uintptr_t)V_lds + v_rd_base(lane);
  struct Slot { bf16x8 k[KN], v[VN]; } sr_[SD];
#define ATT_TBASE(k0, ld, P0, P1) (((k0) < 256) ? ((P0) + (long)(k0) * (ld)) : ((P1) + (long)((k0) - 256) * (ld)))
#define ATT_LD(base, ofs) (*reinterpret_cast<const bf16x8*>((const char*)(base) + (unsigned)(ofs)))
#define ATT_SLOAD(i, k0) do { const bf16* vb_ = ATT_TBASE(k0, ldv, V0, V1); const bf16* kb_ = ATT_TBASE(k0, ldk, K0, K1); \
    _Pragma("unroll") for (int _s = 0; _s < VN; ++_s) sr_[i].v[_s] = ATT_LD(vb_, vofs[_s]); \
    _Pragma("unroll") for (int _s = 0; _s < KN; ++_s) if (_s < KN - 1 || k_last_ok) sr_[i].k[_s] = ATT_LD(kb_, kofs[_s]); } while (0)
#define ATT_SWRITE(b, i) do { \
    _Pragma("unroll") for (int _s = 0; _s < VN; ++_s) *reinterpret_cast<bf16x8*>(V_lds + (b) * SHM_V + vdst[_s]) = sr_[i].v[_s]; \
    _Pragma("unroll") for (int _s = 0; _s < KN; ++_s) if (_s < KN - 1 || k_last_ok) *reinterpret_cast<bf16x8*>(K_lds + (b) * SHM_K + kdst[_s]) = sr_[i].k[_s]; } while (0)
#define ATT_SWAIT() asm volatile("s_waitcnt vmcnt(%0)" :: "n"(SD == 2 ? KN + VN : 0) : "memory")
  f32x16 pA0, pA1, pB0, pB1; bf16x8 pa0, pa1, pa2, pa3; const int NT = nkeys / KVBLK;
  constexpr int SE = 0, SO = SD - 1;
  ATT_SLOAD(SE, 0); asm volatile("s_waitcnt vmcnt(0)" ::: "memory"); ATT_SWRITE(0, SE); __syncthreads();
  qkt<DK>(pA0, pA1, K_lds, qr, r32, hi); partialSM<DK, OFF>(pA0, pA1, negMC);
  ATT_SLOAD(SO, KVBLK); if constexpr (SD == 2) { if (2 < NT) ATT_SLOAD(SE, 2 * KVBLK); }
  ATT_SWAIT(); ATT_SWRITE(1, SO); __syncthreads();
  for (int j = 1; j + 1 < NT; j += 2) {
    ATT_SBAR(); qkt<DK>(pB0, pB1, K_lds + SHM_K, qr, r32, hi);
    finishSM(pA0, pA1, l_reg, pa0, pa1, pa2, pa3); ATT_SBAR();
    ATT_SLOAD(SO, (j + SD) * KVBLK); ATT_SBAR();
    pv_all<DV>(o, vb0, pa0, pa1, pa2, pa3); partialSM<DK, OFF>(pB0, pB1, negMC);
    __syncthreads(); ATT_SWAIT(); ATT_SWRITE(0, SE);
    __syncthreads();
    ATT_SBAR(); qkt<DK>(pA0, pA1, K_lds, qr, r32, hi);
    finishSM(pB0, pB1, l_reg, pa0, pa1, pa2, pa3); ATT_SBAR();
    if (SD == 1 || j + 3 < NT) ATT_SLOAD(SE, (j + 1 + SD) * KVBLK); ATT_SBAR();
    pv_all<DV>(o, vb0 + SHM_V, pa0, pa1, pa2, pa3); partialSM<DK, OFF>(pA0, pA1, negMC);
    __syncthreads(); ATT_SWAIT(); ATT_SWRITE(1, SO);
    __syncthreads();
  }
  ATT_SBAR(); qkt<DK>(pB0, pB1, K_lds + SHM_K, qr, r32, hi);
  finishSM(pA0, pA1, l_reg, pa0, pa1, pa2, pa3); ATT_SBAR();
  pv_all<DV>(o, vb0, pa0, pa1, pa2, pa3); partialSM<DK, OFF>(pB0, pB1, negMC);
  __syncthreads();
  finishSM(pB0, pB1, l_reg, pa0, pa1, pa2, pa3); ATT_SBAR();
  pv_all<DV>(o, vb0 + SHM_V, pa0, pa1, pa2, pa3);
  { auto rr = __builtin_amdgcn_permlane32_swap(__float_as_uint(l_reg), __float_as_uint(l_reg), false, false);
    l_reg = __uint_as_float(rr[0]) + __uint_as_float(rr[1]); }
  if (hi == 0) li_l[r32] = l_reg; asm volatile("s_waitcnt lgkmcnt(0)" ::: "memory");
  float rli[16];
#pragma unroll
  for (int r = 0; r < 16; ++r) rli[r] = __builtin_amdgcn_rcpf(li_l[crow(r, hi)]);
  OE.store(o, rli, wid, r32, hi, lane);
  __syncthreads();
#undef ATT_TBASE
#undef ATT_LD
#undef ATT_SLOAD
#undef ATT_SWRITE
#undef ATT_SWAIT
}
}

#define XB_TMO      128
#define XB_XCNT(j)  (256  + 64 * (j))
#define XB_XSUB(j)  (1280 + 64 * (j))
#define XB_XGEN(j)  (2304 + 64 * (j))
#define XB_TOP      3328
#define XB_TOPGEN   3392
#define XCD_BAR_WORDS 3456
#define XB_SPIN_CAP (1u << 18)

__device__ __forceinline__ unsigned xb_ld(unsigned* p)              { return __hip_atomic_load(p, __ATOMIC_RELAXED, __HIP_MEMORY_SCOPE_AGENT); }
__device__ __forceinline__ unsigned xb_add(unsigned* p, unsigned v) { return __hip_atomic_fetch_add(p, v, __ATOMIC_RELAXED, __HIP_MEMORY_SCOPE_AGENT); }
__device__ __forceinline__ unsigned xb_xcc_id() { return (unsigned)__builtin_amdgcn_s_getreg((3 << 11) | 20) & 0xFu; }
#define XB_SPIN(cond, bar) do { unsigned _sp = 0; while (cond) { __builtin_amdgcn_s_sleep(1); \
    if ((++_sp & 255u) == 0u) { if (xb_ld(&(bar)[XB_TMO])) break; if (_sp > XB_SPIN_CAP) { atomicAdd(&(bar)[XB_TMO], 1u); break; } } } } while (0)

struct XcdBarrier {
    int wave;
    unsigned* bar; unsigned x;
    volatile LAS unsigned* st;
};

__device__ __forceinline__ XcdBarrier xcd_barrier_post(unsigned* bar, volatile LAS unsigned* st) {
    XcdBarrier b; b.wave = 0; b.bar = bar; b.x = xb_xcc_id(); b.st = st;
    if (threadIdx.x == 0) (void)xb_add(&bar[XB_XCNT(b.x)], 1u);
    return b;
}
__device__ __forceinline__ void xcd_barrier_complete(unsigned* bar, unsigned x, unsigned& nloc, unsigned& nx) {
    const unsigned G = gridDim.x * gridDim.y * gridDim.z;
    unsigned sum, cnt, mine, sp = 0u;
    for (;;) {
        sum = 0u; cnt = 0u; mine = 0u;
#pragma unroll
        for (unsigned j = 0; j < 16; ++j) { const unsigned c = xb_ld(&bar[XB_XCNT(j)]); sum += c; cnt += (c > 0u) ? 1u : 0u; mine = (j == x) ? c : mine; }
        if (sum == G) break;
        __builtin_amdgcn_s_sleep(1);
        if ((++sp & 255u) == 0u) { if (xb_ld(&bar[XB_TMO])) break; if (sp > XB_SPIN_CAP) { atomicAdd(&bar[XB_TMO], 1u); break; } }
    }
    nloc = mine > 0u ? mine : 1u; nx = cnt > 0u ? cnt : 1u;
}

__device__ __forceinline__ void xcd_barrier(const XcdBarrier& b) {
    asm volatile("s_waitcnt vmcnt(0)" ::: "memory");
    __syncthreads();
    if (b.wave == 0 && hw_lane() == 0) {
        size_t zb_ = 0; asm volatile("" : "+s"(zb_));
        unsigned* bar = b.bar + zb_;
        __builtin_amdgcn_s_waitcnt(0);
        unsigned nloc = b.st[0], nx = b.st[1];
        if (nloc == 0u) { xcd_barrier_complete(bar, b.x, nloc, nx); b.st[0] = nloc; b.st[1] = nx; }
        const unsigned old = xb_add(&bar[XB_XSUB(b.x)], 1u);
        const unsigned gen = old / nloc;
        if (old + 1u == (gen + 1u) * nloc) {
            __builtin_amdgcn_fence(__ATOMIC_RELEASE, "agent");
            asm volatile("s_waitcnt vmcnt(0)" ::: "memory");
            const unsigned og = xb_add(&bar[XB_TOP], 1u);
            const unsigned tg = og / nx;
            if (og + 1u == (tg + 1u) * nx) xb_add(&bar[XB_TOPGEN], 1u);
            else XB_SPIN(xb_ld(&bar[XB_TOPGEN]) == tg, bar);
            __builtin_amdgcn_fence(__ATOMIC_ACQUIRE, "agent");
            xb_add(&bar[XB_XGEN(b.x)], 1u);
            asm volatile("s_waitcnt vmcnt(0)" ::: "memory");
        } else {
            XB_SPIN(xb_ld(&bar[XB_XGEN(b.x)]) == gen, bar);
            __builtin_amdgcn_fence(__ATOMIC_ACQUIRE, "agent");
            asm volatile("s_waitcnt vmcnt(0)" ::: "memory");
        }
    }
    __syncthreads();
}

struct Args { const float* in[35]; float* out; unsigned char* ws; int ph_lo, ph_hi; };
enum { I_X = 0, I_C, I_CTX, I_CCTX, I_ADAW, I_ADAB, I_NMIX, I_NFFN, I_MLA_WIN, I_MLA_QNG, I_MLA_WUQ, I_MLA_KVNG, I_MLA_WUKV, I_MLA_QN, I_MLA_KN, I_MLA_WOUT,
       I_DF_WIN, I_DF_QN, I_DF_KN, I_DF_LQ1, I_DF_LK1, I_DF_LQ2, I_DF_LK2, I_DF_SUBG, I_DF_WOUT, I_SG_WIN, I_SG_LNG, I_SG_LNB, I_SG_WS, I_SG_BS, I_SG_WOUT,
       I_ROUTER, I_WGATE, I_WUP, I_WDOWN };
struct Frame {
    LAS unsigned char* lds;
    int tid, lane, wave, vcu, G;
    unsigned char* ws; float* out;
};
struct InPtrs {
    volatile LAS unsigned* tab;
    __device__ __forceinline__ const float* operator[](int i) const {
        const unsigned lo = __builtin_amdgcn_readfirstlane(tab[2 * i]), hi = __builtin_amdgcn_readfirstlane(tab[2 * i + 1]);
        return (const float*)(const GAS float*)(((unsigned long long)hi << 32) | lo);
    }
};
__device__ __forceinline__ bf16* xb_row(const Frame& F, int row) { return (bf16*)(F.ws + WS_XB) + (size_t)row * D; }

constexpr int TR_SROW = 136, TR_WAVE_BYTES = 64 * TR_SROW;
typedef short tr_v4i16 __attribute__((ext_vector_type(4)));
__device__ __forceinline__ void transpose_item(const float* W, int N, int k0, int n0, int ncols  , bf16* WT, int K, int drow0, LAS unsigned char* scr, int lane, const float* kscale = nullptr  ) {
    const int r4 = lane >> 4, c4 = (lane & 15) * 4;
    const bool ld_ok = c4 < ncols;
    f32x4 v[16];
    const float* src = W + (size_t)(k0 + r4) * N + n0 + c4;
#pragma unroll
    for (int i = 0; i < 16; ++i) v[i] = ld_ok ? __builtin_nontemporal_load((const f32x4*)(src + (size_t)(4 * i) * N)) : (f32x4){0.f, 0.f, 0.f, 0.f};
#pragma unroll
    for (int i = 0; i < 16; ++i) { if (kscale) v[i] = v[i] * kscale[k0 + 4 * i + r4]; v2u w; w.x = pk2(v[i].x, v[i].y); w.y = pk2(v[i].z, v[i].w); *(LAS v2u*)(scr + (4 * i + r4) * TR_SROW + c4 * 2) = w; }
    LDS_WAIT(); asm volatile("" ::: "memory");
    const LAS unsigned char* rb = scr + ((lane >> 2) & 3) * TR_SROW + ((lane >> 4) * 16 + (lane & 3) * 4) * 2;
    v2u o[16];
#pragma unroll
    for (int k4 = 0; k4 < 16; ++k4) { const tr_v4i16 t = __builtin_amdgcn_ds_read_tr16_b64_v4i16((LAS tr_v4i16*)(rb + k4 * 4 * TR_SROW)); o[k4] = __builtin_bit_cast(v2u, t); }
    LDS_WAIT(); asm volatile("" ::: "memory");
    if (lane < ncols) { v4u* dst = (v4u*)(WT + (size_t)(drow0 + lane) * K + k0);
#pragma unroll
        for (int j = 0; j < 8; ++j) dst[j] = (v4u){o[2 * j].x, o[2 * j].y, o[2 * j + 1].x, o[2 * j + 1].y}; }
}
__device__ __forceinline__ int tr_items(int K, int N) { return (K / 64) * ((N + 63) / 64); }
__device__ __forceinline__ void tr_run(const float* W, int K, int N, bf16* WT, int r, LAS unsigned char* scr, int lane, const float* kscale = nullptr) {
    const int nblk = (N + 63) / 64, kb = r / nblk, nb = r % nblk, k0 = kb * 64, n0 = nb * 64;
    transpose_item(W, N, k0, n0, (N - n0) < 64 ? (N - n0) : 64, WT, K, n0, scr, lane, kscale);
}

__device__ __forceinline__ void p0_prologue(Frame& F, const InPtrs& A) {
    {
        LAS float* sv = (LAS float*)F.lds;
        LAS float* red = (LAS float*)(F.lds + 36864);
        bool have = false;
        for (int it = blockIdx.x; it < 96; it += F.G) {
            if (!have) {
                for (int i = F.tid; i < 9 * 1024; i += NTHREADS) { const int r = i >> 10, k = i & 1023; const float v = r < 8 ? A[I_C][r * 1024 + k] : A[I_CCTX][k]; sv[i] = v / (1.0f + __expf(-v)); }
                __syncthreads(); have = true;
            }
            const int layer = it / 24, cb = it % 24, col = cb * 256 + 4 * F.lane, kbase = F.wave * 128;
            const float* W = A[I_ADAW] + (size_t)layer * 1024 * 6144 + col;
            f32x4 acc[9];
#pragma unroll
            for (int r = 0; r < 9; ++r) acc[r] = (f32x4){0.f, 0.f, 0.f, 0.f};
#pragma unroll 4
            for (int k = 0; k < 128; ++k) { const f32x4 w = *(const f32x4*)(W + (size_t)(kbase + k) * 6144);
#pragma unroll
                for (int r = 0; r < 9; ++r) acc[r] += w * sv[r * 1024 + kbase + k]; }
#pragma unroll
            for (int r = 0; r < 9; ++r) *(LAS f32x4*)(red + (F.wave * 9 + r) * 256 + 4 * F.lane) = acc[r];
            __syncthreads();
            float* MODp = (float*)(F.ws + WS_MOD) + (size_t)layer * 9 * 6144;
            for (int o = F.tid; o < 9 * 256; o += NTHREADS) { const int r = o >> 8, cc = o & 255; float s = 0.f;
#pragma unroll
                for (int w = 0; w < 8; ++w) s += red[(w * 9 + r) * 256 + cc];
                MODp[r * 6144 + cb * 256 + cc] = s + A[I_ADAB][layer * 6144 + cb * 256 + cc]; }
            __syncthreads();
        }
        __syncthreads();
    }
    const int gtid = F.vcu * NTHREADS + F.tid, GT = F.G * NTHREADS;
    {
        float* ca = (float*)(F.ws + WS_ROPEA); float* sa = ca + 4096 * 16; float* cb = (float*)(F.ws + WS_ROPEB); float* sb = cb + 4096 * 32;
        for (int i = gtid; i < 4096 * 16; i += GT) { const int t = i >> 4, j = i & 15, f = j & 7; const float pos = (float)(j < 8 ? (t >> 6) : (t & 63));
            const float inv = powf(10000.0f, -(float)f / 8.0f), ang = pos * inv; ca[i] = cosf(ang); sa[i] = sinf(ang); }
        for (int i = gtid; i < 4096 * 32; i += GT) { const int t = i >> 5, j = i & 31, f = j & 15; const float pos = (float)(j < 16 ? (t >> 6) : (t & 63));
            const float inv = powf(10000.0f, -(float)f / 16.0f), ang = pos * inv; cb[i] = cosf(ang); sb[i] = sinf(ang); }
    }
    {
        for (int j = 0; j < 2; ++j) { v4u* z = (v4u*)(F.ws + WS_WNM + j * MLA_W_STRIDE + MLA_WIN + (size_t)800 * 1024 * 2);
            for (int i = gtid; i < 224 * 1024 * 2 / 16; i += GT) z[i] = (v4u){0u, 0u, 0u, 0u}; }
        bf16* wsA = (bf16*)(F.ws + WS_SG_WS); const float* wsrc = A[I_SG_WS];
        for (int i = gtid; i < 8 * 256 * 128 / 2; i += GT) { const int e0 = i * 2, g = e0 >> 15, p = (e0 >> 7) & 255, q = e0 & 127;
            unsigned w = 0u; if (p < 128) { const float* s = wsrc + ((size_t)g * 128 + p) * 128 + q; w = pk2(s[0], s[1]); }
            ((unsigned*)wsA)[i] = w; }
    }
    {
        LAS unsigned char* scr = F.lds + F.wave * TR_WAVE_BYTES;
        const int gw = F.vcu * NWAVES + F.wave, NGW = F.G * NWAVES;
        const int n_win = tr_items(1024, 800), n_wuq = tr_items(512, 1536), n_wukv = tr_items(256, 2048), n_wout = tr_items(1024, 1024);
        const int n_mla = n_win + n_wuq + n_wukv + n_wout;
        const int n_dwin = tr_items(1024, 3072), n_dwout = tr_items(1024, 1024), n_swin = tr_items(1024, 4096), n_swout = tr_items(2048, 1024);
        const int total = 2 * n_mla + n_dwin + n_dwout + n_swin + n_swout;
        for (int it = gw; it < total; it += NGW) {
            int r = it;
            if (r < 2 * n_mla) { const int j = r / n_mla; r -= j * n_mla; unsigned char* wb = F.ws + WS_WNM + j * MLA_W_STRIDE;
                if (r < n_win) { tr_run(A[I_MLA_WIN] + (size_t)j * 1024 * 800, 1024, 800, (bf16*)(wb + MLA_WIN), r, scr, F.lane); continue; } r -= n_win;
                if (r < n_wuq) { tr_run(A[I_MLA_WUQ] + (size_t)j * 512 * 1536, 512, 1536, (bf16*)(wb + MLA_WUQ), r, scr, F.lane, A[I_MLA_QNG] + j * 512); continue; } r -= n_wuq;
                if (r < n_wukv) { tr_run(A[I_MLA_WUKV] + (size_t)j * 256 * 2048, 256, 2048, (bf16*)(wb + MLA_WUKV), r, scr, F.lane, A[I_MLA_KVNG] + j * 256); continue; } r -= n_wukv;
                tr_run(A[I_MLA_WOUT] + (size_t)j * 1024 * 1024, 1024, 1024, (bf16*)(wb + MLA_WOUT), r, scr, F.lane); continue; }
            r -= 2 * n_mla;
            if (r < n_dwin) { tr_run(A[I_DF_WIN], 1024, 3072, (bf16*)(F.ws + WS_DIFF_WIN), r, scr, F.lane); continue; } r -= n_dwin;
            if (r < n_dwout) { tr_run(A[I_DF_WOUT], 1024, 1024, (bf16*)(F.ws + WS_DIFF_WOUT), r, scr, F.lane); continue; } r -= n_dwout;
            if (r < n_swin) { tr_run(A[I_SG_WIN], 1024, 4096, (bf16*)(F.ws + WS_SG_WIN), r, scr, F.lane); continue; } r -= n_swin;
            tr_run(A[I_SG_WOUT], 2048, 1024, (bf16*)(F.ws + WS_SG_WOUT), r, scr, F.lane);
        }
    }
}
__device__ __forceinline__ void moe_weight_item(Frame& F, const InPtrs& A, int layer, int it, LAS unsigned char* scr) {
    constexpr int PER = 16 * 16;
    const int which = it / (16 * PER), r0 = it % (16 * PER), e = r0 / PER, r = r0 % PER, kb = r >> 4, nb = r & 15, k0 = kb * 64, n0 = nb * 64;
    const size_t eoff = ((size_t)layer * 16 + e) * 1024 * 1024;
    if (which == 0) transpose_item(A[I_WGATE] + eoff, 1024, k0, n0, 64, (bf16*)(F.ws + WS_WGU), 1024, e * 2048 + (n0 >> 7) * 256 + (n0 & 127), scr, F.lane);
    else if (which == 1) transpose_item(A[I_WUP] + eoff, 1024, k0, n0, 64, (bf16*)(F.ws + WS_WGU), 1024, e * 2048 + (n0 >> 7) * 256 + 128 + (n0 & 127), scr, F.lane);
    else transpose_item(A[I_WDOWN] + eoff, 1024, k0, n0, 64, (bf16*)(F.ws + WS_WDN), 1024, e * 1024 + n0, scr, F.lane);
}
constexpr int MOE_CONV_ITEMS = 3 * 16 * 16 * 16;
__device__ __forceinline__ void moe_weight_items(Frame& F, const InPtrs& A, int layer) {
    LAS unsigned char* scr = F.lds + F.wave * TR_WAVE_BYTES;
    const int gw = F.vcu * NWAVES + F.wave, NGW = F.G * NWAVES;
    for (int it = gw; it < MOE_CONV_ITEMS; it += NGW) moe_weight_item(F, A, layer, it, scr);
}
constexpr int DIFF_STASH_OFF = 69632;
constexpr int CONV_LDS_OFF = 69632;
__device__ __forceinline__ int conv_rounds(const Frame& F) { return F.G >= 256 ? 6 : (F.G >= 128 ? 12 : (MOE_CONV_ITEMS + F.G * NWAVES - 1) / (F.G * NWAVES)); }
__device__ __forceinline__ void moe_weight_round(Frame& F, const InPtrs& A, int layer, int round) {
    const int it = round * (F.G * NWAVES) + F.vcu * NWAVES + F.wave;
    Frame Fc = F; Fc.lane = hw_lane();
    if (it < MOE_CONV_ITEMS) moe_weight_item(Fc, A, layer, it, F.lds + CONV_LDS_OFF + F.wave * TR_WAVE_BYTES);
}
template <bool FFN, bool FIRST>
__device__ __forceinline__ void norm_phase(Frame& F, const InPtrs& A, int layer, bool combine, int nrows, float cmul = 1.0f) {
    constexpr bool first = FIRST;
    const int gw = F.vcu * NWAVES + F.wave, NGW = F.G * NWAVES, lane = F.lane;
    const float* MOD = (const float*)(F.ws + WS_MOD);
    LAS float* rT = (LAS float*)F.lds;
    if (FFN) {
        const float* R = A[I_ROUTER] + (size_t)layer * 1024 * 16;
        for (int i = F.tid; i < 16 * 1024; i += NTHREADS) { const int k = i >> 4, e = i & 15; rT[e * 1024 + k] = R[i]; }
        __syncthreads();
    }
#define NPC(q) (8 * (64 * ((q) >> 1) + lane) + 4 * ((q) & 1))
    const float* gvec = (FFN ? A[I_NFFN] : A[I_NMIX]) + layer * 1024;
    f32x4 gn[4];
#pragma unroll
    for (int j = 0; j < 4; ++j) gn[j] = *(const f32x4*)(gvec + NPC(j));
    const bf16* YB = (const bf16*)(F.ws + R_YB);
    const int* SLOT = (const int*)(F.ws + WS_SLOT);
    const float* A_x = first ? A[I_X] : nullptr; const float* A_c = first ? A[I_CTX] : nullptr;
    f32x4 xaf[4], xbf[4]; v4u xab[2], xbb[2]; int sla = -1, slb = -1;
    v4u wB[4][2], wC[4][2]; int sB[4] = {-1, -1, -1, -1}, sC[4] = {-1, -1, -1, -1}; unsigned restB = 0u, restC = 0u;
#define NP_LOADX(mm, XF, XB_, SL) do { if (first) { const float* src_ = (mm) < NLAT ? A_x + (size_t)(mm) * D : A_c + (size_t)((mm) - NLAT) * D; \
        _Pragma("unroll") for (int j = 0; j < 4; ++j) XF[j] = *(const f32x4*)(src_ + NPC(j)); } \
      else { const bf16* src_ = xb_row(F, (mm)); _Pragma("unroll") for (int k = 0; k < 2; ++k) XB_[k] = *(const v4u*)(src_ + NPC(2 * k)); } \
      if (combine) SL = SLOT[(size_t)(mm) * 16 + (lane & 15)]; } while (0)
#define NP_LOADW(SL, W, SI, REST) do { unsigned msk_ = (unsigned)(__ballot((SL) >= 0) & 0xffffull); \
        _Pragma("unroll") for (int q = 0; q < 4; ++q) { SI[q] = -1; if (msk_) { const int e_ = __builtin_ctz(msk_); msk_ &= msk_ - 1u; SI[q] = __builtin_amdgcn_readlane((SL), e_); } } \
        REST = msk_; \
        _Pragma("unroll") for (int q = 0; q < 4; ++q) if (SI[q] >= 0) { const bf16* y_ = YB + (size_t)SI[q] * 1024; \
            _Pragma("unroll") for (int k = 0; k < 2; ++k) W[q][k] = *(const v4u*)(y_ + NPC(2 * k)); } } while (0)
    if (gw < nrows) { NP_LOADX(gw, xbf, xbb, slb); }
    if (gw + NGW < nrows) { NP_LOADX(gw + NGW, xaf, xab, sla); }
    if (combine && gw < nrows) { NP_LOADW(slb, wB, sB, restB); }
    for (int m = gw; m < nrows; m += NGW) {
        const bool lat = m < NLAT; const int rr = lat ? (m >> 12) : 8;
        f32x4 v[4]; const int slc = slb;
#pragma unroll
        for (int k = 0; k < 2; ++k) { v[2 * k] = first ? xbf[2 * k] : (f32x4){bflo(xbb[k].x), bfhi(xbb[k].x), bflo(xbb[k].y), bfhi(xbb[k].y)}; v[2 * k + 1] = first ? xbf[2 * k + 1] : (f32x4){bflo(xbb[k].z), bfhi(xbb[k].z), bflo(xbb[k].w), bfhi(xbb[k].w)}; }
#pragma unroll
        for (int q = 0; q < 4; ++q) { sC[q] = sB[q]; wC[q][0] = wB[q][0]; wC[q][1] = wB[q][1]; }
        restC = restB;
#pragma unroll
        for (int j = 0; j < 4; ++j) xbf[j] = xaf[j];
        xbb[0] = xab[0]; xbb[1] = xab[1];
        slb = sla;
        { const int m2 = m + 2 * NGW; if (m2 < nrows) { NP_LOADX(m2, xaf, xab, sla); } }
        if (combine) { if (m + NGW < nrows) { NP_LOADW(slb, wB, sB, restB); } }
        if (combine) {
            f32x4 acc[4];
#pragma unroll
            for (int j = 0; j < 4; ++j) acc[j] = (f32x4){0.f, 0.f, 0.f, 0.f};
#pragma unroll
            for (int q = 0; q < 4; ++q) if (sC[q] >= 0) {
#pragma unroll
                for (int k = 0; k < 2; ++k) { acc[2 * k] += (f32x4){bflo(wC[q][k].x), bfhi(wC[q][k].x), bflo(wC[q][k].y), bfhi(wC[q][k].y)}; acc[2 * k + 1] += (f32x4){bflo(wC[q][k].z), bfhi(wC[q][k].z), bflo(wC[q][k].w), bfhi(wC[q][k].w)}; } }
            while (restC) {
                const int e = __builtin_ctz(restC); restC &= restC - 1u; const int sidx = __builtin_amdgcn_readlane(slc, e);
                const bf16* y = YB + (size_t)sidx * 1024;
#pragma unroll
                for (int k = 0; k < 2; ++k) { const v4u w = *(const v4u*)(y + NPC(2 * k)); acc[2 * k] += (f32x4){bflo(w.x), bfhi(w.x), bflo(w.y), bfhi(w.y)}; acc[2 * k + 1] += (f32x4){bflo(w.z), bfhi(w.z), bflo(w.w), bfhi(w.w)}; }
            }
            const float* g2 = MOD + ((size_t)(layer - 1) * 9 + rr) * 6144 + 5120;
#pragma unroll
            for (int j = 0; j < 4; ++j) v[j] += *(const f32x4*)(g2 + NPC(j)) * acc[j] * cmul;
        }
        if (first || combine) { bf16* dst = xb_row(F, m);
#pragma unroll
            for (int k = 0; k < 2; ++k) { v4u w; w.x = pk2(v[2 * k].x, v[2 * k].y); w.y = pk2(v[2 * k].z, v[2 * k].w); w.z = pk2(v[2 * k + 1].x, v[2 * k + 1].y); w.w = pk2(v[2 * k + 1].z, v[2 * k + 1].w);
                *(v4u*)(dst + NPC(2 * k)) = w;
                v[2 * k] = (f32x4){bflo(w.x), bfhi(w.x), bflo(w.y), bfhi(w.y)}; v[2 * k + 1] = (f32x4){bflo(w.z), bfhi(w.z), bflo(w.w), bfhi(w.w)}; } }
        float ss = 0.f;
#pragma unroll
        for (int j = 0; j < 4; ++j) ss += (v[j].x * v[j].x + v[j].y * v[j].y) + (v[j].z * v[j].z + v[j].w * v[j].w);
        const float r = 1.0f / sqrtf(wave_sum(ss) * (1.0f / D) + EPS);
        const float* mrow = MOD + ((size_t)layer * 9 + rr) * 6144 + (FFN ? 3072 : 0);
        f32x4 h[4];
#pragma unroll
        for (int j = 0; j < 4; ++j) { const f32x4 sh = *(const f32x4*)(mrow + NPC(j)), sc = *(const f32x4*)(mrow + 1024 + NPC(j));
            h[j] = (v[j] * r * gn[j]) * (sc + 1.0f) + sh; }
        bf16* hrow = (bf16*)(F.ws + WS_H) + (size_t)m * D;
#pragma unroll
        for (int k = 0; k < 2; ++k) { v4u w; w.x = pk2(h[2 * k].x, h[2 * k].y); w.y = pk2(h[2 * k].z, h[2 * k].w); w.z = pk2(h[2 * k + 1].x, h[2 * k + 1].y); w.w = pk2(h[2 * k + 1].z, h[2 * k + 1].w); *(v4u*)(hrow + NPC(2 * k)) = w; }
        if (FFN) {
            float lg[16];
            LAS float* rTm = rT + 8 * lane; asm volatile("" : "+v"(rTm));
#pragma unroll
            for (int e = 0; e < 16; ++e) { float s = 0.f;
#pragma unroll
                for (int j = 0; j < 4; ++j) { const f32x4 w = *(const LAS f32x4*)(rTm + e * 1024 + 512 * (j >> 1) + 4 * (j & 1)); s += (h[j].x * w.x + h[j].y * w.y) + (h[j].z * w.z + h[j].w * w.w); }
                lg[e] = wave_sum(s); }
            float mx = lg[0];
#pragma unroll
            for (int e = 1; e < 16; ++e) mx = fmaxf(mx, lg[e]);
            float den = 0.f;
#pragma unroll
            for (int e = 0; e < 16; ++e) { lg[e] = expf(lg[e] - mx); den += lg[e]; }
            float mine = 0.f;
#pragma unroll
            for (int e = 0; e < 16; ++e) mine = (lane == e) ? lg[e] : mine;
            if (lane < 16) { ((float*)(F.ws + WS_AFF))[(size_t)m * 16 + lane] = mine / den; ((int*)(F.ws + WS_SLOT))[(size_t)m * 16 + lane] = -1; }
        }
    }
}
#undef NP_LOADX
#undef NP_LOADW
#undef NPC
__device__ __forceinline__ void final_phase(Frame& F, int layer) {
    const int gw = F.vcu * NWAVES + F.wave, NGW = F.G * NWAVES, lane = F.lane;
    const float* MOD = (const float*)(F.ws + WS_MOD);
    const bf16* YB = (const bf16*)(F.ws + R_YB); const int* SLOT = (const int*)(F.ws + WS_SLOT);
    v2u vn[4]; int sln = -1;
    if (gw < NLAT) { const bf16* src = xb_row(F, gw);
#pragma unroll
        for (int j = 0; j < 4; ++j) vn[j] = *(const v2u*)(src + 4 * (64 * j + lane));
        sln = SLOT[(size_t)gw * 16 + (lane & 15)]; }
    for (int m = gw; m < NLAT; m += NGW) {
        float* xr = F.out + (size_t)m * D; const int rr = m >> 12;
        f32x4 v[4]; const int sl = sln;
#pragma unroll
        for (int j = 0; j < 4; ++j) v[j] = (f32x4){bflo(vn[j].x), bfhi(vn[j].x), bflo(vn[j].y), bfhi(vn[j].y)};
        { const int mn = m + NGW; if (mn < NLAT) { const bf16* src = xb_row(F, mn);
#pragma unroll
            for (int j = 0; j < 4; ++j) vn[j] = *(const v2u*)(src + 4 * (64 * j + lane));
            sln = SLOT[(size_t)mn * 16 + (lane & 15)]; } }
        f32x4 acc[4];
#pragma unroll
        for (int j = 0; j < 4; ++j) acc[j] = (f32x4){0.f, 0.f, 0.f, 0.f};
        unsigned msk = (unsigned)(__ballot(sl >= 0) & 0xffffull);
        while (msk) {
            int sidx[4]; v2u w[4][4];
#pragma unroll
            for (int q = 0; q < 4; ++q) { sidx[q] = -1; if (msk) { const int e = __builtin_ctz(msk); msk &= msk - 1u; sidx[q] = __builtin_amdgcn_readlane(sl, e); } }
#pragma unroll
            for (int q = 0; q < 4; ++q) if (sidx[q] >= 0) { const bf16* y = YB + (size_t)sidx[q] * 1024;
#pragma unroll
                for (int j = 0; j < 4; ++j) w[q][j] = *(const v2u*)(y + 4 * (64 * j + lane)); }
#pragma unroll
            for (int q = 0; q < 4; ++q) if (sidx[q] >= 0) {
#pragma unroll
                for (int j = 0; j < 4; ++j) acc[j] += (f32x4){bflo(w[q][j].x), bfhi(w[q][j].x), bflo(w[q][j].y), bfhi(w[q][j].y)}; }
        }
        const float* g2 = MOD + ((size_t)layer * 9 + rr) * 6144 + 5120;
#pragma unroll
        for (int j = 0; j < 4; ++j) *(f32x4*)(xr + 4 * (64 * j + lane)) = v[j] + *(const f32x4*)(g2 + 4 * (64 * j + lane)) * acc[j];
    }
}
__device__ __forceinline__ void unpack8(const v4u w, float* f) { f[0] = bflo(w.x); f[1] = bfhi(w.x); f[2] = bflo(w.y); f[3] = bfhi(w.y); f[4] = bflo(w.z); f[5] = bfhi(w.z); f[6] = bflo(w.w); f[7] = bfhi(w.w); }
__device__ __forceinline__ v4u pack8(const float* f) { v4u w; w.x = pk2(f[0], f[1]); w.y = pk2(f[2], f[3]); w.z = pk2(f[4], f[5]); w.w = pk2(f[6], f[7]); return w; }
__device__ __forceinline__ void unpack4(const v2u w, float* f) { f[0] = bflo(w.x); f[1] = bfhi(w.x); f[2] = bflo(w.y); f[3] = bfhi(w.y); }
__device__ __forceinline__ v2u pack4(const float* f) { v2u w; w.x = pk2(f[0], f[1]); w.y = pk2(f[2], f[3]); return w; }

struct MfRow { v4u cq; v2u ckv; v4u k0, k1; v2u kr0, kr1; v4u v0, v1; f32x4 cs, sn; };
__device__ __forceinline__ void mf_load(MfRow& R, int m, const bf16* KVPRE, const bf16* DOWN, const float* ca, const float* sa, int lane, int h, int p) {
    const bf16* dr = DOWN + (size_t)m * 1024;
    R.cq = *(const v4u*)(dr + 8 * lane); R.ckv = *(const v2u*)(dr + 512 + 4 * lane);
    const bf16* s = KVPRE + (size_t)m * 2048 + h * 128; const bf16* kr = dr + 768;
    { const v4u* pp = (const v4u*)(s + 16 * p); R.k0 = pp[0]; R.k1 = pp[1]; R.kr0 = *(const v2u*)(kr + 4 * p); R.kr1 = *(const v2u*)(kr + 16 + 4 * p); }
    { const v4u* vs = (const v4u*)(s + 64 + 16 * p); R.v0 = vs[0]; R.v1 = vs[1]; }
    if (m < NLAT) { const int t = m & 4095; R.cs = *(const f32x4*)(ca + t * 16 + 4 * p); R.sn = *(const f32x4*)(sa + t * 16 + 4 * p); }
    else { R.cs = (f32x4){1.f, 1.f, 1.f, 1.f}; R.sn = (f32x4){0.f, 0.f, 0.f, 0.f}; }
}
__device__ __forceinline__ void mla_finish_phase(Frame& F, const InPtrs& A, int j) {
    const int gw = F.vcu * NWAVES + F.wave, NGW = F.G * NWAVES, lane = F.lane, h = lane >> 2, p = lane & 3;
    const bf16* DOWN = (const bf16*)(F.ws + R_DOWN); const bf16* KVPRE = (const bf16*)(F.ws + R_KVPRE);
    bf16* MK = (bf16*)(F.ws + R_MK); bf16* MV = (bf16*)(F.ws + R_MV); float* RQ = (float*)(F.ws + WS_RQ);
    const float* ca = (const float*)(F.ws + WS_ROPEA); const float* sa = ca + 4096 * 16;
    float gk[24];
    { const float* k = A[I_MLA_KN] + j * 96;
#pragma unroll
      for (int i = 0; i < 16; ++i) gk[i] = k[16 * p + i];
#pragma unroll
      for (int i = 0; i < 4; ++i) { gk[16 + i] = k[64 + 4 * p + i]; gk[20 + i] = k[80 + 4 * p + i]; } }
    MfRow N;
    if (gw < MROWS) mf_load(N, gw, KVPRE, DOWN, ca, sa, lane, h, p);
    for (int m = gw; m < MROWS; m += NGW) {
        const MfRow R = N;
        { const int mn = m + NGW; if (mn < MROWS) mf_load(N, mn, KVPRE, DOWN, ca, sa, lane, h, p); }
        const bool lat = m < NLAT; const int b = lat ? (m >> 12) : ((m - NLAT) >> 8), t = lat ? (m & 4095) : ((m - NLAT) & 255);
        float c8[8], c4[4]; unpack8(R.cq, c8); unpack4(R.ckv, c4);
        float sq = 0.f, skv = 0.f;
#pragma unroll
        for (int i = 0; i < 8; ++i) sq += c8[i] * c8[i];
#pragma unroll
        for (int i = 0; i < 4; ++i) skv += c4[i] * c4[i];
        sq = wave_sum(sq); skv = wave_sum(skv);
        const float rq = 1.0f / sqrtf(sq * (1.0f / 512.0f) + EPS), rkv = 1.0f / sqrtf(skv * (1.0f / 256.0f) + EPS);
        if (lane == 0) RQ[m] = rq;
        float v[24]; unpack8(R.k0, v); unpack8(R.k1, v + 8); unpack4(R.kr0, v + 16); unpack4(R.kr1, v + 20);
#pragma unroll
        for (int i = 0; i < 16; ++i) v[i] *= rkv;
        float ss = 0.f;
#pragma unroll
        for (int i = 0; i < 24; ++i) ss += v[i] * v[i];
        ss += shx<1>(ss); ss += shx<2>(ss);
        const float r = 1.0f / sqrtf(ss * (1.0f / 96.0f) + EPS);
#pragma unroll
        for (int i = 0; i < 24; ++i) v[i] = v[i] * r * gk[i];
#pragma unroll
        for (int i = 0; i < 4; ++i) { const float x1 = v[16 + i], x2 = v[20 + i]; v[16 + i] = x1 * R.cs[i] - x2 * R.sn[i]; v[20 + i] = x1 * R.sn[i] + x2 * R.cs[i]; }
        const int key = lat ? 256 + t : t;
        bf16* d = MK + (((size_t)b * 16 + h) * NKEYS + key) * 96;
        { v4u* o = (v4u*)(d + 16 * p); o[0] = pack8(v); o[1] = pack8(v + 8); *(v2u*)(d + 64 + 4 * p) = pack4(v + 16); *(v2u*)(d + 80 + 4 * p) = pack4(v + 20); }
        float vv[16]; unpack8(R.v0, vv); unpack8(R.v1, vv + 8);
#pragma unroll
        for (int i = 0; i < 16; ++i) vv[i] *= rkv;
        v4u* vd = (v4u*)(MV + (((size_t)b * 16 + h) * NKEYS + key) * 64 + 16 * p);
        vd[0] = pack8(vv); vd[1] = pack8(vv + 8);
    }
}
struct DqRow { v4u q0, q1, k0, k1; f32x4 c0, c1, s0, s1; };
__device__ __forceinline__ void dq_load(DqRow& R, int m, const bf16* QKV, const float* cb, const float* sb, int u, int p) {
    const bf16* s = QKV + (size_t)m * 3072 + u * 64;
    R.q0 = *(const v4u*)(s + 8 * p); R.q1 = *(const v4u*)(s + 32 + 8 * p); R.k0 = *(const v4u*)(s + 1024 + 8 * p); R.k1 = *(const v4u*)(s + 1024 + 32 + 8 * p);
    if (m < NLAT) { const int t = m & 4095; R.c0 = *(const f32x4*)(cb + t * 32 + 8 * p); R.c1 = *(const f32x4*)(cb + t * 32 + 8 * p + 4); R.s0 = *(const f32x4*)(sb + t * 32 + 8 * p); R.s1 = *(const f32x4*)(sb + t * 32 + 8 * p + 4); }
    else { R.c0 = R.c1 = (f32x4){1.f, 1.f, 1.f, 1.f}; R.s0 = R.s1 = (f32x4){0.f, 0.f, 0.f, 0.f}; }
}
__device__ __forceinline__ void diff_finish_qk_phase(Frame& F, const InPtrs& A) {
    const int gw = F.vcu * NWAVES + F.wave, NGW = F.G * NWAVES, lane = F.lane, u = lane >> 2, p = lane & 3;
    const bf16* QKV = (const bf16*)(F.ws + R_QKV);
    bf16* DQ = (bf16*)(F.ws + R_DQ); bf16* DQC = (bf16*)(F.ws + R_DQC); bf16* DK = (bf16*)(F.ws + R_DK);
    const float* cb = (const float*)(F.ws + WS_ROPEB); const float* sb = cb + 4096 * 32;
    float gq[16], gk[16];
    { const float* qn = A[I_DF_QN]; const float* kn = A[I_DF_KN];
#pragma unroll
      for (int i = 0; i < 8; ++i) { gq[i] = qn[8 * p + i] * att::Sc<64>::C; gq[8 + i] = qn[32 + 8 * p + i] * att::Sc<64>::C; gk[i] = kn[8 * p + i]; gk[8 + i] = kn[32 + 8 * p + i]; } }
    DqRow N;
    if (gw < MROWS) dq_load(N, gw, QKV, cb, sb, u, p);
    for (int m = gw; m < MROWS; m += NGW) {
        const DqRow R = N;
        { const int mn = m + NGW; if (mn < MROWS) dq_load(N, mn, QKV, cb, sb, u, p); }
        const bool lat = m < NLAT; const int b = lat ? (m >> 12) : ((m - NLAT) >> 8), t = lat ? (m & 4095) : ((m - NLAT) & 255);
        float cs[8], sn[8];
#pragma unroll
        for (int i = 0; i < 4; ++i) { cs[i] = R.c0[i]; cs[4 + i] = R.c1[i]; sn[i] = R.s0[i]; sn[4 + i] = R.s1[i]; }
#pragma unroll
        for (int isk = 0; isk < 2; ++isk) {
            float v[16]; unpack8(isk ? R.k0 : R.q0, v); unpack8(isk ? R.k1 : R.q1, v + 8);
            float ss = 0.f;
#pragma unroll
            for (int i = 0; i < 16; ++i) ss += v[i] * v[i];
            ss += shx<1>(ss); ss += shx<2>(ss);
            const float r = 1.0f / sqrtf(ss * (1.0f / 64.0f) + EPS);
#pragma unroll
            for (int i = 0; i < 16; ++i) v[i] = v[i] * r * (isk ? gk[i] : gq[i]);
#pragma unroll
            for (int i = 0; i < 8; ++i) { const float x1 = v[i], x2 = v[8 + i]; v[i] = x1 * cs[i] - x2 * sn[i]; v[8 + i] = x1 * sn[i] + x2 * cs[i]; }
            bf16* d;
            if (isk) d = DK + (((size_t)b * 16 + u) * NKEYS + (lat ? 256 + t : t)) * 64;
            else d = lat ? DQ + (((size_t)b * 16 + u) * 4096 + t) * 64 : DQC + (((size_t)b * 16 + u) * 256 + t) * 64;
            *(v4u*)(d + 8 * p) = pack8(v); *(v4u*)(d + 32 + 8 * p) = pack8(v + 8);
        }
    }
}
__device__ __forceinline__ void diff_finish_o_phase(Frame& F, const InPtrs& A, float lam_init) {
    const int gw = F.vcu * NWAVES + F.wave, NGW = F.G * NWAVES, lane = F.lane, h = lane >> 3, p = lane & 7;
    const bf16* OB = (const bf16*)(F.ws + R_OB); bf16* AO = (bf16*)(F.ws + R_DAO);
    const float d1 = wave_sum(A[I_DF_LQ1][lane] * A[I_DF_LK1][lane]), d2 = wave_sum(A[I_DF_LQ2][lane] * A[I_DF_LK2][lane]);
    const float lam = expf(d1) - expf(d2) + lam_init, post = 1.0f - lam_init;
    float g[16];
    { const float* sg = A[I_DF_SUBG];
#pragma unroll
      for (int i = 0; i < 16; ++i) g[i] = sg[16 * p + i] * post; }
    v4u n0 = (v4u){0u, 0u, 0u, 0u}, n1 = n0, n2 = n0, n3 = n0;
    if (gw < MROWS) { const bf16* s0 = OB + (size_t)gw * 2048 + (2 * h) * 128 + 16 * p; n0 = ((const v4u*)s0)[0]; n1 = ((const v4u*)s0)[1]; n2 = ((const v4u*)(s0 + 128))[0]; n3 = ((const v4u*)(s0 + 128))[1]; }
    for (int m = gw; m < MROWS; m += NGW) {
        const v4u c0 = n0, c1 = n1, c2 = n2, c3 = n3;
        { const int mn = m + NGW; if (mn < MROWS) { const bf16* s0 = OB + (size_t)mn * 2048 + (2 * h) * 128 + 16 * p; n0 = ((const v4u*)s0)[0]; n1 = ((const v4u*)s0)[1]; n2 = ((const v4u*)(s0 + 128))[0]; n3 = ((const v4u*)(s0 + 128))[1]; } }
        float a[16], c[16];
        unpack8(c0, a); unpack8(c1, a + 8); unpack8(c2, c); unpack8(c3, c + 8);
        float ss = 0.f;
#pragma unroll
        for (int i = 0; i < 16; ++i) { a[i] = a[i] - lam * c[i]; ss += a[i] * a[i]; }
        ss += shx<1>(ss); ss += shx<2>(ss); ss += shx<4>(ss);
        const float r = 1.0f / sqrtf(ss * (1.0f / 128.0f) + EPS);
#pragma unroll
        for (int i = 0; i < 16; ++i) a[i] = a[i] * r * g[i];
        v4u* o = (v4u*)(AO + (size_t)m * 1024 + h * 128 + 16 * p); o[0] = pack8(a); o[1] = pack8(a + 8);
    }
}
__device__ __forceinline__ void sg_ln_item(Frame& F, const InPtrs& A, int chunk, int g_lo, int g_hi) {
    const bf16* Z = (const bf16*)(F.ws + R_Z); bf16* VNT = (bf16*)(F.ws + R_VNT);
    LAS float* st = (LAS float*)F.lds;
    LAS unsigned short* T = (LAS unsigned short*)(F.lds + 1024);
    constexpr int TS = 258;
    const int lane = F.lane, tid = F.tid;
    {
        const bf16* vr0 = Z + ((size_t)chunk * 128 + F.wave * 16) * 4096 + 2048;
        v4u nx[4];
#pragma unroll
        for (int i = 0; i < 4; ++i) nx[i] = *(const v4u*)(vr0 + 8 * (lane + 64 * i));
        for (int qi = 0; qi < 16; ++qi) {
            float x[32];
#pragma unroll
            for (int i = 0; i < 4; ++i) unpack8(nx[i], x + 8 * i);
            if (qi < 15) {
#pragma unroll
                for (int i = 0; i < 4; ++i) nx[i] = *(const v4u*)(vr0 + (size_t)(qi + 1) * 4096 + 8 * (lane + 64 * i)); }
            float s = 0.f;
#pragma unroll
            for (int i = 0; i < 32; ++i) s += x[i];
            const float mean = wave_sum(s) * (1.0f / 2048.0f); float s2 = 0.f;
#pragma unroll
            for (int i = 0; i < 32; ++i) { const float d = x[i] - mean; s2 += d * d; }
            const float rstd = 1.0f / sqrtf(wave_sum(s2) * (1.0f / 2048.0f) + EPS);
            const int q = F.wave * 16 + qi;
            if (lane == 0) { st[2 * q] = mean; st[2 * q + 1] = rstd; }
        }
    }
    __syncthreads();
    for (int g = g_lo; g < g_hi; ++g) {
        v4u xin[8];
#pragma unroll
        for (int i = 0; i < 8; ++i) { const int id = tid + 512 * i, q = id >> 5, c0 = (id & 31) * 8; xin[i] = *(const v4u*)(Z + ((size_t)chunk * 128 + q) * 4096 + 2048 + g * 256 + c0); }
#pragma unroll
        for (int i = 0; i < 8; ++i) { const int id = tid + 512 * i, q = id >> 5, c0 = (id & 31) * 8;
            float x[8]; unpack8(xin[i], x);
            const float mean = st[2 * q], rstd = st[2 * q + 1];
            const float* lg = A[I_SG_LNG] + g * 256 + c0; const float* lb = A[I_SG_LNB] + g * 256 + c0;
#pragma unroll
            for (int k = 0; k < 8; ++k) T[q * TS + c0 + k] = (unsigned short)f2bf((x[k] - mean) * rstd * lg[k] + lb[k]); }
        __syncthreads();
#pragma unroll
        for (int i = 0; i < 8; ++i) { const int id = tid + 512 * i, c = id >> 4, q0 = (id & 15) * 8;
            v4u w; w.x = (unsigned)T[(q0 + 0) * TS + c] | ((unsigned)T[(q0 + 1) * TS + c] << 16); w.y = (unsigned)T[(q0 + 2) * TS + c] | ((unsigned)T[(q0 + 3) * TS + c] << 16);
            w.z = (unsigned)T[(q0 + 4) * TS + c] | ((unsigned)T[(q0 + 5) * TS + c] << 16); w.w = (unsigned)T[(q0 + 6) * TS + c] | ((unsigned)T[(q0 + 7) * TS + c] << 16);
            *(v4u*)(VNT + (((size_t)chunk * 8 + g) * 256 + c) * 128 + q0) = w; }
        __syncthreads();
    }
}
__device__ __forceinline__ void sg_ln_phase(Frame& F, const InPtrs& A) {
    constexpr int NCH = MROWS / 128;
    const int full = (NCH / F.G) * F.G;
    for (int chunk = F.vcu; chunk < full; chunk += F.G) sg_ln_item(F, A, chunk, 0, 8);
    for (int it = F.vcu; it < (NCH - full) * 8; it += F.G) sg_ln_item(F, A, full + (it >> 3), it & 7, (it & 7) + 1);
}
__device__ __forceinline__ void topk_phase(Frame& F, int ngroups) {
    const float* AFF = (const float*)(F.ws + WS_AFF); int* SLOT = (int*)(F.ws + WS_SLOT); float* GATE = (float*)(F.ws + WS_GATE);
    int* ROWSRC = (int*)(F.ws + R_XG);
    LAS unsigned* cnt = (LAS unsigned*)F.lds;
    LAS unsigned* cgt = cnt + 16;
    LAS unsigned* ceq = cnt + 80;
    LAS unsigned* tot = cnt + 144;
    LAS int* selrow = (LAS int*)(cnt + 160);
    const int tid = F.tid, lane = F.lane, wave = F.wave;
    for (int task = blockIdx.x; task < ngroups; task += F.G) {
        const bool lat = task < 128; const int gi = lat ? task : task - 128, b = gi >> 4, e = gi & 15;
        const int N = lat ? 4096 : 256, K = lat ? CAP_LAT : CAP_CTX, row0 = lat ? b * 4096 : NLAT + b * 256;
        const int pbase = e * EROWS + (lat ? b * CAP_LAT : NB * CAP_LAT + b * CAP_CTX);
        unsigned key[8]; bool valid[8];
#pragma unroll
        for (int i = 0; i < 8; ++i) { const int t = tid + 512 * i; valid[i] = t < N; key[i] = valid[i] ? __float_as_uint(AFF[(size_t)(row0 + t) * 16 + e]) : 0u; }
        unsigned prefix = 0u;
        for (int bit = 30; bit >= 0; --bit) {
            const unsigned cand = prefix | (1u << bit); unsigned c = 0;
#pragma unroll
            for (int i = 0; i < 8; ++i) c += (unsigned)__builtin_popcountll(__ballot(valid[i] && key[i] >= cand));
            LAS unsigned* cb = cnt + 8 * (bit & 1);
            if (lane == 0) cb[wave] = c;
            __syncthreads();
            unsigned total = 0;
#pragma unroll
            for (int w = 0; w < 8; ++w) total += cb[w];
            if (total >= (unsigned)K) prefix = cand;
        }
        const unsigned T = prefix;
        unsigned long long bgt[8], beq[8];
#pragma unroll
        for (int i = 0; i < 8; ++i) { bgt[i] = __ballot(valid[i] && key[i] > T); beq[i] = __ballot(valid[i] && key[i] == T);
            if (lane == 0) { cgt[i * 8 + wave] = (unsigned)__builtin_popcountll(bgt[i]); ceq[i * 8 + wave] = (unsigned)__builtin_popcountll(beq[i]); } }
        __syncthreads();
        if (wave == 0) {
            unsigned pa = 0u, pq = 0u, ta = 0u, tq = 0u;
            for (int k = 0; k < 64; ++k) { const unsigned a = cgt[k], q = ceq[k]; ta += a; tq += q; if (k < lane) { pa += a; pq += q; } }
            LDS_WAIT();
            cgt[lane] = pa; ceq[lane] = pq;
            if (lane == 63) { tot[0] = ta; tot[1] = tq; }
        }
        __syncthreads();
        const unsigned n_gt = tot[0], need_eq = (unsigned)K - n_gt;
        const unsigned long long lmask = (1ull << lane) - 1ull;
#pragma unroll
        for (int i = 0; i < 8; ++i) {
            const bool isgt = (bgt[i] >> lane) & 1ull, iseq = (beq[i] >> lane) & 1ull;
            const unsigned pg = cgt[i * 8 + wave] + (unsigned)__builtin_popcountll(bgt[i] & lmask), pe = ceq[i * 8 + wave] + (unsigned)__builtin_popcountll(beq[i] & lmask);
            const bool sel = isgt || (iseq && pe < need_eq);
            if (sel) { const unsigned pos = isgt ? pg : n_gt + pe; const int row = row0 + tid + 512 * i;
                SLOT[(size_t)row * 16 + e] = pbase + (int)pos; GATE[pbase + pos] = __uint_as_float(key[i]); ROWSRC[pbase + pos] = row; }
        }
        __syncthreads();
        __syncthreads();
    }
}

template <int DK> __device__ __forceinline__ float att_bound(const float* gq, const float* gk, int n, int lane) {
    float mq = 0.f, mk = 0.f;
    for (int i = lane; i < n; i += 64) { mq = fmaxf(mq, fabsf(gq[i])); mk = fmaxf(mk, fabsf(gk[i])); }
    mq = fmaxf(mq, shx<1>(mq)); mq = fmaxf(mq, shx<2>(mq)); mq = fmaxf(mq, shx<4>(mq)); mq = fmaxf(mq, shx<8>(mq)); mq = fmaxf(mq, shx<16>(mq));
    mk = fmaxf(mk, shx<1>(mk)); mk = fmaxf(mk, shx<2>(mk)); mk = fmaxf(mk, shx<4>(mk)); mk = fmaxf(mk, shx<8>(mk)); mk = fmaxf(mk, shx<16>(mk));
    mq = fmaxf(__builtin_bit_cast(float, __builtin_amdgcn_readlane(__builtin_bit_cast(int, mq), 0)), __builtin_bit_cast(float, __builtin_amdgcn_readlane(__builtin_bit_cast(int, mq), 32)));
    mk = fmaxf(__builtin_bit_cast(float, __builtin_amdgcn_readlane(__builtin_bit_cast(int, mk), 0)), __builtin_bit_cast(float, __builtin_amdgcn_readlane(__builtin_bit_cast(int, mk), 32)));
    const float bound = sqrtf((float)DK) * mq * mk;
    return __builtin_bit_cast(float, __builtin_amdgcn_readfirstlane(__builtin_bit_cast(int, bound)));
}
__device__ __forceinline__ void mla_attn_phase(Frame& F, const InPtrs& A, int jl, bool do_ctx, int conv_layer) {
    int cround = 0;
    const bf16* QPRE = (const bf16*)(F.ws + R_QPRE); const float* RQ = (const float*)(F.ws + WS_RQ); const bf16* MK = (const bf16*)(F.ws + R_MK); const bf16* MV = (const bf16*)(F.ws + R_MV);
    bf16* AO = (bf16*)(F.ws + R_AO);
    const float* gq = A[I_MLA_QN] + jl * 96; const float* ropeA = (const float*)(F.ws + WS_ROPEA);
    const float bound = att_bound<96>(gq, A[I_MLA_KN] + jl * 96, 96, F.lane), negMC = -fminf(bound, 30.0f) * 1.4426950408889634f;
    const bool use_off = bound > 60.0f;
    const int nunits = 2048 + (do_ctx ? 128 : 0);
    for (int u = F.vcu; u < nunits; u += F.G) {
        const bool lat = u < 2048; const int bh = lat ? (u >> 4) : (u - 2048), qb = lat ? (u & 15) : 0, b = bh >> 4, h = bh & 15;
        const int row0 = lat ? b * 4096 + qb * 256 : NLAT + b * 256;
        const att::QLoadMLA QL{QPRE + (size_t)row0 * 1536 + h * 96, RQ + row0, gq, lat ? ropeA + (size_t)(qb * 256) * 16 : nullptr};
        const bf16* Kp = MK + (size_t)bh * NKEYS * 96; const bf16* Vp = MV + (size_t)bh * NKEYS * 64;
        const att::OEpiGlobal<2> OE{AO + (size_t)row0 * 1024 + h * 64, 1024};
        if (!use_off) att::body<96, 64, 2, false>(QL, OE, Kp, Kp + 256 * 96, 96, Vp, Vp + 256 * 64, 64, lat ? NKEYS : 256, 0.f, (char*)F.lds, F.tid);
        else att::body<96, 64, 2, true>(QL, OE, Kp, Kp + 256 * 96, 96, Vp, Vp + 256 * 64, 64, lat ? NKEYS : 256, negMC, (char*)F.lds, F.tid);
        if (conv_layer >= 0 && cround < conv_rounds(F)) { moe_weight_round(F, A, conv_layer, cround); ++cround; }
    }
    if (conv_layer >= 0) for (; cround < conv_rounds(F); ++cround) moe_weight_round(F, A, conv_layer, cround);
}
template <bool OFF>
__device__ __forceinline__ void diff_attn_units(Frame& F, const InPtrs& A, bool do_ctx, int conv_layer, float lam_init, float lam, float negMC) {
    int cround = 0;
    const bf16* DQ = (const bf16*)(F.ws + R_DQ); const bf16* DQC = (const bf16*)(F.ws + R_DQC); const bf16* DKp = (const bf16*)(F.ws + R_DK); const bf16* QKV = (const bf16*)(F.ws + R_QKV);
    bf16* AO = (bf16*)(F.ws + R_DAO);
    unsigned short* stash = (unsigned short*)((char*)F.lds + DIFF_STASH_OFF);
    const int nunits = 1024 + (do_ctx ? 64 : 0);
    for (int u = F.vcu; u < nunits; u += F.G) {
        const bool lat = u < 1024; const int bh = lat ? (u >> 4) : (u - 1024), qb = lat ? (u & 15) : 0, b = bh >> 3, h = bh & 7;
        const int row0 = lat ? b * 4096 + qb * 256 : NLAT + b * 256;
        const bf16* V0 = QKV + (size_t)(NLAT + b * 256) * 3072 + 2048 + h * 128; const bf16* V1 = QKV + (size_t)(b * 4096) * 3072 + 2048 + h * 128;
        { const int bvh = b * 16 + 2 * h;
          const bf16* Qp = lat ? DQ + ((size_t)bvh * 4096 + qb * 256) * 64 : DQC + (size_t)bvh * 256 * 64; const bf16* Kp = DKp + (size_t)bvh * NKEYS * 64;
          const att::QLoadPlain QL{Qp, 64}; const att::OEpiStash OE{stash};
          att::body<64, 128, 1, OFF>(QL, OE, Kp, Kp + 256 * 64, 64, V0, V1, 3072, lat ? NKEYS : 256, negMC, (char*)F.lds, F.wave * 64 + hw_lane()); }
        { const int bvh = b * 16 + 2 * h + 1;
          const bf16* Qp = lat ? DQ + ((size_t)bvh * 4096 + qb * 256) * 64 : DQC + (size_t)bvh * 256 * 64; const bf16* Kp = DKp + (size_t)bvh * NKEYS * 64;
          const att::QLoadPlain QL{Qp, 64}; const att::OEpiDiffFinal OE{stash, AO + (size_t)row0 * 1024 + h * 128, 1024, lam, A[I_DF_SUBG], 1.0f - lam_init};
          att::body<64, 128, 1, OFF>(QL, OE, Kp, Kp + 256 * 64, 64, V0, V1, 3072, lat ? NKEYS : 256, negMC, (char*)F.lds, F.wave * 64 + hw_lane()); }
        if (conv_layer >= 0 && cround < conv_rounds(F)) { moe_weight_round(F, A, conv_layer, cround); ++cround; }
    }
    if (conv_layer >= 0) for (; cround < conv_rounds(F); ++cround) moe_weight_round(F, A, conv_layer, cround);
}
__device__ __forceinline__ void diff_attn_phase(Frame& F, const InPtrs& A, bool do_ctx, int conv_layer, float lam_init) {
    const float bound = att_bound<64>(A[I_DF_QN], A[I_DF_KN], 64, F.lane);
    const float d1 = wave_sum(A[I_DF_LQ1][F.lane] * A[I_DF_LK1][F.lane]), d2 = wave_sum(A[I_DF_LQ2][F.lane] * A[I_DF_LK2][F.lane]);
    const float lam = expf(d1) - expf(d2) + lam_init;
    if (bound <= 60.0f) diff_attn_units<false>(F, A, do_ctx, conv_layer, lam_init, lam, 0.f);
    else diff_attn_units<true>(F, A, do_ctx, conv_layer, lam_init, lam, -fminf(bound, 30.0f) * 1.4426950408889634f);
}

#ifndef PG8_SP2
#define PG8_SP2 true
#endif
#ifndef PG8_ALIGN
#define PG8_ALIGN true
#endif
#define GEMM_CALL(EPI, ORD, g, S, E) pg8::gemm_phase<EPI, ORD, PG8_ALIGN, PG8_SP2>(F.lds, g, S, E, F.tid)

__global__ void __launch_bounds__(NTHREADS, 2) fwd_kernel(Args args) {
    extern __shared__ __attribute__((aligned(16))) unsigned char lds[];
    Frame FM;
    FM.lds = (LAS unsigned char*)lds;
    FM.tid = threadIdx.x; FM.lane = FM.tid & 63; FM.wave = __builtin_amdgcn_readfirstlane(FM.tid >> 6);
    FM.G = gridDim.x; { const int bx = blockIdx.x; FM.vcu = (FM.G % 8 == 0) ? (bx % 8) * (FM.G / 8) + bx / 8 : bx; }
    FM.ws = args.ws; FM.out = args.out;
    volatile LAS unsigned* MISC = (volatile LAS unsigned*)(FM.lds + MISC_OFF);
    if (FM.tid < 16) MISC[FM.tid] = 0u;
    if (FM.tid < 35) { const unsigned long long p = (unsigned long long)args.in[FM.tid]; MISC[16 + 2 * FM.tid] = (unsigned)p; MISC[17 + 2 * FM.tid] = (unsigned)(p >> 32); }
    __syncthreads();
    InPtrs A; A.tab = MISC + 16;
    XcdBarrier bar = xcd_barrier_post((unsigned*)(FM.ws + WS_CTL) + 4096, MISC + 8); bar.wave = FM.wave;
    const int lo = args.ph_lo, hi = args.ph_hi;
    int ph = 0;
#ifndef PHASE_MASK
#define PHASE_MASK 0xFFFFFFFFu
#endif
#define EN(b) ((PHASE_MASK >> (b)) & 1u)
#ifndef REP_MASK
#define REP_MASK 0u
#endif
#ifndef BAR_REP
#define BAR_REP 1
#endif
#define REPN(b) (((REP_MASK >> (b)) & 1u) ? 2 : 1)
#define PH_BEGIN if (ph >= lo && ph < hi) { Frame F = FM; { int t_ = FM.wave * 64 + hw_lane(); asm volatile("" : "+v"(t_)); F.tid = t_; F.lane = t_ & 63; F.wave = __builtin_amdgcn_readfirstlane(t_ >> 6); \
        size_t z_ = 0; asm volatile("" : "+s"(z_), "+s"(F.vcu), "+s"(F.G)); F.ws = FM.ws + z_; F.out = FM.out + z_; } \
        const float* MOD = (const float*)(F.ws + WS_MOD); bf16* H = (bf16*)(F.ws + WS_H); (void)MOD; (void)H;
#define PH_END   if (ph + 1 < hi) { for (int br_ = 0; br_ < BAR_REP; ++br_) xcd_barrier(bar); } } ++ph;

    PH_BEGIN for (int rep_ = 0; rep_ < REPN(0); ++rep_) if (EN(0)) p0_prologue(F, A); PH_END

    for (int layer = 0; layer < DEPTH; ++layer) {
        const int kind = layer % 3, jl = layer / 3;
        const bool last = layer == DEPTH - 1, ctx_out = !last;
        const int rows_out = ctx_out ? MROWS : NLAT;

        PH_BEGIN for (int rep_ = 0; rep_ < REPN(1); ++rep_) if (EN(1)) { if (layer == 0 && rep_ == 0) norm_phase<false, true>(F, A, layer, false, MROWS); else norm_phase<false, false>(F, A, layer, layer > 0, MROWS, rep_ == 0 ? 1.0f : 0.0f); } PH_END

        if (kind == 0) {
            const size_t wboff = WS_WNM + jl * MLA_W_STRIDE;
#define wb (F.ws + wboff)
            PH_BEGIN for (int rep_ = 0; rep_ < REPN(2); ++rep_) if (EN(2)) { pg8::Gemm g{H, (const bf16*)(wb + MLA_WIN), MROWS, 1024, 1024}; pg8::StaticOrder S; S.init(MROWS, 1024, F.G, (int)blockIdx.x);
                pg8::EpiStore<0> E{(bf16*)(F.ws + R_DOWN), 1024}; GEMM_CALL(pg8::EpiStore<0>, pg8::StaticOrder, g, S, E); } PH_END
            PH_BEGIN for (int rep_ = 0; rep_ < REPN(2); ++rep_) if (EN(2)) { { pg8::Gemm g{(const bf16*)(F.ws + R_DOWN), (const bf16*)(wb + MLA_WUQ), rows_out, 1536, 512, 1024}; pg8::StaticOrder S; S.init(rows_out, 1536, F.G, (int)blockIdx.x);
                         pg8::EpiStore<0> E{(bf16*)(F.ws + R_QPRE), 1536}; GEMM_CALL(pg8::EpiStore<0>, pg8::StaticOrder, g, S, E); }
                       __syncthreads();
                       { pg8::Gemm g{(const bf16*)(F.ws + R_DOWN) + 512, (const bf16*)(wb + MLA_WUKV), MROWS, 2048, 256, 1024}; pg8::StaticOrder S; S.init(MROWS, 2048, F.G, (int)blockIdx.x);
                         pg8::EpiStore<0> E{(bf16*)(F.ws + R_KVPRE), 2048}; GEMM_CALL(pg8::EpiStore<0>, pg8::StaticOrder, g, S, E); } } PH_END
            PH_BEGIN for (int rep_ = 0; rep_ < REPN(3); ++rep_) if (EN(3)) mla_finish_phase(F, A, jl); PH_END
            PH_BEGIN for (int rep_ = 0; rep_ < REPN(4); ++rep_) if (EN(4)) mla_attn_phase(F, A, jl, ctx_out, (EN(15) && rep_ == 0) ? layer : -1); PH_END
            PH_BEGIN for (int rep_ = 0; rep_ < REPN(14); ++rep_) if (EN(14)) { pg8::Gemm g{(const bf16*)(F.ws + R_AO), (const bf16*)(wb + MLA_WOUT), rows_out, 1024, 1024}; pg8::StaticOrder S; S.init(rows_out, 1024, F.G, (int)blockIdx.x);
                pg8::EpiResid E{(bf16*)(F.ws + WS_XB), MOD + (size_t)layer * 9 * 6144 + 2048, rep_ == 0 ? 1.0f : 0.0f}; GEMM_CALL(pg8::EpiResid, pg8::StaticOrder, g, S, E); } PH_END
#undef wb
        } else if (kind == 1) {
            PH_BEGIN for (int rep_ = 0; rep_ < REPN(12); ++rep_) if (EN(12)) { pg8::Gemm g{H, (const bf16*)(F.ws + WS_DIFF_WIN), MROWS, 3072, 1024}; pg8::StaticOrder S; S.init(MROWS, 3072, F.G, (int)blockIdx.x);
                pg8::EpiStore<0> E{(bf16*)(F.ws + R_QKV), 3072}; GEMM_CALL(pg8::EpiStore<0>, pg8::StaticOrder, g, S, E); } PH_END
            PH_BEGIN for (int rep_ = 0; rep_ < REPN(5); ++rep_) if (EN(5)) diff_finish_qk_phase(F, A); PH_END
            PH_BEGIN for (int rep_ = 0; rep_ < REPN(6); ++rep_) if (EN(6)) diff_attn_phase(F, A, ctx_out, (EN(15) && rep_ == 0) ? layer : -1, 0.8f - 0.6f * expf(-0.3f * (float)layer)); PH_END
            PH_BEGIN for (int rep_ = 0; rep_ < REPN(14); ++rep_) if (EN(14)) { pg8::Gemm g{(const bf16*)(F.ws + R_DAO), (const bf16*)(F.ws + WS_DIFF_WOUT), rows_out, 1024, 1024}; pg8::StaticOrder S; S.init(rows_out, 1024, F.G, (int)blockIdx.x);
                pg8::EpiResid E{(bf16*)(F.ws + WS_XB), MOD + (size_t)layer * 9 * 6144 + 2048, rep_ == 0 ? 1.0f : 0.0f}; GEMM_CALL(pg8::EpiResid, pg8::StaticOrder, g, S, E); } PH_END
        } else {
            PH_BEGIN for (int rep_ = 0; rep_ < REPN(13); ++rep_) if (EN(13)) { pg8::Gemm g{H, (const bf16*)(F.ws + WS_SG_WIN), MROWS, 4096, 1024}; pg8::StaticOrder S; S.init(MROWS, 4096, F.G, (int)blockIdx.x);
                pg8::EpiStore<1> E{(bf16*)(F.ws + R_Z), 4096}; GEMM_CALL(pg8::EpiStore<1>, pg8::StaticOrder, g, S, E); } PH_END
            PH_BEGIN for (int rep_ = 0; rep_ < REPN(7); ++rep_) if (EN(7)) sg_ln_phase(F, A); PH_END
            PH_BEGIN for (int rep_ = 0; rep_ < REPN(13); ++rep_) if (EN(13)) { pg8::Gemm g{(const bf16*)(F.ws + WS_SG_WS), (const bf16*)(F.ws + R_VNT), 2048, 0, 128}; pg8::SpatialOrder S; S.init((MROWS / 128) * 8, F.G, F.vcu);
                pg8::EpiSpatial E{(bf16*)(F.ws + R_UV), (const bf16*)(F.ws + R_Z), A[I_SG_BS]}; GEMM_CALL(pg8::EpiSpatial, pg8::SpatialOrder, g, S, E); } PH_END
            PH_BEGIN for (int rep_ = 0; rep_ < REPN(14); ++rep_) if (EN(14)) { pg8::Gemm g{(const bf16*)(F.ws + R_UV), (const bf16*)(F.ws + WS_SG_WOUT), rows_out, 1024, 2048}; pg8::StaticOrder S; S.init(rows_out, 1024, F.G, (int)blockIdx.x);
                pg8::EpiResid E{(bf16*)(F.ws + WS_XB), MOD + (size_t)layer * 9 * 6144 + 2048, rep_ == 0 ? 1.0f : 0.0f}; GEMM_CALL(pg8::EpiResid, pg8::StaticOrder, g, S, E); } PH_END
        }

        PH_BEGIN { for (int rep_ = 0; rep_ < REPN(8); ++rep_) if (EN(8)) { norm_phase<true, false>(F, A, layer, false, rows_out); __syncthreads(); } for (int rep_ = 0; rep_ < REPN(15); ++rep_) if (EN(15) && kind == 2) { moe_weight_items(F, A, layer); __syncthreads(); } } PH_END
        PH_BEGIN for (int rep_ = 0; rep_ < REPN(9); ++rep_) if (EN(9)) topk_phase(F, ctx_out ? 256 : 128); PH_END
        PH_BEGIN for (int rep_ = 0; rep_ < REPN(10); ++rep_) if (EN(10)) { pg8::Gemm g{H, (const bf16*)(F.ws + WS_WGU), MOE_ROWS, 0, 1024}; pg8::MoeOrder S; S.init(ctx_out ? 17 : 16, 8, F.G, F.vcu);
            pg8::EpiSwiGLU E{(bf16*)(F.ws + R_HID), 8}; pg8::gemm_phase<pg8::EpiSwiGLU, pg8::MoeOrder, PG8_ALIGN, PG8_SP2, true>(F.lds, g, S, E, F.tid, (const int*)(F.ws + R_XG), (LAS int*)(F.lds + RING_BYTES)); } PH_END
        PH_BEGIN for (int rep_ = 0; rep_ < REPN(10); ++rep_) if (EN(10)) { pg8::Gemm g{(const bf16*)(F.ws + R_HID), (const bf16*)(F.ws + WS_WDN), MOE_ROWS, 0, 1024}; pg8::MoeOrder S; S.init(ctx_out ? 17 : 16, 4, F.G, F.vcu);
            pg8::EpiMoeDown E{(bf16*)(F.ws + R_YB), (const float*)(F.ws + WS_GATE)}; GEMM_CALL(pg8::EpiMoeDown, pg8::MoeOrder, g, S, E); } PH_END
    }
    PH_BEGIN for (int rep_ = 0; rep_ < REPN(11); ++rep_) if (EN(11)) final_phase(F, DEPTH - 1); PH_END
#undef PH_BEGIN
#undef PH_END
}
constexpr int N_PHASES = 1 + (1 + 5 + 4) + (1 + 4 + 4) + (1 + 4 + 4) + (1 + 5 + 4) + 1;

extern "C" void kernel_launch(void* const* d_in, const int* in_sizes, int n_in, void* d_out, int out_size, void* d_ws, size_t ws_size, hipStream_t stream) {
    static int grid = 0;
    if (grid == 0) {
        if (n_in != 35 || in_sizes[0] != NLAT * D || out_size != NLAT * D || ws_size < WS_END) {
            fprintf(stderr, "kernel_launch: unexpected shapes: n_in %d in0 %d out %d ws %zu (need >= %zu); nothing launched\n", n_in, n_in > 0 ? in_sizes[0] : -1, out_size, ws_size, (size_t)WS_END); grid = -1; return; }
        int dev = 0, cus = 0, per_cu = 0;
        if (hipGetDevice(&dev) != hipSuccess || hipDeviceGetAttribute(&cus, hipDeviceAttributeMultiprocessorCount, dev) != hipSuccess) { fprintf(stderr, "kernel_launch: device query failed\n"); grid = -1; return; }
        if (hipFuncSetAttribute((const void*)fwd_kernel, hipFuncAttributeMaxDynamicSharedMemorySize, LDS_BYTES) != hipSuccess) { fprintf(stderr, "kernel_launch: hipFuncSetAttribute failed\n"); grid = -1; return; }
        if (hipOccupancyMaxActiveBlocksPerMultiprocessor(&per_cu, (const void*)fwd_kernel, NTHREADS, LDS_BYTES) != hipSuccess || per_cu < 1)
            fprintf(stderr, "kernel_launch: note: occupancy query reports %d workgroups per CU\n", per_cu);
        (void)hipGetLastError();
        grid = cus;
    }
    if (grid < 0) return;
    if (hipMemsetAsync((char*)d_ws + WS_CTL, 0, CTL_ZERO_BYTES, stream) != hipSuccess) { fprintf(stderr, "kernel_launch: memset failed\n"); return; }
    Args a{};
    for (int i = 0; i < 35; ++i) a.in[i] = (const float*)d_in[i];
    a.out = (float*)d_out; a.ws = (unsigned char*)d_ws;
#if MK_PER_PHASE
    for (int p = 0; p < N_PHASES; ++p) { a.ph_lo = p; a.ph_hi = p + 1; hipLaunchKernelGGL(fwd_kernel, dim3(grid), dim3(NTHREADS), LDS_BYTES, stream, a); }
#else
    a.ph_lo = 0; a.ph_hi = N_PHASES;
    hipLaunchKernelGGL(fwd_kernel, dim3(grid), dim3(NTHREADS), LDS_BYTES, stream, a);
#endif
    const hipError_t le = hipPeekAtLastError();
    if (le != hipSuccess) fprintf(stderr, "kernel_launch: launch failed: %s\n", hipGetErrorName(le));
}
```

```cpp
#include <hip/hip_runtime.h>
#include <cstdio>
#include <cstdint>

#ifndef MK_PER_PHASE
#define MK_PER_PHASE 0
#endif

constexpr int D = 1024, NB = 8, SEQ = 4096, CTXL = 256, NLAT = NB * SEQ, NCTX = NB * CTXL, MROWS = NLAT + NCTX;
constexpr int NKEYS = CTXL + SEQ;
constexpr int NE = 16, CAP_LAT = 512, CAP_CTX = 32, EROWS = NB * CAP_LAT + NB * CAP_CTX, MOE_ROWS = NE * EROWS;
constexpr int DEPTH = 4;
constexpr float EPS = 1e-6f;
constexpr int NWAVES = 8, NTHREADS = 512;

constexpr size_t MiB = 1u << 20;
constexpr size_t WS_CTL = 0, CTL_ZERO_BYTES = 1 * MiB;
constexpr size_t WS_MOD = 1 * MiB;
constexpr size_t WS_ROPEA = 2 * MiB;
constexpr size_t WS_ROPEB = 2 * MiB + 512 * 1024;
constexpr size_t WS_WNM = 4 * MiB;
constexpr size_t MLA_W_STRIDE = 7 * MiB, MLA_WIN = 0, MLA_WUQ = 2 * MiB, MLA_WUKV = 3 * MiB + 512 * 1024, MLA_WOUT = 4 * MiB + 512 * 1024;
constexpr size_t WS_DIFF_WIN = 18 * MiB, WS_DIFF_WOUT = 24 * MiB;
constexpr size_t WS_SG_WIN = 26 * MiB, WS_SG_WOUT = 34 * MiB, WS_SG_WS = 38 * MiB;
constexpr size_t WS_WGU = 40 * MiB, WS_WDN = 104 * MiB;
constexpr size_t WS_XCTX = 136 * MiB;
constexpr size_t WS_H = 144 * MiB;
constexpr size_t WS_AFF = 212 * MiB;
constexpr size_t WS_SLOT = 215 * MiB;
constexpr size_t WS_GATE = 218 * MiB;
constexpr size_t WS_RQ = 219 * MiB;
constexpr size_t WS_R = 220 * MiB;
constexpr size_t WS_XB = WS_R + 640 * MiB;
constexpr size_t WS_END = WS_XB + 68 * MiB;
constexpr size_t R_DOWN = WS_R, R_CQN = WS_R + 68 * MiB, R_CKVN = WS_R + 102 * MiB, R_QPRE = WS_R + 120 * MiB, R_KVPRE = WS_R + 222 * MiB;
constexpr size_t R_MQ = WS_R + 358 * MiB, R_MQC = WS_R + 454 * MiB, R_MK = WS_R + 460 * MiB, R_MV = WS_R + 562 * MiB, R_AO = WS_R;
constexpr size_t R_QKV = WS_R, R_DQ = WS_R + 204 * MiB, R_DQC = WS_R + 268 * MiB, R_DK = WS_R + 272 * MiB, R_OB = WS_R + 340 * MiB, R_DAO = WS_R + 476 * MiB;
constexpr size_t R_Z = WS_R, R_VNT = WS_R + 272 * MiB, R_UV = WS_R + 408 * MiB;
constexpr size_t R_XG = WS_R, R_HID = WS_R + 136 * MiB, R_YB = WS_R + 272 * MiB;

constexpr int RING_BYTES = 131072;
constexpr int LDS_BYTES = 147456;
constexpr int MISC_OFF = LDS_BYTES - 512;

#define GAS __attribute__((address_space(1)))
#define LAS __attribute__((address_space(3)))
typedef unsigned short bf16;
typedef unsigned v4u __attribute__((ext_vector_type(4)));
typedef unsigned v2u __attribute__((ext_vector_type(2)));
typedef float f32x4 __attribute__((ext_vector_type(4)));
typedef float f32x2 __attribute__((ext_vector_type(2)));
typedef GAS unsigned gu32;
#define RLX_AGENT __ATOMIC_RELAXED, __HIP_MEMORY_SCOPE_AGENT
#define LDS_WAIT() asm volatile("s_waitcnt lgkmcnt(0)" ::: "memory")
#define VM_WAIT() asm volatile("s_waitcnt vmcnt(0)" ::: "memory")
__device__ __forceinline__ unsigned f2bf(float f) { unsigned u = __builtin_bit_cast(unsigned, f); return (u + 0x7fffu + ((u >> 16) & 1u)) >> 16; }
__device__ __forceinline__ unsigned pk2(float lo, float hi) { return f2bf(lo) | (f2bf(hi) << 16); }
__device__ __forceinline__ float bflo(unsigned w) { return __builtin_bit_cast(float, w << 16); }
__device__ __forceinline__ float bfhi(unsigned w) { return __builtin_bit_cast(float, w & 0xffff0000u); }
template <int M> __device__ __forceinline__ float shx(float v) {
    static_assert(M == 1 || M == 2 || M == 4 || M == 8 || M == 16, "shx: xor mask inside a 32-lane group");
    return __builtin_bit_cast(float, __builtin_amdgcn_ds_swizzle(__builtin_bit_cast(int, v), (M << 10) | 0x1f));
}
__device__ __forceinline__ float wave_sum(float v) {
    v += shx<1>(v); v += shx<2>(v); v += shx<4>(v); v += shx<8>(v); v += shx<16>(v);
    const unsigned a = __builtin_bit_cast(unsigned, v);
    const auto rr = __builtin_amdgcn_permlane32_swap(a, a, false, false);
    const unsigned r0 = rr[0], r1 = rr[1];
    return __uint_as_float(r0) + __uint_as_float(r1);
}
__device__ __forceinline__ int hw_lane() { int l; asm volatile("v_mbcnt_lo_u32_b32 %0, -1, 0\n\tv_mbcnt_hi_u32_b32 %0, -1, %0" : "=v"(l)); return l; }
__device__ __forceinline__ float fast_rcp(float x) { return __builtin_amdgcn_rcpf(x); }
__device__ __forceinline__ float silu_f(float x) { return x * fast_rcp(1.0f + __builtin_amdgcn_exp2f(-1.4426950408889634f * x)); }
__device__ __forceinline__ float gelu_tanh_f(float x) { const float u2 = 1.5957691216057308f * (x + 0.044715f * x * x * x); return x * fast_rcp(1.0f + __builtin_amdgcn_exp2f(-1.4426950408889634f * u2)); }

namespace pg8 {
#define PG8_LAS __attribute__((address_space(3)))
typedef unsigned short bf16_t;
typedef short bf16x8 __attribute__((ext_vector_type(8)));
typedef float f32x4 __attribute__((ext_vector_type(4)));
typedef unsigned u32x4 __attribute__((ext_vector_type(4)));
constexpr int BM = 256, BK = 64, HALF = 128, HTB = HALF * BK * 2  , STAGE_BYTES = 8 * HTB, NXCD = 8, WGM = 8;

__host__ __device__ __forceinline__ int lds_byte(int r, int c) { const int st = (r >> 4) * 2 + (c >> 5), rr = r & 15, cc = c & 31, ob = rr * 64 + cc * 2; return st * 1024 + (ob ^ (((ob >> 9) & 1) << 5)); }
__host__ __device__ __forceinline__ void stage_rc(int b, int& R, int& C) { const int st = b / 1024, sb = b % 1024, swz = sb ^ (((sb >> 9) & 1) << 5); R = (st >> 1) * 16 + swz / 64; C = (st & 1) * 32 + (swz % 64) / 2; }
__host__ __device__ __forceinline__ int perm32(int rho) { const int n = rho >> 4, i = rho & 15; return 8 * (i >> 2) + 4 * n + (i & 3); }

struct Unit { int pm, pn; };
struct Gemm { const bf16_t* A; const bf16_t* Bt; int M, N, K; int lda = 0; };

struct StaticOrder {
    int nM, nN, nwg, G, c;
    __host__ __device__ void init(int M, int N, int G_, int c_) { nM = M / BM; nN = N / BM; nwg = nM * nN; G = G_; c = c_; }
    __host__ __device__ bool next(int i, Unit& u) const {
        const long L = (long)i * G + c; if (L >= nwg) return false;
        int wgid = (int)L; { const int q = nwg / NXCD, r = nwg % NXCD, xcd = wgid % NXCD, off = wgid / NXCD; wgid = (xcd < r ? xcd * (q + 1) : r * (q + 1) + (xcd - r) * q) + off; }
        const int nig = WGM * nN, gid = wgid / nig, fm = gid * WGM, gsz = (nM - fm) < WGM ? (nM - fm) : WGM;
        u.pm = fm + ((wgid % nig) % gsz); u.pn = (wgid % nig) / gsz; return true;
    }
    __device__ __forceinline__ void a_ready(const Unit&) const {}
    __device__ __forceinline__ void done(const Unit&) const {}
};

__device__ __forceinline__ unsigned cvt_pk_bf16(float lo, float hi) { unsigned r; asm volatile("v_cvt_pk_bf16_f32 %0, %1, %2" : "=v"(r) : "v"(lo), "v"(hi)); return r; }
typedef float f32x2 __attribute__((ext_vector_type(2)));

template <int ACT> struct EpiStore {
    static constexpr bool PERM = true, AFTER_DRAIN = false;
    bf16_t* O; int ldc;
    __device__ __forceinline__ void operator()(const f32x4 (&acc)[2][2][4][2], const Unit& u, int wr, int wc, int fr, int fq) const {
        const int row0 = u.pm * BM + wr * 64 + fr, col0 = u.pn * BM + wc * 32 + 8 * fq;
#pragma unroll
        for (int ai = 0; ai < 2; ++ai)
#pragma unroll
            for (int m = 0; m < 4; ++m) { bf16_t* rowp = O + (size_t)(row0 + ai * HALF + m * 16) * ldc + col0;
#pragma unroll
                for (int bj = 0; bj < 2; ++bj) { f32x4 v0 = acc[ai][bj][m][0], v1 = acc[ai][bj][m][1];
                    if (ACT == 1) {
#pragma unroll
                        for (int i = 0; i < 4; ++i) { v0[i] = gelu_tanh_f(v0[i]); v1[i] = gelu_tanh_f(v1[i]); } }
                    u32x4 w; w.x = cvt_pk_bf16(v0[0], v0[1]); w.y = cvt_pk_bf16(v0[2], v0[3]); w.z = cvt_pk_bf16(v1[0], v1[1]); w.w = cvt_pk_bf16(v1[2], v1[3]);
                    *(u32x4*)(rowp + bj * HALF) = w; } }
    }
};
struct EpiResid {
    static constexpr bool PERM = true, AFTER_DRAIN = false;
    bf16_t* xb; const float* gmod; float mul;
    __device__ __forceinline__ void operator()(const f32x4 (&acc)[2][2][4][2], const Unit& u, int wr, int wc, int fr, int fq) const {
        const int rr = u.pm < 128 ? (u.pm >> 4) : 8;
        bf16_t* xbase = xb + (size_t)u.pm * BM * 1024;
        const int col0 = u.pn * BM + wc * 32 + 8 * fq;
        f32x4 gv[2][2];
#pragma unroll
        for (int bj = 0; bj < 2; ++bj)
#pragma unroll
            for (int n = 0; n < 2; ++n) gv[bj][n] = *(const f32x4*)(gmod + rr * 6144 + col0 + bj * HALF + 4 * n) * mul;
#pragma unroll
        for (int ai = 0; ai < 2; ++ai)
#pragma unroll
            for (int m = 0; m < 4; ++m) { bf16_t* rowp = xbase + (size_t)(ai * HALF + wr * 64 + m * 16 + fr) * 1024 + col0;
#pragma unroll
                for (int bj = 0; bj < 2; ++bj) { u32x4* p = (u32x4*)(rowp + bj * HALF); const u32x4 w = *p;
                    const f32x4 x0 = (f32x4){__builtin_bit_cast(float, w.x << 16), __builtin_bit_cast(float, w.x & 0xffff0000u), __builtin_bit_cast(float, w.y << 16), __builtin_bit_cast(float, w.y & 0xffff0000u)};
                    const f32x4 x1 = (f32x4){__builtin_bit_cast(float, w.z << 16), __builtin_bit_cast(float, w.z & 0xffff0000u), __builtin_bit_cast(float, w.w << 16), __builtin_bit_cast(float, w.w & 0xffff0000u)};
                    const f32x4 o0 = x0 + gv[bj][0] * acc[ai][bj][m][0], o1 = x1 + gv[bj][1] * acc[ai][bj][m][1];
                    u32x4 r; r.x = cvt_pk_bf16(o0[0], o0[1]); r.y = cvt_pk_bf16(o0[2], o0[3]); r.z = cvt_pk_bf16(o1[0], o1[1]); r.w = cvt_pk_bf16(o1[2], o1[3]); *p = r; } }
    }
};
struct EpiSwiGLU {
    static constexpr bool PERM = true, AFTER_DRAIN = false;
    bf16_t* O; int nct;
    __device__ __forceinline__ void operator()(const f32x4 (&acc)[2][2][4][2], const Unit& u, int wr, int wc, int fr, int fq) const {
        const int row0 = u.pm * BM + wr * 64 + fr, col0 = (u.pn % nct) * HALF + wc * 32 + 8 * fq;
#pragma unroll
        for (int ai = 0; ai < 2; ++ai)
#pragma unroll
            for (int m = 0; m < 4; ++m) { bf16_t* rowp = O + (size_t)(row0 + ai * HALF + m * 16) * 1024 + col0;
                f32x4 v0, v1;
#pragma unroll
                for (int i = 0; i < 4; ++i) { v0[i] = silu_f(acc[ai][0][m][0][i]) * acc[ai][1][m][0][i]; v1[i] = silu_f(acc[ai][0][m][1][i]) * acc[ai][1][m][1][i]; }
                u32x4 w; w.x = cvt_pk_bf16(v0[0], v0[1]); w.y = cvt_pk_bf16(v0[2], v0[3]); w.z = cvt_pk_bf16(v1[0], v1[1]); w.w = cvt_pk_bf16(v1[2], v1[3]);
                *(u32x4*)rowp = w; }
    }
};
struct EpiMoeDown {
    static constexpr bool PERM = true, AFTER_DRAIN = false;
    bf16_t* O; const float* gate;
    __device__ __forceinline__ void operator()(const f32x4 (&acc)[2][2][4][2], const Unit& u, int wr, int wc, int fr, int fq) const {
        const int row0 = u.pm * BM + wr * 64 + fr, col0 = (u.pn & 3) * BM + wc * 32 + 8 * fq;
#pragma unroll
        for (int ai = 0; ai < 2; ++ai)
#pragma unroll
            for (int m = 0; m < 4; ++m) { const int row = row0 + ai * HALF + m * 16; const float gt = gate[row]; bf16_t* rowp = O + (size_t)row * 1024 + col0;
#pragma unroll
                for (int bj = 0; bj < 2; ++bj) { const f32x4 v0 = acc[ai][bj][m][0] * gt, v1 = acc[ai][bj][m][1] * gt;
                    u32x4 w; w.x = cvt_pk_bf16(v0[0], v0[1]); w.y = cvt_pk_bf16(v0[2], v0[3]); w.z = cvt_pk_bf16(v1[0], v1[1]); w.w = cvt_pk_bf16(v1[2], v1[3]);
                    *(u32x4*)(rowp + bj * HALF) = w; } }
    }
};
struct EpiSpatial {
    static constexpr bool PERM = true, AFTER_DRAIN = false;
    bf16_t* UV; const bf16_t* Z; const float* bs;
    __device__ __forceinline__ void operator()(const f32x4 (&acc)[2][2][4][2], const Unit& u, int wr, int wc, int fr, int fq) const {
        const int g = u.pm, chunk = u.pn >> 3;
#pragma unroll
        for (int m = 0; m < 4; ++m) { const int p = wr * 64 + m * 16 + fr; const float b = bs[g * 128 + p]; const size_t tok = (size_t)chunk * 128 + p;
#pragma unroll
            for (int bj = 0; bj < 2; ++bj) { const int ch = g * 256 + bj * HALF + wc * 32 + 8 * fq;
                const u32x4 uw = *(const u32x4*)(Z + tok * 4096 + ch);
                const f32x4 a0 = acc[0][bj][m][0] + b, a1 = acc[0][bj][m][1] + b;
                u32x4 w;
                w.x = cvt_pk_bf16(a0[0] * __builtin_bit_cast(float, uw.x << 16), a0[1] * __builtin_bit_cast(float, uw.x & 0xffff0000u));
                w.y = cvt_pk_bf16(a0[2] * __builtin_bit_cast(float, uw.y << 16), a0[3] * __builtin_bit_cast(float, uw.y & 0xffff0000u));
                w.z = cvt_pk_bf16(a1[0] * __builtin_bit_cast(float, uw.z << 16), a1[1] * __builtin_bit_cast(float, uw.z & 0xffff0000u));
                w.w = cvt_pk_bf16(a1[2] * __builtin_bit_cast(float, uw.w << 16), a1[3] * __builtin_bit_cast(float, uw.w & 0xffff0000u));
                *(u32x4*)(UV + tok * 2048 + ch) = w; } }
    }
};
struct MoeOrder {
    int nrt, nct, nwg, G, c;
    __device__ void init(int nrt_, int nct_, int G_, int c_) { nrt = nrt_; nct = nct_; nwg = 16 * nrt * nct; G = G_; c = c_; }
    __device__ bool next(int i, Unit& u) const {
        const int L = i * G + c; if (L >= nwg) return false;
        const int per = nrt * nct, e = L / per, r = L % per, j = r / nrt, rt = r % nrt;
        u.pm = e * 17 + rt; u.pn = e * nct + j; return true;
    }
    __device__ __forceinline__ void a_ready(const Unit&) const {}
    __device__ __forceinline__ void done(const Unit&) const {}
};
struct SpatialOrder {
    int nwg, G, c;
    __device__ void init(int nblocks, int G_, int c_) { nwg = nblocks; G = G_; c = c_; }
    __device__ bool next(int i, Unit& u) const { const int L = i * G + c; if (L >= nwg) return false; u.pm = L & 7; u.pn = L; return true; }
    __device__ __forceinline__ void a_ready(const Unit&) const {}
    __device__ __forceinline__ void done(const Unit&) const {}
};
template <class Epi, class Sched, bool ALIGN_EPI = false, bool SP2 = false, bool GATHER = false>
__device__ __forceinline__ void gemm_phase(PG8_LAS unsigned char* lds, const Gemm g, const Sched& S, const Epi& E, int tid_in, const int* rowsrc = nullptr, PG8_LAS int* idx_lds = nullptr) {
    int tid_ = tid_in; asm volatile("" : "+v"(tid_));
    const int tid = tid_, wid = __builtin_amdgcn_readfirstlane(tid >> 6), lane = tid & 63, wr = wid >> 2, wc = wid & 3, fr = lane & 15, fq = lane >> 4;
    const int K = g.K, nt = K / BK, LDA = g.lda ? g.lda : g.K;
    unsigned voffA[2], voffB[2];
#pragma unroll
    for (int i = 0; i < 2; ++i) { int R, C; stage_rc(tid * 16 + i * 8192, R, C); const int Rb = Epi::PERM ? ((R & ~31) + perm32(R & 31)) : R;
        voffA[i] = (unsigned)(R * LDA + C) * 2u; voffB[i] = (unsigned)(Rb * K + C) * 2u; }
    const size_t kstep = (size_t)(BK * 2);
    const size_t hstep = (size_t)HALF * K * 2;
    const size_t tstep = 2 * hstep;
    const size_t hstepA = GATHER ? 0 : (size_t)HALF * LDA * 2, tstepA = 2 * hstepA;
    unsigned gA[2][2], gN[2][2], gS[2][2];
    int gR[2], gC[2];
    if constexpr (GATHER) {
#pragma unroll
        for (int i = 0; i < 2; ++i) { int R, C; stage_rc(tid * 16 + i * 8192, R, C); gR[i] = R; gC[i] = C * 2; }
        Unit u_; for (int i = 0; S.next(i, u_); ++i) if (tid < 256) idx_lds[i * 256 + tid] = rowsrc[u_.pm * BM + tid];
        asm volatile("s_waitcnt vmcnt(0) lgkmcnt(0)" ::: "memory"); __builtin_amdgcn_s_barrier(); asm volatile("" ::: "memory");
    }
#define PG8_GOFF(dst, unit_i) do { _Pragma("unroll") for (int h_ = 0; h_ < 2; ++h_) _Pragma("unroll") for (int i_ = 0; i_ < 2; ++i_) \
        dst[h_][i_] = (unsigned)idx_lds[(unit_i) * 256 + h_ * HALF + gR[i_]] * (unsigned)(LDA * 2) + (unsigned)gC[i_]; } while (0)
#define PG8_OA(h) (GATHER ? gA[h] : voffA)
#define PG8_OS(h) (GATHER ? gS[h] : voffA)
    const unsigned ldsw = (unsigned)wid * 1024u;
    const int aoff = lds_byte(wr * 64 + fr, fq * 8), boff = lds_byte(wc * 32 + fr, fq * 8);
#define PG8_SA(b, h) (((b) * 2 + (h)) * HTB)
#define PG8_SB(b, h) ((4 + (b) * 2 + (h)) * HTB)
#define PG8_STAGE(bufoff, gbase, voff) do { _Pragma("unroll") for (int _i = 0; _i < 2; ++_i) \
        __builtin_amdgcn_global_load_lds((const unsigned*)((const char*)(gbase) + (voff)[_i]), (PG8_LAS unsigned*)(lds + (bufoff) + ldsw + _i * 8192), 16, 0, 0); } while (0)
#define PG8_LDA(dst, b, h) do { _Pragma("unroll") for (int m = 0; m < 4; ++m) _Pragma("unroll") for (int k = 0; k < 2; ++k) dst[m][k] = *(const PG8_LAS bf16x8*)(lds + PG8_SA(b, h) + aoff + m * 2048 + k * 1024); } while (0)
#define PG8_LDB(dst, b, h) do { _Pragma("unroll") for (int n = 0; n < 2; ++n) _Pragma("unroll") for (int k = 0; k < 2; ++k) dst[n][k] = *(const PG8_LAS bf16x8*)(lds + PG8_SB(b, h) + boff + n * 2048 + k * 1024); } while (0)
#define PG8_MMA(ai, bj, At, Bt) do { __builtin_amdgcn_s_setprio(1); _Pragma("unroll") for (int m = 0; m < 4; ++m) _Pragma("unroll") for (int n = 0; n < 2; ++n) _Pragma("unroll") for (int k = 0; k < 2; ++k) \
        acc[ai][bj][m][n] = __builtin_amdgcn_mfma_f32_16x16x32_bf16(Bt[n][k], At[m][k], acc[ai][bj][m][n], 0, 0, 0); __builtin_amdgcn_s_setprio(0); } while (0)
#define PG8_WAIT_V(n) asm volatile("s_waitcnt vmcnt(" #n ")" ::: "memory")
#define PG8_WAIT_L(n) asm volatile("s_waitcnt lgkmcnt(" #n ")" ::: "memory")
#define PG8_BAR __builtin_amdgcn_s_barrier()
#define PG8_SCHED __builtin_amdgcn_sched_barrier(0)
    Unit cur, nxt; int ui = 0;
    if (!S.next(0, cur)) return;
    if constexpr (GATHER) { PG8_GOFF(gA, 0); }
    f32x4 acc[2][2][4][2];
#pragma unroll
    for (int a = 0; a < 2; ++a)
#pragma unroll
        for (int b = 0; b < 2; ++b)
#pragma unroll
            for (int m = 0; m < 4; ++m)
#pragma unroll
                for (int n = 0; n < 2; ++n) acc[a][b][m][n] = (f32x4){0.f, 0.f, 0.f, 0.f};
    bf16x8 At[4][2], B0[2][2], B1[2][2];
    const char* cA = (const char*)g.A + (size_t)cur.pm * tstepA; const char* cB = (const char*)g.Bt + (size_t)cur.pn * tstep;
    S.a_ready(cur);
    if constexpr (SP2) {
        PG8_STAGE(PG8_SB(0, 0), cB, voffB); PG8_STAGE(PG8_SB(0, 1), cB + hstep, voffB); PG8_STAGE(PG8_SA(0, 0), cA, PG8_OA(0)); PG8_STAGE(PG8_SA(0, 1), cA + hstepA, PG8_OA(1));
        if (wr == 1) PG8_BAR;
        PG8_WAIT_V(2); PG8_BAR;
        PG8_STAGE(PG8_SB(1, 0), cB + kstep, voffB); PG8_STAGE(PG8_SA(1, 0), cA + kstep, PG8_OA(0)); PG8_STAGE(PG8_SB(1, 1), cB + hstep + kstep, voffB);
        PG8_WAIT_V(6); PG8_BAR;
    } else {
        PG8_STAGE(PG8_SB(0, 0), cB, voffB); PG8_STAGE(PG8_SA(0, 0), cA, PG8_OA(0)); PG8_STAGE(PG8_SB(0, 1), cB + hstep, voffB); PG8_STAGE(PG8_SA(0, 1), cA + hstepA, PG8_OA(1));
        if (wr == 1) PG8_BAR;
        PG8_WAIT_V(4); PG8_BAR;
        PG8_STAGE(PG8_SB(1, 0), cB + kstep, voffB); PG8_STAGE(PG8_SA(1, 0), cA + kstep, PG8_OA(0)); PG8_STAGE(PG8_SB(1, 1), cB + hstep + kstep, voffB);
        PG8_WAIT_V(6); PG8_BAR;
    }
    for (;;) {
        const bool has_next = S.next(ui + 1, nxt);
        if constexpr (GATHER) { if (has_next) { PG8_GOFF(gN, ui + 1); } else {
#pragma unroll
            for (int h_ = 0; h_ < 2; ++h_) { gN[h_][0] = gA[h_][0]; gN[h_][1] = gA[h_][1]; } } }
        const char* nA = has_next ? (const char*)g.A + (size_t)nxt.pm * tstepA : cA; const char* nB = has_next ? (const char*)g.Bt + (size_t)nxt.pn * tstep : cB;
        for (int t = 0; t < nt; t += 2) {
            const bool last = (t == nt - 2);
            if constexpr (GATHER) {
#pragma unroll
                for (int h_ = 0; h_ < 2; ++h_) { gS[h_][0] = last ? gN[h_][0] : gA[h_][0]; gS[h_][1] = last ? gN[h_][1] : gA[h_][1]; } }
            const char* a1 = cA + (size_t)(t + 1) * kstep;
            const char* a2 = last ? nA : cA + (size_t)(t + 2) * kstep; const char* b2 = last ? nB : cB + (size_t)(t + 2) * kstep;
            const char* a3 = a2 + kstep; const char* b3 = b2 + kstep;
            if (last && has_next) S.a_ready(nxt);
            if constexpr (SP2) {
            PG8_LDB(B0, 0, 0); PG8_LDB(B1, 0, 1); PG8_SCHED; PG8_LDA(At, 0, 0); PG8_STAGE(PG8_SA(1, 1), a1 + hstepA, PG8_OA(1));
            PG8_WAIT_V(8); PG8_WAIT_L(0); PG8_BAR; PG8_MMA(0, 0, At, B0); PG8_MMA(0, 1, At, B1); PG8_BAR; PG8_SCHED;
            PG8_LDA(At, 0, 1); PG8_STAGE(PG8_SB(0, 0), b2, voffB); PG8_STAGE(PG8_SB(0, 1), b2 + hstep, voffB); PG8_STAGE(PG8_SA(0, 0), a2, PG8_OS(0));
            PG8_WAIT_V(8); PG8_WAIT_L(0); PG8_BAR; PG8_MMA(1, 0, At, B0); PG8_MMA(1, 1, At, B1); PG8_BAR; PG8_SCHED;
            PG8_LDB(B0, 1, 0); PG8_LDB(B1, 1, 1); PG8_SCHED; PG8_LDA(At, 1, 0); PG8_STAGE(PG8_SA(0, 1), a2 + hstepA, PG8_OS(1));
            PG8_WAIT_V(8); PG8_WAIT_L(0); PG8_BAR; PG8_MMA(0, 0, At, B0); PG8_MMA(0, 1, At, B1); PG8_BAR; PG8_SCHED;
            PG8_LDA(At, 1, 1); PG8_STAGE(PG8_SB(1, 0), b3, voffB); PG8_STAGE(PG8_SB(1, 1), b3 + hstep, voffB); PG8_STAGE(PG8_SA(1, 0), a3, PG8_OS(0));
            PG8_WAIT_V(8); PG8_WAIT_L(0); PG8_BAR; PG8_MMA(1, 0, At, B0); PG8_MMA(1, 1, At, B1); PG8_BAR; PG8_SCHED;
            } else {
            PG8_LDB(B0, 0, 0); PG8_SCHED; PG8_LDA(At, 0, 0); PG8_STAGE(PG8_SA(1, 1), a1 + hstepA, PG8_OA(1));
            PG8_WAIT_L(8); PG8_BAR; PG8_WAIT_L(0); PG8_MMA(0, 0, At, B0); PG8_BAR; PG8_SCHED;
            PG8_LDB(B1, 0, 1); PG8_STAGE(PG8_SB(0, 0), b2, voffB);
            PG8_BAR; PG8_WAIT_L(0); PG8_MMA(0, 1, At, B1); PG8_BAR;
            PG8_LDA(At, 0, 1); PG8_STAGE(PG8_SA(0, 0), a2, PG8_OS(0));
            PG8_BAR; PG8_WAIT_L(0); PG8_MMA(1, 0, At, B0); PG8_BAR; PG8_SCHED;
            PG8_STAGE(PG8_SB(0, 1), b2 + hstep, voffB);
            PG8_WAIT_V(6); PG8_BAR; PG8_MMA(1, 1, At, B1); PG8_BAR;
            PG8_LDB(B0, 1, 0); PG8_SCHED; PG8_LDA(At, 1, 0); PG8_STAGE(PG8_SA(0, 1), a2 + hstepA, PG8_OS(1));
            PG8_WAIT_L(8); PG8_BAR; PG8_WAIT_L(0); PG8_MMA(0, 0, At, B0); PG8_BAR; PG8_SCHED;
            PG8_LDB(B1, 1, 1); PG8_STAGE(PG8_SB(1, 0), b3, voffB);
            PG8_BAR; PG8_WAIT_L(0); PG8_MMA(0, 1, At, B1); PG8_BAR;
            PG8_LDA(At, 1, 1); PG8_STAGE(PG8_SA(1, 0), a3, PG8_OS(0));
            PG8_BAR; PG8_WAIT_L(0); PG8_MMA(1, 0, At, B0); PG8_BAR; PG8_SCHED;
            PG8_STAGE(PG8_SB(1, 1), b3 + hstep, voffB);
            PG8_WAIT_V(6); PG8_BAR; PG8_MMA(1, 1, At, B1); PG8_BAR;
            }
        }
        if constexpr (ALIGN_EPI) { if (wr == 0) PG8_BAR; }
        if constexpr (!Epi::AFTER_DRAIN) { E(acc, cur, wr, wc, fr, fq); S.done(cur); }
        if (!has_next) break;
#pragma unroll
        for (int a = 0; a < 2; ++a)
#pragma unroll
            for (int b = 0; b < 2; ++b)
#pragma unroll
                for (int m = 0; m < 4; ++m)
#pragma unroll
                    for (int n = 0; n < 2; ++n) acc[a][b][m][n] = (f32x4){0.f, 0.f, 0.f, 0.f};
        cur = nxt; cA = nA; cB = nB; ++ui;
        if constexpr (GATHER) {
#pragma unroll
            for (int h_ = 0; h_ < 2; ++h_) { gA[h_][0] = gN[h_][0]; gA[h_][1] = gN[h_][1]; } }
        if constexpr (ALIGN_EPI) { if (wr == 1) PG8_BAR; }
    }
    PG8_WAIT_V(0);
    if constexpr (!ALIGN_EPI) { if (wr == 0) PG8_BAR; }
    PG8_BAR;
    if constexpr (Epi::AFTER_DRAIN) { E.fused(acc, cur, wr, wc, fr, fq, lds, wid, lane); S.done(cur); }
#undef PG8_SA
#undef PG8_GOFF
#undef PG8_OA
#undef PG8_OS
#undef PG8_SB
#undef PG8_STAGE
#undef PG8_LDA
#undef PG8_LDB
#undef PG8_MMA
#undef PG8_WAIT_V
#undef PG8_WAIT_L
#undef PG8_BAR
#undef PG8_SCHED
}
}

namespace att {
using bf16x8 = __attribute__((ext_vector_type(8))) short;
using s16x4  = __attribute__((ext_vector_type(4))) short;
using f32x16 = __attribute__((ext_vector_type(16))) float;
using u32x4  = __attribute__((ext_vector_type(4))) unsigned;
constexpr int NW = 8, QBLK = 32, KVBLK = 64, KROWB = 256;
constexpr float THR = 8.f;
#define ATT_KSWZ(row, colB) ((row) * 256 + ((colB) ^ (((row) & 7) << 4)))
#define ATT_SBAR() __builtin_amdgcn_sched_barrier(0)
__device__ __forceinline__ int crow(int r, int hi) { return (r & 3) + 8 * (r >> 2) + 4 * hi; }
__device__ __forceinline__ unsigned cvtpk(float lo, float hi) { unsigned r; asm volatile("v_cvt_pk_bf16_f32 %0, %1, %2" : "=v"(r) : "v"(lo), "v"(hi)); return r; }
template <int DK> struct Sc { static constexpr float SCALE = (DK == 96) ? 0.10206207261596575f : 0.125f; static constexpr float C = SCALE * 1.4426950408889634f; };

template <int DK, bool OFF>
__device__ __forceinline__ void partialSM(f32x16& p0, f32x16& p1, float negMC) {
  if constexpr (OFF) {
#pragma unroll
    for (int r = 0; r < 16; ++r) p0[r] += negMC;
#pragma unroll
    for (int r = 0; r < 16; ++r) p1[r] += negMC;
  }
#pragma unroll
  for (int r = 0; r < 16; ++r) p0[r] = __builtin_amdgcn_exp2f(p0[r]);
}
__device__ __forceinline__ void finishSM(f32x16& p0, f32x16& p1, float& l_reg, bf16x8& pa0, bf16x8& pa1, bf16x8& pa2, bf16x8& pa3) {
#pragma unroll
  for (int r = 0; r < 16; ++r) p1[r] = __builtin_amdgcn_exp2f(p1[r]);
  float ps = 0;
#pragma unroll
  for (int r = 0; r < 16; ++r) ps += p0[r];
#pragma unroll
  for (int r = 0; r < 16; ++r) ps += p1[r];
  l_reg += ps;
#define ATT_PK4(P, BASE, OUT) do { unsigned a0 = cvtpk(P[BASE + 0], P[BASE + 1]), a1 = cvtpk(P[BASE + 2], P[BASE + 3]);   \
    unsigned b0 = cvtpk(P[BASE + 4], P[BASE + 5]), b1 = cvtpk(P[BASE + 6], P[BASE + 7]);                              \
    auto r0 = __builtin_amdgcn_permlane32_swap(a0, b0, false, false); auto r1 = __builtin_amdgcn_permlane32_swap(a1, b1, false, false); \
    u32x4 w = {r0[0], r1[0], r0[1], r1[1]}; OUT = *reinterpret_cast<bf16x8*>(&w); } while (0)
  ATT_PK4(p0, 0, pa0); ATT_PK4(p0, 8, pa1); ATT_PK4(p1, 0, pa2); ATT_PK4(p1, 8, pa3);
#undef ATT_PK4
}
template <int DK>
__device__ __forceinline__ void qkt(f32x16& p0, f32x16& p1, const char* Ks, const bf16x8* qr, int r32, int hi) {
  p0 = f32x16{}; p1 = f32x16{};
#pragma unroll
  for (int d0 = 0; d0 < DK / 16; ++d0) { const int cb = (d0 * 16 + hi * 8) * 2;
    const bf16x8 b0 = *reinterpret_cast<const bf16x8*>(Ks + ATT_KSWZ(r32, cb));
    const bf16x8 b1 = *reinterpret_cast<const bf16x8*>(Ks + ATT_KSWZ(32 + r32, cb));
    p0 = __builtin_amdgcn_mfma_f32_32x32x16_bf16(b0, qr[d0], p0, 0, 0, 0);
    p1 = __builtin_amdgcn_mfma_f32_32x32x16_bf16(b1, qr[d0], p1, 0, 0, 0);
  }
}
template <int DV> __device__ __forceinline__ int v_st(int k, int c) { const int kk = (k & ~0xC) | ((k & 4) << 1) | ((k & 8) >> 1); return ((kk >> 3) * (DV / 32) + (c >> 5)) * 512 + ((kk & 7) * 32 + (c & 31)) * 2; }
__device__ __forceinline__ int v_rd_base(int lane) { return ((lane & 3) << 3) | (((lane >> 2) & 3) << 6) | (((lane >> 4) & 1) << 5) | (((lane >> 5) & 1) << 8); }
template <int DV> constexpr int v_rd_off(int d0, int ks, int half) { return d0 * 512 + ks * (2 * (DV / 32) * 512) + half * ((DV / 32) * 512); }
template <int OFF> __device__ __forceinline__ s16x4 tr_read(int vb) {
  s16x4 r; asm volatile("ds_read_b64_tr_b16 %0, %1 offset:%2" : "=&v"(r) : "v"(vb), "i"(OFF) : "memory"); return r;
}
template <int DV, int D0> __device__ __forceinline__ void pv_one(f32x16& od, int vb, bf16x8 pa0, bf16x8 pa1, bf16x8 pa2, bf16x8 pa3) {
  const s16x4 l0 = tr_read<v_rd_off<DV>(D0, 0, 0)>(vb), h0 = tr_read<v_rd_off<DV>(D0, 0, 1)>(vb), l1 = tr_read<v_rd_off<DV>(D0, 1, 0)>(vb), h1 = tr_read<v_rd_off<DV>(D0, 1, 1)>(vb);
  const s16x4 l2 = tr_read<v_rd_off<DV>(D0, 2, 0)>(vb), h2 = tr_read<v_rd_off<DV>(D0, 2, 1)>(vb), l3 = tr_read<v_rd_off<DV>(D0, 3, 0)>(vb), h3 = tr_read<v_rd_off<DV>(D0, 3, 1)>(vb);
  asm volatile("s_waitcnt lgkmcnt(0)" ::: "memory"); ATT_SBAR();
#define ATT_PK(L, H) (bf16x8){L[0], L[1], L[2], L[3], H[0], H[1], H[2], H[3]}
  od = __builtin_amdgcn_mfma_f32_32x32x16_bf16(pa0, ATT_PK(l0, h0), od, 0, 0, 0);
  od = __builtin_amdgcn_mfma_f32_32x32x16_bf16(pa1, ATT_PK(l1, h1), od, 0, 0, 0);
  od = __builtin_amdgcn_mfma_f32_32x32x16_bf16(pa2, ATT_PK(l2, h2), od, 0, 0, 0);
  od = __builtin_amdgcn_mfma_f32_32x32x16_bf16(pa3, ATT_PK(l3, h3), od, 0, 0, 0);
#undef ATT_PK
}
template <int DV> __device__ __forceinline__ void pv_all(f32x16* o, int vb, bf16x8 pa0, bf16x8 pa1, bf16x8 pa2, bf16x8 pa3) {
  pv_one<DV, 0>(o[0], vb, pa0, pa1, pa2, pa3); pv_one<DV, 1>(o[1], vb, pa0, pa1, pa2, pa3);
  if constexpr (DV == 128) { pv_one<DV, 2>(o[2], vb, pa0, pa1, pa2, pa3); pv_one<DV, 3>(o[3], vb, pa0, pa1, pa2, pa3); }
}
__device__ __forceinline__ float half_pair_sum(float v) { const unsigned a = __float_as_uint(v); auto rr = __builtin_amdgcn_permlane32_swap(a, a, false, false); const unsigned r0 = rr[0], r1 = rr[1]; return __uint_as_float(r0) + __uint_as_float(r1); }
__device__ __forceinline__ void unpack_bf8(const bf16x8 w, float* f) {
#pragma unroll
  for (int i = 0; i < 8; ++i) f[i] = __uint_as_float((unsigned)(unsigned short)w[i] << 16); }
__device__ __forceinline__ bf16x8 pack_bf8(const float* f) { u32x4 w = {cvtpk(f[0], f[1]), cvtpk(f[2], f[3]), cvtpk(f[4], f[5]), cvtpk(f[6], f[7])}; return *reinterpret_cast<bf16x8*>(&w); }
struct QLoadMLA {
  const bf16* qpre;
  const float* rq;
  const float* gq;
  const float* cosA;
  __device__ __forceinline__ void load(bf16x8 (&qr)[6], int r, int hi) const {
    const bf16* src = qpre + (long)r * 1536 + hi * 8; float v[6][8]; float ss = 0.f;
#pragma unroll
    for (int d0 = 0; d0 < 6; ++d0) { unpack_bf8(*reinterpret_cast<const bf16x8*>(src + d0 * 16), v[d0]);
#pragma unroll
      for (int j = 0; j < 8; ++j) ss += v[d0][j] * v[d0][j]; }
    ss = half_pair_sum(ss);
    const float rqv = rq[r], f = Sc<96>::C * rqv / sqrtf(rqv * rqv * ss * (1.0f / 96.0f) + EPS);
#pragma unroll
    for (int d0 = 0; d0 < 6; ++d0) { const f32x4 g0 = *(const f32x4*)(gq + d0 * 16 + hi * 8), g1 = *(const f32x4*)(gq + d0 * 16 + hi * 8 + 4);
#pragma unroll
      for (int j = 0; j < 4; ++j) { v[d0][j] *= f * g0[j]; v[d0][4 + j] *= f * g1[j]; } }
    if (cosA) { const float* c = cosA + (long)r * 16 + hi * 8; const float* sn = c + 4096 * 16;
#pragma unroll
      for (int j = 0; j < 8; ++j) { const float x1 = v[4][j], x2 = v[5][j], cs = c[j], si = sn[j]; v[4][j] = x1 * cs - x2 * si; v[5][j] = x1 * si + x2 * cs; } }
#pragma unroll
    for (int d0 = 0; d0 < 6; ++d0) qr[d0] = pack_bf8(v[d0]);
  }
};
struct QLoadPlain {
  const bf16* q; int ldq;
  template <int NQ> __device__ __forceinline__ void load(bf16x8 (&qr)[NQ], int r, int hi) const {
    const bf16* src = q + (long)r * ldq + hi * 8;
#pragma unroll
    for (int d0 = 0; d0 < NQ; ++d0) qr[d0] = *reinterpret_cast<const bf16x8*>(src + d0 * 16);
  }
};
template <int DK, int DV> struct Geo {
  static constexpr int SHM_V = KVBLK * DV * 2, SHM_K = KVBLK * KROWB, SHM = 2 * SHM_V + 2 * SHM_K + NW * 64 * 4;
  static constexpr int KCPR = DK / 8, VCPR = DV / 8;
  static constexpr int NKC = KVBLK * KCPR, NVC = KVBLK * VCPR;
  static constexpr int KN = (NKC + 511) / 512, VN = NVC / 512;
  static_assert(NVC % 512 == 0 && SHM <= 131072, "attention geometry");
};

template <int DK, int DV, int SD, bool OFF, class QLoader>
__device__ __forceinline__ void body(const QLoader& QL, const bf16* __restrict__ K0, const bf16* __restrict__ K1, int ldk,
                                     const bf16* __restrict__ V0, const bf16* __restrict__ V1, int ldv, bf16* __restrict__ Ob, int ldo, int nkeys, float negMC, char* lds, int tid_in) {
  using G = Geo<DK, DV>;
  constexpr int SHM_V = G::SHM_V, SHM_K = G::SHM_K, KN = G::KN, VN = G::VN, ND = DV / 32;
  int tid_ = tid_in; asm volatile("" : "+v"(tid_));
  const int tid = tid_, wid = tid >> 6, lane = tid & 63, r32 = lane & 31, hi = lane >> 5;
  char* V_lds = lds; char* K_lds = lds + 2 * SHM_V;
  float* ws = (float*)(lds + 2 * SHM_V + 2 * SHM_K) + wid * 64; float* li_l = ws;
  float l_reg = 0; f32x16 o[ND];
#pragma unroll
  for (int d = 0; d < ND; ++d) o[d] = f32x16{};
  bf16x8 qr[DK / 16];
  QL.load(qr, wid * QBLK + r32, hi);
  int kofs[KN], kdst[KN], vofs[VN], vdst[VN];
#pragma unroll
  for (int i = 0; i < KN; ++i) { const int c = tid + 512 * i, row = (c / G::KCPR) & 63, col = (c % G::KCPR) * 8; kofs[i] = (row * ldk + col) * 2; kdst[i] = ATT_KSWZ(row, col * 2); }
#pragma unroll
  for (int i = 0; i < VN; ++i) { const int c = tid + 512 * i, row = c / G::VCPR, col = (c % G::VCPR) * 8; vofs[i] = (row * ldv + col) * 2; vdst[i] = v_st<DV>(row, col); }
  const bool k_last_ok = (tid + 512 * (KN - 1)) < G::NKC;
  const int vb0 = (int)(uintptr_t)V_lds + v_rd_base(lane);
  struct Slot { bf16x8 k[KN], v[VN]; } sr_[SD];
#define ATT_TBASE(k0, ld, P0, P1) (((k0) < 256) ? ((P0) + (long)(k0) * (ld)) : ((P1) + (long)((k0) - 256) * (ld)))
#define ATT_LD(base, ofs) (*reinterpret_cast<const bf16x8*>((const char*)(base) + (unsigned)(ofs)))
#define ATT_SLOAD(i, k0) do { const bf16* vb_ = ATT_TBASE(k0, ldv, V0, V1); const bf16* kb_ = ATT_TBASE(k0, ldk, K0, K1); \
    _Pragma("unroll") for (int _s = 0; _s < VN; ++_s) sr_[i].v[_s] = ATT_LD(vb_, vofs[_s]); \
    _Pragma("unroll") for (int _s = 0; _s < KN; ++_s) if (_s < KN - 1 || k_last_ok) sr_[i].k[_s] = ATT_LD(kb_, kofs[_s]); } while (0)
#define ATT_SWRITE(b, i) do { \
    _Pragma("unroll") for (int _s = 0; _s < VN; ++_s) *reinterpret_cast<bf16x8*>(V_lds + (b) * SHM_V + vdst[_s]) = sr_[i].v[_s]; \
    _Pragma("unroll") for (int _s = 0; _s < KN; ++_s) if (_s < KN - 1 || k_last_ok) *reinterpret_cast<bf16x8*>(K_lds + (b) * SHM_K + kdst[_s]) = sr_[i].k[_s]; } while (0)
#define ATT_SWAIT() asm volatile("s_waitcnt vmcnt(%0)" :: "n"(SD == 2 ? KN + VN : 0) : "memory")
  f32x16 pA0, pA1, pB0, pB1; bf16x8 pa0, pa1, pa2, pa3; const int NT = nkeys / KVBLK;
  constexpr int SE = 0, SO = SD - 1;
  ATT_SLOAD(SE, 0); asm volatile("s_waitcnt vmcnt(0)" ::: "memory"); ATT_SWRITE(0, SE); __syncthreads();
  qkt<DK>(pA0, pA1, K_lds, qr, r32, hi); partialSM<DK, OFF>(pA0, pA1, negMC);
  ATT_SLOAD(SO, KVBLK); if constexpr (SD == 2) { if (2 < NT) ATT_SLOAD(SE, 2 * KVBLK); }
  ATT_SWAIT(); ATT_SWRITE(1, SO); __syncthreads();
  for (int j = 1; j + 1 < NT; j += 2) {
    ATT_SBAR(); qkt<DK>(pB0, pB1, K_lds + SHM_K, qr, r32, hi);
    finishSM(pA0, pA1, l_reg, pa0, pa1, pa2, pa3); ATT_SBAR();
    ATT_SLOAD(SO, (j + SD) * KVBLK); ATT_SBAR();
    pv_all<DV>(o, vb0, pa0, pa1, pa2, pa3); partialSM<DK, OFF>(pB0, pB1, negMC);
    __syncthreads(); ATT_SWAIT(); ATT_SWRITE(0, SE);
    __syncthreads();
    ATT_SBAR(); qkt<DK>(pA0, pA1, K_lds, qr, r32, hi);
    finishSM(pB0, pB1, l_reg, pa0, pa1, pa2, pa3); ATT_SBAR();
    if (SD == 1 || j + 3 < NT) ATT_SLOAD(SE, (j + 1 + SD) * KVBLK); ATT_SBAR();
    pv_all<DV>(o, vb0 + SHM_V, pa0, pa1, pa2, pa3); partialSM<DK, OFF>(pA0, pA1, negMC);
    __syncthreads(); ATT_SWAIT(); ATT_SWRITE(1, SO);
    __syncthreads();
  }
  ATT_SBAR(); qkt<DK>(pB0, pB1, K_lds + SHM_K, qr, r32, hi);
  finishSM(pA0, pA1, l_reg, pa0, pa1, pa2, pa3); ATT_SBAR();
  pv_all<DV>(o, vb0, pa0, pa1, pa2, pa3); partialSM<DK, OFF>(pB0, pB1, negMC);
  __syncthreads();
  finishSM(pB0, pB1, l_reg, pa0, pa1, pa2, pa3); ATT_SBAR();
  pv_all<DV>(o, vb0 + SHM_V, pa0, pa1, pa2, pa3);
  { auto rr = __builtin_amdgcn_permlane32_swap(__float_as_uint(l_reg), __float_as_uint(l_reg), false, false);
    l_reg = __uint_as_float(rr[0]) + __uint_as_float(rr[1]); }
  if (hi == 0) li_l[r32] = l_reg; asm volatile("s_waitcnt lgkmcnt(0)" ::: "memory");
  float rli[16];
#pragma unroll
  for (int r = 0; r < 16; ++r) rli[r] = __builtin_amdgcn_rcpf(li_l[crow(r, hi)]);
  bf16* Ow = Ob + (long)(wid * QBLK) * ldo;
#pragma unroll
  for (int r = 0; r < 16; ++r) { const int orow = crow(r, hi);
#pragma unroll
    for (int d0 = 0; d0 < ND; ++d0) Ow[(long)orow * ldo + d0 * 32 + r32] = (bf16)f2bf(o[d0][r] * rli[r]); }
  __syncthreads();
#undef ATT_TBASE
#undef ATT_LD
#undef ATT_SLOAD
#undef ATT_SWRITE
#undef ATT_SWAIT
}
template <int DK, int DV, bool OFF, class QLoader>
__device__ __forceinline__ void body_dma(const QLoader& QL, const bf16* __restrict__ K0, const bf16* __restrict__ K1, int ldk,
                                         const bf16* __restrict__ V0, const bf16* __restrict__ V1, int ldv, bf16* __restrict__ Ob, int ldo, int nkeys, float negMC, char* lds, int tid_in) {
  using G = Geo<DK, DV>;
  constexpr int SHM_V = G::SHM_V, SHM_K = G::SHM_K, ND = DV / 32, NSL = 4;
  constexpr int KPW = (SHM_K / 1024) / NW, VPW = (SHM_V / 1024) / NW, NPW = KPW + VPW;
  static_assert(KPW == 2 && (VPW == 1 || VPW == 2) && NSL * (SHM_V + SHM_K) + NW * 256 <= 135168, "DMA geometry");
  int tid_ = tid_in; asm volatile("" : "+v"(tid_));
  const int tid = tid_, wid = __builtin_amdgcn_readfirstlane(tid >> 6), lane = tid & 63, r32 = lane & 31, hi = lane >> 5;
  char* V_lds = lds; char* K_lds = lds + NSL * SHM_V;
  float* ws = (float*)(lds + NSL * (SHM_V + SHM_K)) + wid * 64; float* li_l = ws;
  float l_reg = 0; f32x16 o[ND];
#pragma unroll
  for (int d = 0; d < ND; ++d) o[d] = f32x16{};
  bf16x8 qr[DK / 16];
  QL.load(qr, wid * QBLK + r32, hi);
  asm volatile("s_waitcnt vmcnt(0)" ::: "memory");
  unsigned koff[KPW], voff[VPW];
#pragma unroll
  for (int i = 0; i < (DK == 64 ? 1 : KPW); ++i) { const int row = (wid * KPW + i) * 4 + (lane >> 4); int c = (lane & 15) ^ (row & 7); c = (c < DK / 8) ? c : (c & 7); koff[i] = (unsigned)((row * ldk) * 2 + c * 16); }
#pragma unroll
  for (int i = 0; i < 1; ++i) { const int sidx = (wid * VPW + i) * 2 + (lane >> 5), kg = sidx / ND, st = sidx % ND, kk = kg * 8 + ((lane & 31) >> 2);
    const int k = (kk & ~0xC) | ((kk & 4) << 1) | ((kk & 8) >> 1), c = st * 32 + (lane & 3) * 8; voff[i] = (unsigned)((k * ldv + c) * 2); }
  const int vb0 = (int)(uintptr_t)V_lds + v_rd_base(lane);
  LAS unsigned* const ldsK = (LAS unsigned*)(LAS char*)K_lds + (wid * KPW) * 256; LAS unsigned* const ldsV = (LAS unsigned*)(LAS char*)V_lds + (wid * VPW) * 256;
#define ATT_TBASE(k0, ld, P0, P1) (((k0) < 256) ? ((P0) + (long)(k0) * (ld)) : ((P1) + (long)((k0) - 256) * (ld)))
#define DMA_TILE(t, slot) do { const int k0_ = (t) * KVBLK; const char* kb_ = (const char*)ATT_TBASE(k0_, ldk, K0, K1); const char* vb_ = (const char*)ATT_TBASE(k0_, ldv, V0, V1); \
    __builtin_amdgcn_global_load_lds((const unsigned*)(kb_ + koff[0]), ldsK + (slot) * (SHM_K / 4), 16, 0, 0); \
    if constexpr (DK == 64) __builtin_amdgcn_global_load_lds((const unsigned*)(kb_ + 4 * 64 * 2 + (koff[0] ^ 64u)), ldsK + (slot) * (SHM_K / 4) + 256, 16, 0, 0);     \
    else __builtin_amdgcn_global_load_lds((const unsigned*)(kb_ + koff[1]), ldsK + (slot) * (SHM_K / 4) + 256, 16, 0, 0); \
    __builtin_amdgcn_global_load_lds((const unsigned*)(vb_ + voff[0]), ldsV + (slot) * (SHM_V / 4), 16, 0, 0); \
    if constexpr (VPW == 2) __builtin_amdgcn_global_load_lds((const unsigned*)(vb_ + 128 + voff[0]), ldsV + (slot) * (SHM_V / 4) + 256, 16, 0, 0);     } while (0)
#define DMA_WAIT(last) do { if (last) asm volatile("s_waitcnt vmcnt(0)" ::: "memory"); else asm volatile("s_waitcnt vmcnt(%0)" :: "n"(NPW) : "memory"); } while (0)
  f32x16 pA0, pA1, pB0, pB1; bf16x8 pa0, pa1, pa2, pa3; const int NT = nkeys / KVBLK;
  DMA_TILE(0, 0); DMA_TILE(1, 1); DMA_WAIT(false); __syncthreads(); if (2 < NT) DMA_TILE(2, 2);
  qkt<DK>(pA0, pA1, K_lds, qr, r32, hi); partialSM<DK, OFF>(pA0, pA1, negMC);
#define DMA_ITER(j, PN0, PN1, PO0, PO1, KS, VS, DS) do { \
    DMA_WAIT((j) + 1 >= NT); __syncthreads(); if ((j) + 2 < NT) DMA_TILE((j) + 2, DS); \
    ATT_SBAR(); qkt<DK>(PN0, PN1, K_lds + (KS) * SHM_K, qr, r32, hi); \
    finishSM(PO0, PO1, l_reg, pa0, pa1, pa2, pa3); ATT_SBAR(); \
    pv_all<DV>(o, vb0 + (VS) * SHM_V, pa0, pa1, pa2, pa3); partialSM<DK, OFF>(PN0, PN1, negMC); } while (0)
  for (int j = 1; j < NT; j += 4) {
    DMA_ITER(j, pB0, pB1, pA0, pA1, 1, 0, 3);
    if (j + 1 < NT) DMA_ITER(j + 1, pA0, pA1, pB0, pB1, 2, 1, 0);
    if (j + 2 < NT) DMA_ITER(j + 2, pB0, pB1, pA0, pA1, 3, 2, 1);
    if (j + 3 < NT) DMA_ITER(j + 3, pA0, pA1, pB0, pB1, 0, 3, 2);
  }
  finishSM(pB0, pB1, l_reg, pa0, pa1, pa2, pa3); ATT_SBAR();
  pv_all<DV>(o, vb0 + 3 * SHM_V, pa0, pa1, pa2, pa3);
  { auto rr = __builtin_amdgcn_permlane32_swap(__float_as_uint(l_reg), __float_as_uint(l_reg), false, false);
    const unsigned r0 = rr[0], r1 = rr[1]; l_reg = __uint_as_float(r0) + __uint_as_float(r1); }
  const int lane_e = hw_lane(), r32e = lane_e & 31, hie = lane_e >> 5;
  if (hie == 0) li_l[r32e] = l_reg; asm volatile("s_waitcnt lgkmcnt(0)" ::: "memory");
  float rli[16];
#pragma unroll
  for (int r = 0; r < 16; ++r) rli[r] = __builtin_amdgcn_rcpf(li_l[crow(r, hie)]);
  bf16* Ow = Ob + (long)(wid * QBLK) * ldo;
#pragma unroll
  for (int r = 0; r < 16; ++r) { const int orow = crow(r, hie);
#pragma unroll
    for (int d0 = 0; d0 < ND; ++d0) Ow[(long)orow * ldo + d0 * 32 + r32e] = (bf16)f2bf(o[d0][r] * rli[r]); }
  __syncthreads();
#undef ATT_TBASE
#undef DMA_TILE
#undef DMA_WAIT
#undef DMA_ITER
}
}

#define XB_TMO      128
#define XB_XCNT(j)  (256  + 64 * (j))
#define XB_XSUB(j)  (1280 + 64 * (j))
#define XB_XGEN(j)  (2304 + 64 * (j))
#define XB_TOP      3328
#define XB_TOPGEN   3392
#define XCD_BAR_WORDS 3456
#define XB_SPIN_CAP (1u << 18)

__device__ __forceinline__ unsigned xb_ld(unsigned* p)              { return __hip_atomic_load(p, __ATOMIC_RELAXED, __HIP_MEMORY_SCOPE_AGENT); }
__device__ __forceinline__ unsigned xb_add(unsigned* p, unsigned v) { return __hip_atomic_fetch_add(p, v, __ATOMIC_RELAXED, __HIP_MEMORY_SCOPE_AGENT); }
__device__ __forceinline__ unsigned xb_xcc_id() { return (unsigned)__builtin_amdgcn_s_getreg((3 << 11) | 20) & 0xFu; }
#define XB_SPIN(cond, bar) do { unsigned _sp = 0; while (cond) { __builtin_amdgcn_s_sleep(1); \
    if ((++_sp & 255u) == 0u) { if (xb_ld(&(bar)[XB_TMO])) break; if (_sp > XB_SPIN_CAP) { atomicAdd(&(bar)[XB_TMO], 1u); break; } } } } while (0)

struct XcdBarrier {
    int wave;
    unsigned* bar; unsigned x;
    volatile LAS unsigned* st;
};

__device__ __forceinline__ XcdBarrier xcd_barrier_post(unsigned* bar, volatile LAS unsigned* st) {
    XcdBarrier b; b.wave = 0; b.bar = bar; b.x = xb_xcc_id(); b.st = st;
    if (threadIdx.x == 0) (void)xb_add(&bar[XB_XCNT(b.x)], 1u);
    return b;
}
__device__ __forceinline__ void xcd_barrier_complete(unsigned* bar, unsigned x, unsigned& nloc, unsigned& nx) {
    const unsigned G = gridDim.x * gridDim.y * gridDim.z;
    unsigned sum, cnt, mine, sp = 0u;
    for (;;) {
        sum = 0u; cnt = 0u; mine = 0u;
#pragma unroll
        for (unsigned j = 0; j < 16; ++j) { const unsigned c = xb_ld(&bar[XB_XCNT(j)]); sum += c; cnt += (c > 0u) ? 1u : 0u; mine = (j == x) ? c : mine; }
        if (sum == G) break;
        __builtin_amdgcn_s_sleep(1);
        if ((++sp & 255u) == 0u) { if (xb_ld(&bar[XB_TMO])) break; if (sp > XB_SPIN_CAP) { atomicAdd(&bar[XB_TMO], 1u); break; } }
    }
    nloc = mine > 0u ? mine : 1u; nx = cnt > 0u ? cnt : 1u;
}

__device__ __forceinline__ void xcd_barrier(const XcdBarrier& b) {
    asm volatile("s_waitcnt vmcnt(0)" ::: "memory");
    __syncthreads();
    if (b.wave == 0 && hw_lane() == 0) {
        size_t zb_ = 0; asm volatile("" : "+s"(zb_));
        unsigned* bar = b.bar + zb_;
        __builtin_amdgcn_s_waitcnt(0);
        unsigned nloc = b.st[0], nx = b.st[1];
        if (nloc == 0u) { xcd_barrier_complete(bar, b.x, nloc, nx); b.st[0] = nloc; b.st[1] = nx; }
        const unsigned old = xb_add(&bar[XB_XSUB(b.x)], 1u);
        const unsigned gen = old / nloc;
        if (old + 1u == (gen + 1u) * nloc) {
            __builtin_amdgcn_fence(__ATOMIC_RELEASE, "agent");
            asm volatile("s_waitcnt vmcnt(0)" ::: "memory");
            const unsigned og = xb_add(&bar[XB_TOP], 1u);
            const unsigned tg = og / nx;
            if (og + 1u == (tg + 1u) * nx) xb_add(&bar[XB_TOPGEN], 1u);
            else XB_SPIN(xb_ld(&bar[XB_TOPGEN]) == tg, bar);
            __builtin_amdgcn_fence(__ATOMIC_ACQUIRE, "agent");
            xb_add(&bar[XB_XGEN(b.x)], 1u);
            asm volatile("s_waitcnt vmcnt(0)" ::: "memory");
        } else {
            XB_SPIN(xb_ld(&bar[XB_XGEN(b.x)]) == gen, bar);
            __builtin_amdgcn_fence(__ATOMIC_ACQUIRE, "agent");
            asm volatile("s_waitcnt vmcnt(0)" ::: "memory");
        }
    }
    __syncthreads();
}

struct Args { const float* in[35]; float* out; unsigned char* ws; int ph_lo, ph_hi; };
enum { I_X = 0, I_C, I_CTX, I_CCTX, I_ADAW, I_ADAB, I_NMIX, I_NFFN, I_MLA_WIN, I_MLA_QNG, I_MLA_WUQ, I_MLA_KVNG, I_MLA_WUKV, I_MLA_QN, I_MLA_KN, I_MLA_WOUT,
       I_DF_WIN, I_DF_QN, I_DF_KN, I_DF_LQ1, I_DF_LK1, I_DF_LQ2, I_DF_LK2, I_DF_SUBG, I_DF_WOUT, I_SG_WIN, I_SG_LNG, I_SG_LNB, I_SG_WS, I_SG_BS, I_SG_WOUT,
       I_ROUTER, I_WGATE, I_WUP, I_WDOWN };
struct Frame {
    LAS unsigned char* lds;
    int tid, lane, wave, vcu, G;
    unsigned char* ws; float* out;
};
struct InPtrs {
    volatile LAS unsigned* tab;
    __device__ __forceinline__ const float* operator[](int i) const {
        const unsigned lo = __builtin_amdgcn_readfirstlane(tab[2 * i]), hi = __builtin_amdgcn_readfirstlane(tab[2 * i + 1]);
        return (const float*)(const GAS float*)(((unsigned long long)hi << 32) | lo);
    }
};
__device__ __forceinline__ bf16* xb_row(const Frame& F, int row) { return (bf16*)(F.ws + WS_XB) + (size_t)row * D; }

constexpr int TR_SROW = 136, TR_WAVE_BYTES = 64 * TR_SROW;
typedef short tr_v4i16 __attribute__((ext_vector_type(4)));
__device__ __forceinline__ void transpose_item(const float* W, int N, int k0, int n0, int ncols  , bf16* WT, int K, int drow0, LAS unsigned char* scr, int lane, const float* kscale = nullptr  ) {
    const int r4 = lane >> 4, c4 = (lane & 15) * 4;
    const bool ld_ok = c4 < ncols;
    f32x4 v[16];
    const float* src = W + (size_t)(k0 + r4) * N + n0 + c4;
#pragma unroll
    for (int i = 0; i < 16; ++i) v[i] = ld_ok ? __builtin_nontemporal_load((const f32x4*)(src + (size_t)(4 * i) * N)) : (f32x4){0.f, 0.f, 0.f, 0.f};
#pragma unroll
    for (int i = 0; i < 16; ++i) { if (kscale) v[i] = v[i] * kscale[k0 + 4 * i + r4]; v2u w; w.x = pk2(v[i].x, v[i].y); w.y = pk2(v[i].z, v[i].w); *(LAS v2u*)(scr + (4 * i + r4) * TR_SROW + c4 * 2) = w; }
    LDS_WAIT(); asm volatile("" ::: "memory");
    const LAS unsigned char* rb = scr + ((lane >> 2) & 3) * TR_SROW + ((lane >> 4) * 16 + (lane & 3) * 4) * 2;
    v2u o[16];
#pragma unroll
    for (int k4 = 0; k4 < 16; ++k4) { const tr_v4i16 t = __builtin_amdgcn_ds_read_tr16_b64_v4i16((LAS tr_v4i16*)(rb + k4 * 4 * TR_SROW)); o[k4] = __builtin_bit_cast(v2u, t); }
    LDS_WAIT(); asm volatile("" ::: "memory");
    if (lane < ncols) { v4u* dst = (v4u*)(WT + (size_t)(drow0 + lane) * K + k0);
#pragma unroll
        for (int j = 0; j < 8; ++j) dst[j] = (v4u){o[2 * j].x, o[2 * j].y, o[2 * j + 1].x, o[2 * j + 1].y}; }
}
__device__ __forceinline__ int tr_items(int K, int N) { return (K / 64) * ((N + 63) / 64); }
__device__ __forceinline__ void tr_run(const float* W, int K, int N, bf16* WT, int r, LAS unsigned char* scr, int lane, const float* kscale = nullptr) {
    const int nblk = (N + 63) / 64, kb = r / nblk, nb = r % nblk, k0 = kb * 64, n0 = nb * 64;
    transpose_item(W, N, k0, n0, (N - n0) < 64 ? (N - n0) : 64, WT, K, n0, scr, lane, kscale);
}

__device__ __forceinline__ void p0_prologue(Frame& F, const InPtrs& A) {
    {
        LAS float* sv = (LAS float*)F.lds;
        LAS float* red = (LAS float*)(F.lds + 36864);
        bool have = false;
        for (int it = blockIdx.x; it < 96; it += F.G) {
            if (!have) {
                for (int i = F.tid; i < 9 * 1024; i += NTHREADS) { const int r = i >> 10, k = i & 1023; const float v = r < 8 ? A[I_C][r * 1024 + k] : A[I_CCTX][k]; sv[i] = v / (1.0f + __expf(-v)); }
                __syncthreads(); have = true;
            }
            const int layer = it / 24, cb = it % 24, col = cb * 256 + 4 * F.lane, kbase = F.wave * 128;
            const float* W = A[I_ADAW] + (size_t)layer * 1024 * 6144 + col;
            f32x4 acc[9];
#pragma unroll
            for (int r = 0; r < 9; ++r) acc[r] = (f32x4){0.f, 0.f, 0.f, 0.f};
#pragma unroll 4
            for (int k = 0; k < 128; ++k) { const f32x4 w = *(const f32x4*)(W + (size_t)(kbase + k) * 6144);
#pragma unroll
                for (int r = 0; r < 9; ++r) acc[r] += w * sv[r * 1024 + kbase + k]; }
#pragma unroll
            for (int r = 0; r < 9; ++r) *(LAS f32x4*)(red + (F.wave * 9 + r) * 256 + 4 * F.lane) = acc[r];
            __syncthreads();
            float* MODp = (float*)(F.ws + WS_MOD) + (size_t)layer * 9 * 6144;
            for (int o = F.tid; o < 9 * 256; o += NTHREADS) { const int r = o >> 8, cc = o & 255; float s = 0.f;
#pragma unroll
                for (int w = 0; w < 8; ++w) s += red[(w * 9 + r) * 256 + cc];
                MODp[r * 6144 + cb * 256 + cc] = s + A[I_ADAB][layer * 6144 + cb * 256 + cc]; }
            __syncthreads();
        }
        __syncthreads();
    }
    const int gtid = F.vcu * NTHREADS + F.tid, GT = F.G * NTHREADS;
    {
        float* ca = (float*)(F.ws + WS_ROPEA); float* sa = ca + 4096 * 16; float* cb = (float*)(F.ws + WS_ROPEB); float* sb = cb + 4096 * 32;
        for (int i = gtid; i < 4096 * 16; i += GT) { const int t = i >> 4, j = i & 15, f = j & 7; const float pos = (float)(j < 8 ? (t >> 6) : (t & 63));
            const float inv = powf(10000.0f, -(float)f / 8.0f), ang = pos * inv; ca[i] = cosf(ang); sa[i] = sinf(ang); }
        for (int i = gtid; i < 4096 * 32; i += GT) { const int t = i >> 5, j = i & 31, f = j & 15; const float pos = (float)(j < 16 ? (t >> 6) : (t & 63));
            const float inv = powf(10000.0f, -(float)f / 16.0f), ang = pos * inv; cb[i] = cosf(ang); sb[i] = sinf(ang); }
    }
    {
        for (int j = 0; j < 2; ++j) { v4u* z = (v4u*)(F.ws + WS_WNM + j * MLA_W_STRIDE + MLA_WIN + (size_t)800 * 1024 * 2);
            for (int i = gtid; i < 224 * 1024 * 2 / 16; i += GT) z[i] = (v4u){0u, 0u, 0u, 0u}; }
        bf16* wsA = (bf16*)(F.ws + WS_SG_WS); const float* wsrc = A[I_SG_WS];
        for (int i = gtid; i < 8 * 256 * 128 / 2; i += GT) { const int e0 = i * 2, g = e0 >> 15, p = (e0 >> 7) & 255, q = e0 & 127;
            unsigned w = 0u; if (p < 128) { const float* s = wsrc + ((size_t)g * 128 + p) * 128 + q; w = pk2(s[0], s[1]); }
            ((unsigned*)wsA)[i] = w; }
    }
    {
        LAS unsigned char* scr = F.lds + F.wave * TR_WAVE_BYTES;
        const int gw = F.vcu * NWAVES + F.wave, NGW = F.G * NWAVES;
        const int n_win = tr_items(1024, 800), n_wuq = tr_items(512, 1536), n_wukv = tr_items(256, 2048), n_wout = tr_items(1024, 1024);
        const int n_mla = n_win + n_wuq + n_wukv + n_wout;
        const int n_dwin = tr_items(1024, 3072), n_dwout = tr_items(1024, 1024), n_swin = tr_items(1024, 4096), n_swout = tr_items(2048, 1024);
        const int total = 2 * n_mla + n_dwin + n_dwout + n_swin + n_swout;
        for (int it = gw; it < total; it += NGW) {
            int r = it;
            if (r < 2 * n_mla) { const int j = r / n_mla; r -= j * n_mla; unsigned char* wb = F.ws + WS_WNM + j * MLA_W_STRIDE;
                if (r < n_win) { tr_run(A[I_MLA_WIN] + (size_t)j * 1024 * 800, 1024, 800, (bf16*)(wb + MLA_WIN), r, scr, F.lane); continue; } r -= n_win;
                if (r < n_wuq) { tr_run(A[I_MLA_WUQ] + (size_t)j * 512 * 1536, 512, 1536, (bf16*)(wb + MLA_WUQ), r, scr, F.lane, A[I_MLA_QNG] + j * 512); continue; } r -= n_wuq;
                if (r < n_wukv) { tr_run(A[I_MLA_WUKV] + (size_t)j * 256 * 2048, 256, 2048, (bf16*)(wb + MLA_WUKV), r, scr, F.lane, A[I_MLA_KVNG] + j * 256); continue; } r -= n_wukv;
                tr_run(A[I_MLA_WOUT] + (size_t)j * 1024 * 1024, 1024, 1024, (bf16*)(wb + MLA_WOUT), r, scr, F.lane); continue; }
            r -= 2 * n_mla;
            if (r < n_dwin) { tr_run(A[I_DF_WIN], 1024, 3072, (bf16*)(F.ws + WS_DIFF_WIN), r, scr, F.lane); continue; } r -= n_dwin;
            if (r < n_dwout) { tr_run(A[I_DF_WOUT], 1024, 1024, (bf16*)(F.ws + WS_DIFF_WOUT), r, scr, F.lane); continue; } r -= n_dwout;
            if (r < n_swin) { tr_run(A[I_SG_WIN], 1024, 4096, (bf16*)(F.ws + WS_SG_WIN), r, scr, F.lane); continue; } r -= n_swin;
            tr_run(A[I_SG_WOUT], 2048, 1024, (bf16*)(F.ws + WS_SG_WOUT), r, scr, F.lane);
        }
    }
}
__device__ __forceinline__ void moe_weight_item(Frame& F, const InPtrs& A, int layer, int it, LAS unsigned char* scr) {
    constexpr int PER = 16 * 16;
    const int which = it / (16 * PER), r0 = it % (16 * PER), e = r0 / PER, r = r0 % PER, kb = r >> 4, nb = r & 15, k0 = kb * 64, n0 = nb * 64;
    const size_t eoff = ((size_t)layer * 16 + e) * 1024 * 1024;
    if (which == 0) transpose_item(A[I_WGATE] + eoff, 1024, k0, n0, 64, (bf16*)(F.ws + WS_WGU), 1024, e * 2048 + (n0 >> 7) * 256 + (n0 & 127), scr, F.lane);
    else if (which == 1) transpose_item(A[I_WUP] + eoff, 1024, k0, n0, 64, (bf16*)(F.ws + WS_WGU), 1024, e * 2048 + (n0 >> 7) * 256 + 128 + (n0 & 127), scr, F.lane);
    else transpose_item(A[I_WDOWN] + eoff, 1024, k0, n0, 64, (bf16*)(F.ws + WS_WDN), 1024, e * 1024 + n0, scr, F.lane);
}
constexpr int MOE_CONV_ITEMS = 3 * 16 * 16 * 16;
__device__ __forceinline__ void moe_weight_items(Frame& F, const InPtrs& A, int layer) {
    LAS unsigned char* scr = F.lds + F.wave * TR_WAVE_BYTES;
    const int gw = F.vcu * NWAVES + F.wave, NGW = F.G * NWAVES;
    for (int it = gw; it < MOE_CONV_ITEMS; it += NGW) moe_weight_item(F, A, layer, it, scr);
}
constexpr int CONV_LDS_OFF = 69632;
__device__ __forceinline__ int conv_rounds(const Frame& F) { return F.G >= 256 ? 6 : (F.G >= 128 ? 12 : (MOE_CONV_ITEMS + F.G * NWAVES - 1) / (F.G * NWAVES)); }
__device__ __forceinline__ void moe_weight_round(Frame& F, const InPtrs& A, int layer, int round) {
    const int it = round * (F.G * NWAVES) + F.vcu * NWAVES + F.wave;
    Frame Fc = F; { int l_ = F.lane; asm volatile("" : "+v"(l_)); Fc.lane = l_; }
    if (it < MOE_CONV_ITEMS) moe_weight_item(Fc, A, layer, it, F.lds + CONV_LDS_OFF + F.wave * TR_WAVE_BYTES);
}
template <bool FFN, bool FIRST>
__device__ __forceinline__ void norm_phase(Frame& F, const InPtrs& A, int layer, bool combine, int nrows, float cmul = 1.0f) {
    constexpr bool first = FIRST;
    const int gw = F.vcu * NWAVES + F.wave, NGW = F.G * NWAVES, lane = F.lane;
    const float* MOD = (const float*)(F.ws + WS_MOD);
    LAS float* rT = (LAS float*)F.lds;
    if (FFN) {
        const float* R = A[I_ROUTER] + (size_t)layer * 1024 * 16;
        for (int i = F.tid; i < 16 * 1024; i += NTHREADS) { const int k = i >> 4, e = i & 15; rT[e * 1024 + k] = R[i]; }
        __syncthreads();
    }
#define NPC(q) (8 * (64 * ((q) >> 1) + lane) + 4 * ((q) & 1))
    const float* gvec = (FFN ? A[I_NFFN] : A[I_NMIX]) + layer * 1024;
    f32x4 gn[4];
#pragma unroll
    for (int j = 0; j < 4; ++j) gn[j] = *(const f32x4*)(gvec + NPC(j));
    const bf16* YB = (const bf16*)(F.ws + R_YB);
    const int* SLOT = (const int*)(F.ws + WS_SLOT);
    const float* A_x = first ? A[I_X] : nullptr; const float* A_c = first ? A[I_CTX] : nullptr;
    f32x4 xaf[4], xbf[4]; v4u xab[2], xbb[2]; int sla = -1, slb = -1;
    v4u wB[4][2], wC[4][2]; int sB[4] = {-1, -1, -1, -1}, sC[4] = {-1, -1, -1, -1}; unsigned restB = 0u, restC = 0u;
#define NP_LOADX(mm, XF, XB_, SL) do { if (first) { const float* src_ = (mm) < NLAT ? A_x + (size_t)(mm) * D : A_c + (size_t)((mm) - NLAT) * D; \
        _Pragma("unroll") for (int j = 0; j < 4; ++j) XF[j] = *(const f32x4*)(src_ + NPC(j)); } \
      else { const bf16* src_ = xb_row(F, (mm)); _Pragma("unroll") for (int k = 0; k < 2; ++k) XB_[k] = *(const v4u*)(src_ + NPC(2 * k)); } \
      if (combine) SL = SLOT[(size_t)(mm) * 16 + (lane & 15)]; } while (0)
#define NP_LOADW(SL, W, SI, REST) do { unsigned msk_ = (unsigned)(__ballot((SL) >= 0) & 0xffffull); \
        _Pragma("unroll") for (int q = 0; q < 4; ++q) { SI[q] = -1; if (msk_) { const int e_ = __builtin_ctz(msk_); msk_ &= msk_ - 1u; SI[q] = __builtin_amdgcn_readlane((SL), e_); } } \
        REST = msk_; \
        _Pragma("unroll") for (int q = 0; q < 4; ++q) if (SI[q] >= 0) { const bf16* y_ = YB + (size_t)SI[q] * 1024; \
            _Pragma("unroll") for (int k = 0; k < 2; ++k) W[q][k] = *(const v4u*)(y_ + NPC(2 * k)); } } while (0)
    if (gw < nrows) { NP_LOADX(gw, xbf, xbb, slb); }
    if (gw + NGW < nrows) { NP_LOADX(gw + NGW, xaf, xab, sla); }
    if (combine && gw < nrows) { NP_LOADW(slb, wB, sB, restB); }
    for (int m = gw; m < nrows; m += NGW) {
        const bool lat = m < NLAT; const int rr = lat ? (m >> 12) : 8;
        f32x4 v[4]; const int slc = slb;
#pragma unroll
        for (int k = 0; k < 2; ++k) { v[2 * k] = first ? xbf[2 * k] : (f32x4){bflo(xbb[k].x), bfhi(xbb[k].x), bflo(xbb[k].y), bfhi(xbb[k].y)}; v[2 * k + 1] = first ? xbf[2 * k + 1] : (f32x4){bflo(xbb[k].z), bfhi(xbb[k].z), bflo(xbb[k].w), bfhi(xbb[k].w)}; }
#pragma unroll
        for (int q = 0; q < 4; ++q) { sC[q] = sB[q]; wC[q][0] = wB[q][0]; wC[q][1] = wB[q][1]; }
        restC = restB;
#pragma unroll
        for (int j = 0; j < 4; ++j) xbf[j] = xaf[j];
        xbb[0] = xab[0]; xbb[1] = xab[1];
        slb = sla;
        { const int m2 = m + 2 * NGW; if (m2 < nrows) { NP_LOADX(m2, xaf, xab, sla); } }
        if (combine) { if (m + NGW < nrows) { NP_LOADW(slb, wB, sB, restB); } }
        if (combine) {
            f32x4 acc[4];
#pragma unroll
            for (int j = 0; j < 4; ++j) acc[j] = (f32x4){0.f, 0.f, 0.f, 0.f};
#pragma unroll
            for (int q = 0; q < 4; ++q) if (sC[q] >= 0) {
#pragma unroll
                for (int k = 0; k < 2; ++k) { acc[2 * k] += (f32x4){bflo(wC[q][k].x), bfhi(wC[q][k].x), bflo(wC[q][k].y), bfhi(wC[q][k].y)}; acc[2 * k + 1] += (f32x4){bflo(wC[q][k].z), bfhi(wC[q][k].z), bflo(wC[q][k].w), bfhi(wC[q][k].w)}; } }
            while (restC) {
                const int e = __builtin_ctz(restC); restC &= restC - 1u; const int sidx = __builtin_amdgcn_readlane(slc, e);
                const bf16* y = YB + (size_t)sidx * 1024;
#pragma unroll
                for (int k = 0; k < 2; ++k) { const v4u w = *(const v4u*)(y + NPC(2 * k)); acc[2 * k] += (f32x4){bflo(w.x), bfhi(w.x), bflo(w.y), bfhi(w.y)}; acc[2 * k + 1] += (f32x4){bflo(w.z), bfhi(w.z), bflo(w.w), bfhi(w.w)}; }
            }
            const float* g2 = MOD + ((size_t)(layer - 1) * 9 + rr) * 6144 + 5120;
#pragma unroll
            for (int j = 0; j < 4; ++j) v[j] += *(const f32x4*)(g2 + NPC(j)) * acc[j] * cmul;
        }
        if (first || combine) { bf16* dst = xb_row(F, m);
#pragma unroll
            for (int k = 0; k < 2; ++k) { v4u w; w.x = pk2(v[2 * k].x, v[2 * k].y); w.y = pk2(v[2 * k].z, v[2 * k].w); w.z = pk2(v[2 * k + 1].x, v[2 * k + 1].y); w.w = pk2(v[2 * k + 1].z, v[2 * k + 1].w);
                *(v4u*)(dst + NPC(2 * k)) = w;
                v[2 * k] = (f32x4){bflo(w.x), bfhi(w.x), bflo(w.y), bfhi(w.y)}; v[2 * k + 1] = (f32x4){bflo(w.z), bfhi(w.z), bflo(w.w), bfhi(w.w)}; } }
        float ss = 0.f;
#pragma unroll
        for (int j = 0; j < 4; ++j) ss += (v[j].x * v[j].x + v[j].y * v[j].y) + (v[j].z * v[j].z + v[j].w * v[j].w);
        const float r = 1.0f / sqrtf(wave_sum(ss) * (1.0f / D) + EPS);
        const float* mrow = MOD + ((size_t)layer * 9 + rr) * 6144 + (FFN ? 3072 : 0);
        f32x4 h[4];
#pragma unroll
        for (int j = 0; j < 4; ++j) { const f32x4 sh = *(const f32x4*)(mrow + NPC(j)), sc = *(const f32x4*)(mrow + 1024 + NPC(j));
            h[j] = (v[j] * r * gn[j]) * (sc + 1.0f) + sh; }
        bf16* hrow = (bf16*)(F.ws + WS_H) + (size_t)m * D;
#pragma unroll
        for (int k = 0; k < 2; ++k) { v4u w; w.x = pk2(h[2 * k].x, h[2 * k].y); w.y = pk2(h[2 * k].z, h[2 * k].w); w.z = pk2(h[2 * k + 1].x, h[2 * k + 1].y); w.w = pk2(h[2 * k + 1].z, h[2 * k + 1].w); *(v4u*)(hrow + NPC(2 * k)) = w; }
        if (FFN) {
            float lg[16];
            LAS float* rTm = rT + 8 * lane; asm volatile("" : "+v"(rTm));
#pragma unroll
            for (int e = 0; e < 16; ++e) { float s = 0.f;
#pragma unroll
                for (int j = 0; j < 4; ++j) { const f32x4 w = *(const LAS f32x4*)(rTm + e * 1024 + 512 * (j >> 1) + 4 * (j & 1)); s += (h[j].x * w.x + h[j].y * w.y) + (h[j].z * w.z + h[j].w * w.w); }
                lg[e] = wave_sum(s); }
            float mx = lg[0];
#pragma unroll
            for (int e = 1; e < 16; ++e) mx = fmaxf(mx, lg[e]);
            float den = 0.f;
#pragma unroll
            for (int e = 0; e < 16; ++e) { lg[e] = expf(lg[e] - mx); den += lg[e]; }
            float mine = 0.f;
#pragma unroll
            for (int e = 0; e < 16; ++e) mine = (lane == e) ? lg[e] : mine;
            if (lane < 16) { ((float*)(F.ws + WS_AFF))[(size_t)m * 16 + lane] = mine / den; ((int*)(F.ws + WS_SLOT))[(size_t)m * 16 + lane] = -1; }
        }
    }
}
#undef NP_LOADX
#undef NP_LOADW
#undef NPC
__device__ __forceinline__ void final_phase(Frame& F, int layer) {
    const int gw = F.vcu * NWAVES + F.wave, NGW = F.G * NWAVES, lane = F.lane;
    const float* MOD = (const float*)(F.ws + WS_MOD);
    const bf16* YB = (const bf16*)(F.ws + R_YB); const int* SLOT = (const int*)(F.ws + WS_SLOT);
    v2u vn[4]; int sln = -1;
    if (gw < NLAT) { const bf16* src = xb_row(F, gw);
#pragma unroll
        for (int j = 0; j < 4; ++j) vn[j] = *(const v2u*)(src + 4 * (64 * j + lane));
        sln = SLOT[(size_t)gw * 16 + (lane & 15)]; }
    for (int m = gw; m < NLAT; m += NGW) {
        float* xr = F.out + (size_t)m * D; const int rr = m >> 12;
        f32x4 v[4]; const int sl = sln;
#pragma unroll
        for (int j = 0; j < 4; ++j) v[j] = (f32x4){bflo(vn[j].x), bfhi(vn[j].x), bflo(vn[j].y), bfhi(vn[j].y)};
        { const int mn = m + NGW; if (mn < NLAT) { const bf16* src = xb_row(F, mn);
#pragma unroll
            for (int j = 0; j < 4; ++j) vn[j] = *(const v2u*)(src + 4 * (64 * j + lane));
            sln = SLOT[(size_t)mn * 16 + (lane & 15)]; } }
        f32x4 acc[4];
#pragma unroll
        for (int j = 0; j < 4; ++j) acc[j] = (f32x4){0.f, 0.f, 0.f, 0.f};
        unsigned msk = (unsigned)(__ballot(sl >= 0) & 0xffffull);
        while (msk) {
            int sidx[4]; v2u w[4][4];
#pragma unroll
            for (int q = 0; q < 4; ++q) { sidx[q] = -1; if (msk) { const int e = __builtin_ctz(msk); msk &= msk - 1u; sidx[q] = __builtin_amdgcn_readlane(sl, e); } }
#pragma unroll
            for (int q = 0; q < 4; ++q) if (sidx[q] >= 0) { const bf16* y = YB + (size_t)sidx[q] * 1024;
#pragma unroll
                for (int j = 0; j < 4; ++j) w[q][j] = *(const v2u*)(y + 4 * (64 * j + lane)); }
#pragma unroll
            for (int q = 0; q < 4; ++q) if (sidx[q] >= 0) {
#pragma unroll
                for (int j = 0; j < 4; ++j) acc[j] += (f32x4){bflo(w[q][j].x), bfhi(w[q][j].x), bflo(w[q][j].y), bfhi(w[q][j].y)}; }
        }
        const float* g2 = MOD + ((size_t)layer * 9 + rr) * 6144 + 5120;
#pragma unroll
        for (int j = 0; j < 4; ++j) *(f32x4*)(xr + 4 * (64 * j + lane)) = v[j] + *(const f32x4*)(g2 + 4 * (64 * j + lane)) * acc[j];
    }
}
__device__ __forceinline__ void unpack8(const v4u w, float* f) { f[0] = bflo(w.x); f[1] = bfhi(w.x); f[2] = bflo(w.y); f[3] = bfhi(w.y); f[4] = bflo(w.z); f[5] = bfhi(w.z); f[6] = bflo(w.w); f[7] = bfhi(w.w); }
__device__ __forceinline__ v4u pack8(const float* f) { v4u w; w.x = pk2(f[0], f[1]); w.y = pk2(f[2], f[3]); w.z = pk2(f[4], f[5]); w.w = pk2(f[6], f[7]); return w; }
__device__ __forceinline__ void unpack4(const v2u w, float* f) { f[0] = bflo(w.x); f[1] = bfhi(w.x); f[2] = bflo(w.y); f[3] = bfhi(w.y); }
__device__ __forceinline__ v2u pack4(const float* f) { v2u w; w.x = pk2(f[0], f[1]); w.y = pk2(f[2], f[3]); return w; }

struct MfRow { v4u cq; v2u ckv; v4u k0, k1; v2u kr0, kr1; v4u v0, v1; f32x4 cs, sn; };
__device__ __forceinline__ void mf_load(MfRow& R, int m, const bf16* KVPRE, const bf16* DOWN, const float* ca, const float* sa, int lane, int h, int p) {
    const bf16* dr = DOWN + (size_t)m * 1024;
    R.cq = *(const v4u*)(dr + 8 * lane); R.ckv = *(const v2u*)(dr + 512 + 4 * lane);
    const bf16* s = KVPRE + (size_t)m * 2048 + h * 128; const bf16* kr = dr + 768;
    { const v4u* pp = (const v4u*)(s + 16 * p); R.k0 = pp[0]; R.k1 = pp[1]; R.kr0 = *(const v2u*)(kr + 4 * p); R.kr1 = *(const v2u*)(kr + 16 + 4 * p); }
    { const v4u* vs = (const v4u*)(s + 64 + 16 * p); R.v0 = vs[0]; R.v1 = vs[1]; }
    if (m < NLAT) { const int t = m & 4095; R.cs = *(const f32x4*)(ca + t * 16 + 4 * p); R.sn = *(const f32x4*)(sa + t * 16 + 4 * p); }
    else { R.cs = (f32x4){1.f, 1.f, 1.f, 1.f}; R.sn = (f32x4){0.f, 0.f, 0.f, 0.f}; }
}
__device__ __forceinline__ void mla_finish_phase(Frame& F, const InPtrs& A, int j) {
    const int gw = F.vcu * NWAVES + F.wave, NGW = F.G * NWAVES, lane = F.lane, h = lane >> 2, p = lane & 3;
    const bf16* DOWN = (const bf16*)(F.ws + R_DOWN); const bf16* KVPRE = (const bf16*)(F.ws + R_KVPRE);
    bf16* MK = (bf16*)(F.ws + R_MK); bf16* MV = (bf16*)(F.ws + R_MV); float* RQ = (float*)(F.ws + WS_RQ);
    const float* ca = (const float*)(F.ws + WS_ROPEA); const float* sa = ca + 4096 * 16;
    float gk[24];
    { const float* k = A[I_MLA_KN] + j * 96;
#pragma unroll
      for (int i = 0; i < 16; ++i) gk[i] = k[16 * p + i];
#pragma unroll
      for (int i = 0; i < 4; ++i) { gk[16 + i] = k[64 + 4 * p + i]; gk[20 + i] = k[80 + 4 * p + i]; } }
    MfRow N;
    if (gw < MROWS) mf_load(N, gw, KVPRE, DOWN, ca, sa, lane, h, p);
    for (int m = gw; m < MROWS; m += NGW) {
        const MfRow R = N;
        { const int mn = m + NGW; if (mn < MROWS) mf_load(N, mn, KVPRE, DOWN, ca, sa, lane, h, p); }
        const bool lat = m < NLAT; const int b = lat ? (m >> 12) : ((m - NLAT) >> 8), t = lat ? (m & 4095) : ((m - NLAT) & 255);
        float c8[8], c4[4]; unpack8(R.cq, c8); unpack4(R.ckv, c4);
        float sq = 0.f, skv = 0.f;
#pragma unroll
        for (int i = 0; i < 8; ++i) sq += c8[i] * c8[i];
#pragma unroll
        for (int i = 0; i < 4; ++i) skv += c4[i] * c4[i];
        sq = wave_sum(sq); skv = wave_sum(skv);
        const float rq = 1.0f / sqrtf(sq * (1.0f / 512.0f) + EPS), rkv = 1.0f / sqrtf(skv * (1.0f / 256.0f) + EPS);
        if (lane == 0) RQ[m] = rq;
        float v[24]; unpack8(R.k0, v); unpack8(R.k1, v + 8); unpack4(R.kr0, v + 16); unpack4(R.kr1, v + 20);
#pragma unroll
        for (int i = 0; i < 16; ++i) v[i] *= rkv;
        float ss = 0.f;
#pragma unroll
        for (int i = 0; i < 24; ++i) ss += v[i] * v[i];
        ss += shx<1>(ss); ss += shx<2>(ss);
        const float r = 1.0f / sqrtf(ss * (1.0f / 96.0f) + EPS);
#pragma unroll
        for (int i = 0; i < 24; ++i) v[i] = v[i] * r * gk[i];
#pragma unroll
        for (int i = 0; i < 4; ++i) { const float x1 = v[16 + i], x2 = v[20 + i]; v[16 + i] = x1 * R.cs[i] - x2 * R.sn[i]; v[20 + i] = x1 * R.sn[i] + x2 * R.cs[i]; }
        const int key = lat ? 256 + t : t;
        bf16* d = MK + (((size_t)b * 16 + h) * NKEYS + key) * 96;
        { v4u* o = (v4u*)(d + 16 * p); o[0] = pack8(v); o[1] = pack8(v + 8); *(v2u*)(d + 64 + 4 * p) = pack4(v + 16); *(v2u*)(d + 80 + 4 * p) = pack4(v + 20); }
        float vv[16]; unpack8(R.v0, vv); unpack8(R.v1, vv + 8);
#pragma unroll
        for (int i = 0; i < 16; ++i) vv[i] *= rkv;
        v4u* vd = (v4u*)(MV + (((size_t)b * 16 + h) * NKEYS + key) * 64 + 16 * p);
        vd[0] = pack8(vv); vd[1] = pack8(vv + 8);
    }
}
struct DqRow { v4u q0, q1, k0, k1; f32x4 c0, c1, s0, s1; };
__device__ __forceinline__ void dq_load(DqRow& R, int m, const bf16* QKV, const float* cb, const float* sb, int u, int p) {
    const bf16* s = QKV + (size_t)m * 3072 + u * 64;
    R.q0 = *(const v4u*)(s + 8 * p); R.q1 = *(const v4u*)(s + 32 + 8 * p); R.k0 = *(const v4u*)(s + 1024 + 8 * p); R.k1 = *(const v4u*)(s + 1024 + 32 + 8 * p);
    if (m < NLAT) { const int t = m & 4095; R.c0 = *(const f32x4*)(cb + t * 32 + 8 * p); R.c1 = *(const f32x4*)(cb + t * 32 + 8 * p + 4); R.s0 = *(const f32x4*)(sb + t * 32 + 8 * p); R.s1 = *(const f32x4*)(sb + t * 32 + 8 * p + 4); }
    else { R.c0 = R.c1 = (f32x4){1.f, 1.f, 1.f, 1.f}; R.s0 = R.s1 = (f32x4){0.f, 0.f, 0.f, 0.f}; }
}
__device__ __forceinline__ void diff_finish_qk_phase(Frame& F, const InPtrs& A) {
    const int gw = F.vcu * NWAVES + F.wave, NGW = F.G * NWAVES, lane = F.lane, u = lane >> 2, p = lane & 3;
    const bf16* QKV = (const bf16*)(F.ws + R_QKV);
    bf16* DQ = (bf16*)(F.ws + R_DQ); bf16* DQC = (bf16*)(F.ws + R_DQC); bf16* DK = (bf16*)(F.ws + R_DK);
    const float* cb = (const float*)(F.ws + WS_ROPEB); const float* sb = cb + 4096 * 32;
    float gq[16], gk[16];
    { const float* qn = A[I_DF_QN]; const float* kn = A[I_DF_KN];
#pragma unroll
      for (int i = 0; i < 8; ++i) { gq[i] = qn[8 * p + i] * att::Sc<64>::C; gq[8 + i] = qn[32 + 8 * p + i] * att::Sc<64>::C; gk[i] = kn[8 * p + i]; gk[8 + i] = kn[32 + 8 * p + i]; } }
    DqRow N;
    if (gw < MROWS) dq_load(N, gw, QKV, cb, sb, u, p);
    for (int m = gw; m < MROWS; m += NGW) {
        const DqRow R = N;
        { const int mn = m + NGW; if (mn < MROWS) dq_load(N, mn, QKV, cb, sb, u, p); }
        const bool lat = m < NLAT; const int b = lat ? (m >> 12) : ((m - NLAT) >> 8), t = lat ? (m & 4095) : ((m - NLAT) & 255);
        float cs[8], sn[8];
#pragma unroll
        for (int i = 0; i < 4; ++i) { cs[i] = R.c0[i]; cs[4 + i] = R.c1[i]; sn[i] = R.s0[i]; sn[4 + i] = R.s1[i]; }
#pragma unroll
        for (int isk = 0; isk < 2; ++isk) {
            float v[16]; unpack8(isk ? R.k0 : R.q0, v); unpack8(isk ? R.k1 : R.q1, v + 8);
            float ss = 0.f;
#pragma unroll
            for (int i = 0; i < 16; ++i) ss += v[i] * v[i];
            ss += shx<1>(ss); ss += shx<2>(ss);
            const float r = 1.0f / sqrtf(ss * (1.0f / 64.0f) + EPS);
#pragma unroll
            for (int i = 0; i < 16; ++i) v[i] = v[i] * r * (isk ? gk[i] : gq[i]);
#pragma unroll
            for (int i = 0; i < 8; ++i) { const float x1 = v[i], x2 = v[8 + i]; v[i] = x1 * cs[i] - x2 * sn[i]; v[8 + i] = x1 * sn[i] + x2 * cs[i]; }
            bf16* d;
            if (isk) d = DK + (((size_t)b * 16 + u) * NKEYS + (lat ? 256 + t : t)) * 64;
            else d = lat ? DQ + (((size_t)b * 16 + u) * 4096 + t) * 64 : DQC + (((size_t)b * 16 + u) * 256 + t) * 64;
            *(v4u*)(d + 8 * p) = pack8(v); *(v4u*)(d + 32 + 8 * p) = pack8(v + 8);
        }
    }
}
__device__ __forceinline__ void diff_finish_o_phase(Frame& F, const InPtrs& A, float lam_init) {
    const int gw = F.vcu * NWAVES + F.wave, NGW = F.G * NWAVES, lane = F.lane, h = lane >> 3, p = lane & 7;
    const bf16* OB = (const bf16*)(F.ws + R_OB); bf16* AO = (bf16*)(F.ws + R_DAO);
    const float d1 = wave_sum(A[I_DF_LQ1][lane] * A[I_DF_LK1][lane]), d2 = wave_sum(A[I_DF_LQ2][lane] * A[I_DF_LK2][lane]);
    const float lam = expf(d1) - expf(d2) + lam_init, post = 1.0f - lam_init;
    float g[16];
    { const float* sg = A[I_DF_SUBG];
#pragma unroll
      for (int i = 0; i < 16; ++i) g[i] = sg[16 * p + i] * post; }
    v4u n0 = (v4u){0u, 0u, 0u, 0u}, n1 = n0, n2 = n0, n3 = n0;
    if (gw < MROWS) { const bf16* s0 = OB + (size_t)gw * 2048 + (2 * h) * 128 + 16 * p; n0 = ((const v4u*)s0)[0]; n1 = ((const v4u*)s0)[1]; n2 = ((const v4u*)(s0 + 128))[0]; n3 = ((const v4u*)(s0 + 128))[1]; }
    for (int m = gw; m < MROWS; m += NGW) {
        const v4u c0 = n0, c1 = n1, c2 = n2, c3 = n3;
        { const int mn = m + NGW; if (mn < MROWS) { const bf16* s0 = OB + (size_t)mn * 2048 + (2 * h) * 128 + 16 * p; n0 = ((const v4u*)s0)[0]; n1 = ((const v4u*)s0)[1]; n2 = ((const v4u*)(s0 + 128))[0]; n3 = ((const v4u*)(s0 + 128))[1]; } }
        float a[16], c[16];
        unpack8(c0, a); unpack8(c1, a + 8); unpack8(c2, c); unpack8(c3, c + 8);
        float ss = 0.f;
#pragma unroll
        for (int i = 0; i < 16; ++i) { a[i] = a[i] - lam * c[i]; ss += a[i] * a[i]; }
        ss += shx<1>(ss); ss += shx<2>(ss); ss += shx<4>(ss);
        const float r = 1.0f / sqrtf(ss * (1.0f / 128.0f) + EPS);
#pragma unroll
        for (int i = 0; i < 16; ++i) a[i] = a[i] * r * g[i];
        v4u* o = (v4u*)(AO + (size_t)m * 1024 + h * 128 + 16 * p); o[0] = pack8(a); o[1] = pack8(a + 8);
    }
}
__device__ __forceinline__ void sg_ln_item(Frame& F, const InPtrs& A, int chunk, int g_lo, int g_hi) {
    const bf16* Z = (const bf16*)(F.ws + R_Z); bf16* VNT = (bf16*)(F.ws + R_VNT);
    LAS float* st = (LAS float*)F.lds;
    LAS unsigned short* T = (LAS unsigned short*)(F.lds + 1024);
    constexpr int TS = 258;
    const int lane = F.lane, tid = F.tid;
    {
        const bf16* vr0 = Z + ((size_t)chunk * 128 + F.wave * 16) * 4096 + 2048;
        v4u nx[4];
#pragma unroll
        for (int i = 0; i < 4; ++i) nx[i] = *(const v4u*)(vr0 + 8 * (lane + 64 * i));
        for (int qi = 0; qi < 16; ++qi) {
            float x[32];
#pragma unroll
            for (int i = 0; i < 4; ++i) unpack8(nx[i], x + 8 * i);
            if (qi < 15) {
#pragma unroll
                for (int i = 0; i < 4; ++i) nx[i] = *(const v4u*)(vr0 + (size_t)(qi + 1) * 4096 + 8 * (lane + 64 * i)); }
            float s = 0.f;
#pragma unroll
            for (int i = 0; i < 32; ++i) s += x[i];
            const float mean = wave_sum(s) * (1.0f / 2048.0f); float s2 = 0.f;
#pragma unroll
            for (int i = 0; i < 32; ++i) { const float d = x[i] - mean; s2 += d * d; }
            const float rstd = 1.0f / sqrtf(wave_sum(s2) * (1.0f / 2048.0f) + EPS);
            const int q = F.wave * 16 + qi;
            if (lane == 0) { st[2 * q] = mean; st[2 * q + 1] = rstd; }
        }
    }
    __syncthreads();
    for (int g = g_lo; g < g_hi; ++g) {
        v4u xin[8];
#pragma unroll
        for (int i = 0; i < 8; ++i) { const int id = tid + 512 * i, q = id >> 5, c0 = (id & 31) * 8; xin[i] = *(const v4u*)(Z + ((size_t)chunk * 128 + q) * 4096 + 2048 + g * 256 + c0); }
#pragma unroll
        for (int i = 0; i < 8; ++i) { const int id = tid + 512 * i, q = id >> 5, c0 = (id & 31) * 8;
            float x[8]; unpack8(xin[i], x);
            const float mean = st[2 * q], rstd = st[2 * q + 1];
            const float* lg = A[I_SG_LNG] + g * 256 + c0; const float* lb = A[I_SG_LNB] + g * 256 + c0;
#pragma unroll
            for (int k = 0; k < 8; ++k) T[q * TS + c0 + k] = (unsigned short)f2bf((x[k] - mean) * rstd * lg[k] + lb[k]); }
        __syncthreads();
#pragma unroll
        for (int i = 0; i < 8; ++i) { const int id = tid + 512 * i, c = id >> 4, q0 = (id & 15) * 8;
            v4u w; w.x = (unsigned)T[(q0 + 0) * TS + c] | ((unsigned)T[(q0 + 1) * TS + c] << 16); w.y = (unsigned)T[(q0 + 2) * TS + c] | ((unsigned)T[(q0 + 3) * TS + c] << 16);
            w.z = (unsigned)T[(q0 + 4) * TS + c] | ((unsigned)T[(q0 + 5) * TS + c] << 16); w.w = (unsigned)T[(q0 + 6) * TS + c] | ((unsigned)T[(q0 + 7) * TS + c] << 16);
            *(v4u*)(VNT + (((size_t)chunk * 8 + g) * 256 + c) * 128 + q0) = w; }
        __syncthreads();
    }
}
__device__ __forceinline__ void sg_ln_phase(Frame& F, const InPtrs& A) {
    constexpr int NCH = MROWS / 128;
    const int full = (NCH / F.G) * F.G;
    for (int chunk = F.vcu; chunk < full; chunk += F.G) sg_ln_item(F, A, chunk, 0, 8);
    for (int it = F.vcu; it < (NCH - full) * 8; it += F.G) sg_ln_item(F, A, full + (it >> 3), it & 7, (it & 7) + 1);
}
__device__ __forceinline__ void topk_phase(Frame& F, int ngroups) {
    const float* AFF = (const float*)(F.ws + WS_AFF); int* SLOT = (int*)(F.ws + WS_SLOT); float* GATE = (float*)(F.ws + WS_GATE);
    int* ROWSRC = (int*)(F.ws + R_XG);
    LAS unsigned* cnt = (LAS unsigned*)F.lds;
    LAS unsigned* cgt = cnt + 16;
    LAS unsigned* ceq = cnt + 80;
    LAS unsigned* tot = cnt + 144;
    LAS int* selrow = (LAS int*)(cnt + 160);
    const int tid = F.tid, lane = F.lane, wave = F.wave;
    for (int task = blockIdx.x; task < ngroups; task += F.G) {
        const bool lat = task < 128; const int gi = lat ? task : task - 128, b = gi >> 4, e = gi & 15;
        const int N = lat ? 4096 : 256, K = lat ? CAP_LAT : CAP_CTX, row0 = lat ? b * 4096 : NLAT + b * 256;
        const int pbase = e * EROWS + (lat ? b * CAP_LAT : NB * CAP_LAT + b * CAP_CTX);
        unsigned key[8]; bool valid[8];
#pragma unroll
        for (int i = 0; i < 8; ++i) { const int t = tid + 512 * i; valid[i] = t < N; key[i] = valid[i] ? __float_as_uint(AFF[(size_t)(row0 + t) * 16 + e]) : 0u; }
        unsigned prefix = 0u;
        for (int bit = 30; bit >= 0; --bit) {
            const unsigned cand = prefix | (1u << bit); unsigned c = 0;
#pragma unroll
            for (int i = 0; i < 8; ++i) c += (unsigned)__builtin_popcountll(__ballot(valid[i] && key[i] >= cand));
            LAS unsigned* cb = cnt + 8 * (bit & 1);
            if (lane == 0) cb[wave] = c;
            __syncthreads();
            unsigned total = 0;
#pragma unroll
            for (int w = 0; w < 8; ++w) total += cb[w];
            if (total >= (unsigned)K) prefix = cand;
        }
        const unsigned T = prefix;
        unsigned long long bgt[8], beq[8];
#pragma unroll
        for (int i = 0; i < 8; ++i) { bgt[i] = __ballot(valid[i] && key[i] > T); beq[i] = __ballot(valid[i] && key[i] == T);
            if (lane == 0) { cgt[i * 8 + wave] = (unsigned)__builtin_popcountll(bgt[i]); ceq[i * 8 + wave] = (unsigned)__builtin_popcountll(beq[i]); } }
        __syncthreads();
        if (wave == 0) {
            unsigned pa = 0u, pq = 0u, ta = 0u, tq = 0u;
            for (int k = 0; k < 64; ++k) { const unsigned a = cgt[k], q = ceq[k]; ta += a; tq += q; if (k < lane) { pa += a; pq += q; } }
            LDS_WAIT();
            cgt[lane] = pa; ceq[lane] = pq;
            if (lane == 63) { tot[0] = ta; tot[1] = tq; }
        }
        __syncthreads();
        const unsigned n_gt = tot[0], need_eq = (unsigned)K - n_gt;
        const unsigned long long lmask = (1ull << lane) - 1ull;
#pragma unroll
        for (int i = 0; i < 8; ++i) {
            const bool isgt = (bgt[i] >> lane) & 1ull, iseq = (beq[i] >> lane) & 1ull;
            const unsigned pg = cgt[i * 8 + wave] + (unsigned)__builtin_popcountll(bgt[i] & lmask), pe = ceq[i * 8 + wave] + (unsigned)__builtin_popcountll(beq[i] & lmask);
            const bool sel = isgt || (iseq && pe < need_eq);
            if (sel) { const unsigned pos = isgt ? pg : n_gt + pe; const int row = row0 + tid + 512 * i;
                SLOT[(size_t)row * 16 + e] = pbase + (int)pos; GATE[pbase + pos] = __uint_as_float(key[i]); ROWSRC[pbase + pos] = row; }
        }
        __syncthreads();
        __syncthreads();
    }
}

template <int DK> __device__ __forceinline__ float att_bound(const float* gq, const float* gk, int n, int lane) {
    float mq = 0.f, mk = 0.f;
    for (int i = lane; i < n; i += 64) { mq = fmaxf(mq, fabsf(gq[i])); mk = fmaxf(mk, fabsf(gk[i])); }
    mq = fmaxf(mq, shx<1>(mq)); mq = fmaxf(mq, shx<2>(mq)); mq = fmaxf(mq, shx<4>(mq)); mq = fmaxf(mq, shx<8>(mq)); mq = fmaxf(mq, shx<16>(mq));
    mk = fmaxf(mk, shx<1>(mk)); mk = fmaxf(mk, shx<2>(mk)); mk = fmaxf(mk, shx<4>(mk)); mk = fmaxf(mk, shx<8>(mk)); mk = fmaxf(mk, shx<16>(mk));
    mq = fmaxf(__builtin_bit_cast(float, __builtin_amdgcn_readlane(__builtin_bit_cast(int, mq), 0)), __builtin_bit_cast(float, __builtin_amdgcn_readlane(__builtin_bit_cast(int, mq), 32)));
    mk = fmaxf(__builtin_bit_cast(float, __builtin_amdgcn_readlane(__builtin_bit_cast(int, mk), 0)), __builtin_bit_cast(float, __builtin_amdgcn_readlane(__builtin_bit_cast(int, mk), 32)));
    const float bound = sqrtf((float)DK) * mq * mk;
    return __builtin_bit_cast(float, __builtin_amdgcn_readfirstlane(__builtin_bit_cast(int, bound)));
}
__device__ __forceinline__ void mla_attn_phase(Frame& F, const InPtrs& A, int jl, bool do_ctx, int conv_layer) {
    int cround = 0;
    const bf16* QPRE = (const bf16*)(F.ws + R_QPRE); const float* RQ = (const float*)(F.ws + WS_RQ); const bf16* MK = (const bf16*)(F.ws + R_MK); const bf16* MV = (const bf16*)(F.ws + R_MV);
    bf16* AO = (bf16*)(F.ws + R_AO);
    const float* gq = A[I_MLA_QN] + jl * 96; const float* ropeA = (const float*)(F.ws + WS_ROPEA);
    const float bound = att_bound<96>(gq, A[I_MLA_KN] + jl * 96, 96, F.lane);
    const bool use_off = bound > 60.0f;
    const int nunits = 2048 + (do_ctx ? 128 : 0);
    for (int u = F.vcu; u < nunits; u += F.G) {
        const bool lat = u < 2048; const int bh = lat ? (u >> 4) : (u - 2048), qb = lat ? (u & 15) : 0, b = bh >> 4, h = bh & 15;
        const int row0 = lat ? b * 4096 + qb * 256 : NLAT + b * 256;
        const att::QLoadMLA QL{QPRE + (size_t)row0 * 1536 + h * 96, RQ + row0, gq, lat ? ropeA + (size_t)(qb * 256) * 16 : nullptr};
        const bf16* Kp = MK + (size_t)bh * NKEYS * 96; const bf16* Vp = MV + (size_t)bh * NKEYS * 64;
        bf16* Op = AO + (size_t)row0 * 1024 + h * 64;
        if (!use_off) att::body_dma<96, 64, false>(QL, Kp, Kp + 256 * 96, 96, Vp, Vp + 256 * 64, 64, Op, 1024, lat ? NKEYS : 256, 0.f, (char*)F.lds, F.tid);
        else { int bi_ = __builtin_amdgcn_readfirstlane(__builtin_bit_cast(int, bound)); asm volatile("" : "+s"(bi_)); const float nm_ = -fminf(__builtin_bit_cast(float, bi_), 30.0f) * 1.4426950408889634f;     att::body<96, 64, 2, true>(QL, Kp, Kp + 256 * 96, 96, Vp, Vp + 256 * 64, 64, Op, 1024, lat ? NKEYS : 256, nm_, (char*)F.lds, F.tid); }
        if (conv_layer >= 0 && cround < conv_rounds(F)) { moe_weight_round(F, A, conv_layer, cround); ++cround; __syncthreads(); }
    }
    if (conv_layer >= 0) for (; cround < conv_rounds(F); ++cround) moe_weight_round(F, A, conv_layer, cround);
}
__device__ __forceinline__ void diff_attn_phase(Frame& F, const InPtrs& A, bool do_ctx, int conv_layer) {
    int cround = 0;
    const bf16* DQ = (const bf16*)(F.ws + R_DQ); const bf16* DQC = (const bf16*)(F.ws + R_DQC); const bf16* DKp = (const bf16*)(F.ws + R_DK); const bf16* QKV = (const bf16*)(F.ws + R_QKV);
    bf16* OB = (bf16*)(F.ws + R_OB);
    const float bound = att_bound<64>(A[I_DF_QN], A[I_DF_KN], 64, F.lane);
    const bool use_off = bound > 60.0f;
    const int nunits = 2048 + (do_ctx ? 128 : 0);
    for (int u = F.vcu; u < nunits; u += F.G) {
        const bool lat = u < 2048; const int bh = lat ? (u >> 4) : (u - 2048), qb = lat ? (u & 15) : 0, b = bh >> 4, vh = bh & 15, h = vh >> 1;
        const bf16* Qp = lat ? DQ + ((size_t)bh * 4096 + qb * 256) * 64 : DQC + (size_t)bh * 256 * 64;
        const bf16* Kp = DKp + (size_t)bh * NKEYS * 64;
        const bf16* V0 = QKV + (size_t)(NLAT + b * 256) * 3072 + 2048 + h * 128; const bf16* V1 = QKV + (size_t)(b * 4096) * 3072 + 2048 + h * 128;
        bf16* Op = OB + (size_t)(lat ? b * 4096 + qb * 256 : NLAT + b * 256) * 2048 + vh * 128;
        const att::QLoadPlain QL{Qp, 64};
        if (!use_off) att::body_dma<64, 128, false>(QL, Kp, Kp + 256 * 64, 64, V0, V1, 3072, Op, 2048, lat ? NKEYS : 256, 0.f, (char*)F.lds, F.tid);
        else { int bi_ = __builtin_amdgcn_readfirstlane(__builtin_bit_cast(int, bound)); asm volatile("" : "+s"(bi_)); const float nm_ = -fminf(__builtin_bit_cast(float, bi_), 30.0f) * 1.4426950408889634f;     att::body<64, 128, 1, true>(QL, Kp, Kp + 256 * 64, 64, V0, V1, 3072, Op, 2048, lat ? NKEYS : 256, nm_, (char*)F.lds, F.tid); }
        if (conv_layer >= 0 && cround < conv_rounds(F)) { moe_weight_round(F, A, conv_layer, cround); ++cround; __syncthreads(); }
    }
    if (conv_layer >= 0) for (; cround < conv_rounds(F); ++cround) moe_weight_round(F, A, conv_layer, cround);
}

#ifndef PG8_SP2
#define PG8_SP2 true
#endif
#ifndef PG8_ALIGN
#define PG8_ALIGN true
#endif
#define GEMM_CALL(EPI, ORD, g, S, E) pg8::gemm_phase<EPI, ORD, PG8_ALIGN, PG8_SP2>(F.lds, g, S, E, F.tid)

__global__ void __launch_bounds__(NTHREADS, 2) fwd_kernel(Args args) {
    extern __shared__ __attribute__((aligned(16))) unsigned char lds[];
    Frame FM;
    FM.lds = (LAS unsigned char*)lds;
    FM.tid = threadIdx.x; FM.lane = FM.tid & 63; FM.wave = __builtin_amdgcn_readfirstlane(FM.tid >> 6);
    FM.G = gridDim.x; { const int bx = blockIdx.x; FM.vcu = (FM.G % 8 == 0) ? (bx % 8) * (FM.G / 8) + bx / 8 : bx; }
    FM.ws = args.ws; FM.out = args.out;
    volatile LAS unsigned* MISC = (volatile LAS unsigned*)(FM.lds + MISC_OFF);
    if (FM.tid < 16) MISC[FM.tid] = 0u;
    if (FM.tid < 35) { const unsigned long long p = (unsigned long long)args.in[FM.tid]; MISC[16 + 2 * FM.tid] = (unsigned)p; MISC[17 + 2 * FM.tid] = (unsigned)(p >> 32); }
    __syncthreads();
    InPtrs A; A.tab = MISC + 16;
    XcdBarrier bar = xcd_barrier_post((unsigned*)(FM.ws + WS_CTL) + 4096, MISC + 8); bar.wave = FM.wave;
    const int lo = args.ph_lo, hi = args.ph_hi;
    int ph = 0;
#ifndef PHASE_MASK
#define PHASE_MASK 0xFFFFFFFFu
#endif
#define EN(b) ((PHASE_MASK >> (b)) & 1u)
#ifndef REP_MASK
#define REP_MASK 0u
#endif
#ifndef BAR_REP
#define BAR_REP 1
#endif
#define REPN(b) (((REP_MASK >> (b)) & 1u) ? 2 : 1)
#define PH_BEGIN if (ph >= lo && ph < hi) { Frame F = FM; { int t_ = FM.wave * 64 + hw_lane(); asm volatile("" : "+v"(t_)); F.tid = t_; F.lane = t_ & 63; F.wave = __builtin_amdgcn_readfirstlane(t_ >> 6); \
        size_t z_ = 0; asm volatile("" : "+s"(z_), "+s"(F.vcu), "+s"(F.G)); F.ws = FM.ws + z_; F.out = FM.out + z_; } \
        const float* MOD = (const float*)(F.ws + WS_MOD); bf16* H = (bf16*)(F.ws + WS_H); (void)MOD; (void)H;
#define PH_END   if (ph + 1 < hi) { for (int br_ = 0; br_ < BAR_REP; ++br_) xcd_barrier(bar); } } ++ph;

    PH_BEGIN for (int rep_ = 0; rep_ < REPN(0); ++rep_) if (EN(0)) p0_prologue(F, A); PH_END

    for (int layer = 0; layer < DEPTH; ++layer) {
        const int kind = layer % 3, jl = layer / 3;
        const bool last = layer == DEPTH - 1, ctx_out = !last;
        const int rows_out = ctx_out ? MROWS : NLAT;

        PH_BEGIN for (int rep_ = 0; rep_ < REPN(1); ++rep_) if (EN(1)) { if (layer == 0 && rep_ == 0) norm_phase<false, true>(F, A, layer, false, MROWS); else norm_phase<false, false>(F, A, layer, layer > 0, MROWS, rep_ == 0 ? 1.0f : 0.0f); } PH_END

        if (kind == 0) {
            const size_t wboff = WS_WNM + jl * MLA_W_STRIDE;
#define wb (F.ws + wboff)
            PH_BEGIN for (int rep_ = 0; rep_ < REPN(2); ++rep_) if (EN(2)) { pg8::Gemm g{H, (const bf16*)(wb + MLA_WIN), MROWS, 1024, 1024}; pg8::StaticOrder S; S.init(MROWS, 1024, F.G, (int)blockIdx.x);
                pg8::EpiStore<0> E{(bf16*)(F.ws + R_DOWN), 1024}; GEMM_CALL(pg8::EpiStore<0>, pg8::StaticOrder, g, S, E); } PH_END
            PH_BEGIN for (int rep_ = 0; rep_ < REPN(2); ++rep_) if (EN(2)) { { pg8::Gemm g{(const bf16*)(F.ws + R_DOWN), (const bf16*)(wb + MLA_WUQ), rows_out, 1536, 512, 1024}; pg8::StaticOrder S; S.init(rows_out, 1536, F.G, (int)blockIdx.x);
                         pg8::EpiStore<0> E{(bf16*)(F.ws + R_QPRE), 1536}; GEMM_CALL(pg8::EpiStore<0>, pg8::StaticOrder, g, S, E); }
                       __syncthreads();
                       { pg8::Gemm g{(const bf16*)(F.ws + R_DOWN) + 512, (const bf16*)(wb + MLA_WUKV), MROWS, 2048, 256, 1024}; pg8::StaticOrder S; S.init(MROWS, 2048, F.G, (int)blockIdx.x);
                         pg8::EpiStore<0> E{(bf16*)(F.ws + R_KVPRE), 2048}; GEMM_CALL(pg8::EpiStore<0>, pg8::StaticOrder, g, S, E); } } PH_END
            PH_BEGIN for (int rep_ = 0; rep_ < REPN(3); ++rep_) if (EN(3)) mla_finish_phase(F, A, jl); PH_END
            PH_BEGIN for (int rep_ = 0; rep_ < REPN(4); ++rep_) if (EN(4)) mla_attn_phase(F, A, jl, ctx_out, (EN(15) && rep_ == 0) ? layer : -1); PH_END
            PH_BEGIN for (int rep_ = 0; rep_ < REPN(14); ++rep_) if (EN(14)) { pg8::Gemm g{(const bf16*)(F.ws + R_AO), (const bf16*)(wb + MLA_WOUT), rows_out, 1024, 1024}; pg8::StaticOrder S; S.init(rows_out, 1024, F.G, (int)blockIdx.x);
                pg8::EpiResid E{(bf16*)(F.ws + WS_XB), MOD + (size_t)layer * 9 * 6144 + 2048, rep_ == 0 ? 1.0f : 0.0f}; GEMM_CALL(pg8::EpiResid, pg8::StaticOrder, g, S, E); } PH_END
#undef wb
        } else if (kind == 1) {
            PH_BEGIN for (int rep_ = 0; rep_ < REPN(12); ++rep_) if (EN(12)) { pg8::Gemm g{H, (const bf16*)(F.ws + WS_DIFF_WIN), MROWS, 3072, 1024}; pg8::StaticOrder S; S.init(MROWS, 3072, F.G, (int)blockIdx.x);
                pg8::EpiStore<0> E{(bf16*)(F.ws + R_QKV), 3072}; GEMM_CALL(pg8::EpiStore<0>, pg8::StaticOrder, g, S, E); } PH_END
            PH_BEGIN for (int rep_ = 0; rep_ < REPN(5); ++rep_) if (EN(5)) diff_finish_qk_phase(F, A); PH_END
            PH_BEGIN for (int rep_ = 0; rep_ < REPN(6); ++rep_) if (EN(6)) diff_attn_phase(F, A, ctx_out, (EN(15) && rep_ == 0) ? layer : -1); PH_END
            PH_BEGIN for (int rep_ = 0; rep_ < REPN(5); ++rep_) if (EN(5)) diff_finish_o_phase(F, A, 0.8f - 0.6f * expf(-0.3f * (float)layer)); PH_END
            PH_BEGIN for (int rep_ = 0; rep_ < REPN(14); ++rep_) if (EN(14)) { pg8::Gemm g{(const bf16*)(F.ws + R_DAO), (const bf16*)(F.ws + WS_DIFF_WOUT), rows_out, 1024, 1024}; pg8::StaticOrder S; S.init(rows_out, 1024, F.G, (int)blockIdx.x);
                pg8::EpiResid E{(bf16*)(F.ws + WS_XB), MOD + (size_t)layer * 9 * 6144 + 2048, rep_ == 0 ? 1.0f : 0.0f}; GEMM_CALL(pg8::EpiResid, pg8::StaticOrder, g, S, E); } PH_END
        } else {
            PH_BEGIN for (int rep_ = 0; rep_ < REPN(13); ++rep_) if (EN(13)) { pg8::Gemm g{H, (const bf16*)(F.ws + WS_SG_WIN), MROWS, 4096, 1024}; pg8::StaticOrder S; S.init(MROWS, 4096, F.G, (int)blockIdx.x);
                pg8::EpiStore<1> E{(bf16*)(F.ws + R_Z), 4096}; GEMM_CALL(pg8::EpiStore<1>, pg8::StaticOrder, g, S, E); } PH_END
            PH_BEGIN for (int rep_ = 0; rep_ < REPN(7); ++rep_) if (EN(7)) sg_ln_phase(F, A); PH_END
            PH_BEGIN for (int rep_ = 0; rep_ < REPN(13); ++rep_) if (EN(13)) { pg8::Gemm g{(const bf16*)(F.ws + WS_SG_WS), (const bf16*)(F.ws + R_VNT), 2048, 0, 128}; pg8::SpatialOrder S; S.init((MROWS / 128) * 8, F.G, F.vcu);
                pg8::EpiSpatial E{(bf16*)(F.ws + R_UV), (const bf16*)(F.ws + R_Z), A[I_SG_BS]}; GEMM_CALL(pg8::EpiSpatial, pg8::SpatialOrder, g, S, E); } PH_END
            PH_BEGIN for (int rep_ = 0; rep_ < REPN(14); ++rep_) if (EN(14)) { pg8::Gemm g{(const bf16*)(F.ws + R_UV), (const bf16*)(F.ws + WS_SG_WOUT), rows_out, 1024, 2048}; pg8::StaticOrder S; S.init(rows_out, 1024, F.G, (int)blockIdx.x);
                pg8::EpiResid E{(bf16*)(F.ws + WS_XB), MOD + (size_t)layer * 9 * 6144 + 2048, rep_ == 0 ? 1.0f : 0.0f}; GEMM_CALL(pg8::EpiResid, pg8::StaticOrder, g, S, E); } PH_END
        }

        PH_BEGIN { for (int rep_ = 0; rep_ < REPN(8); ++rep_) if (EN(8)) { norm_phase<true, false>(F, A, layer, false, rows_out); __syncthreads(); } for (int rep_ = 0; rep_ < REPN(15); ++rep_) if (EN(15) && kind == 2) { moe_weight_items(F, A, layer); __syncthreads(); } } PH_END
        PH_BEGIN for (int rep_ = 0; rep_ < REPN(9); ++rep_) if (EN(9)) topk_phase(F, ctx_out ? 256 : 128); PH_END
        PH_BEGIN for (int rep_ = 0; rep_ < REPN(10); ++rep_) if (EN(10)) { pg8::Gemm g{H, (const bf16*)(F.ws + WS_WGU), MOE_ROWS, 0, 1024}; pg8::MoeOrder S; S.init(ctx_out ? 17 : 16, 8, F.G, F.vcu);
            pg8::EpiSwiGLU E{(bf16*)(F.ws + R_HID), 8}; pg8::gemm_phase<pg8::EpiSwiGLU, pg8::MoeOrder, PG8_ALIGN, PG8_SP2, true>(F.lds, g, S, E, F.tid, (const int*)(F.ws + R_XG), (LAS int*)(F.lds + RING_BYTES)); } PH_END
        PH_BEGIN for (int rep_ = 0; rep_ < REPN(10); ++rep_) if (EN(10)) { pg8::Gemm g{(const bf16*)(F.ws + R_HID), (const bf16*)(F.ws + WS_WDN), MOE_ROWS, 0, 1024}; pg8::MoeOrder S; S.init(ctx_out ? 17 : 16, 4, F.G, F.vcu);
            pg8::EpiMoeDown E{(bf16*)(F.ws + R_YB), (const float*)(F.ws + WS_GATE)}; GEMM_CALL(pg8::EpiMoeDown, pg8::MoeOrder, g, S, E); } PH_END
    }
    PH_BEGIN for (int rep_ = 0; rep_ < REPN(11); ++rep_) if (EN(11)) final_phase(F, DEPTH - 1); PH_END
#undef PH_BEGIN
#undef PH_END
}
constexpr int N_PHASES = 1 + (1 + 5 + 4) + (1 + 5 + 4) + (1 + 4 + 4) + (1 + 5 + 4) + 1;

extern "C" void kernel_launch(void* const* d_in, const int* in_sizes, int n_in, void* d_out, int out_size, void* d_ws, size_t ws_size, hipStream_t stream) {
    static int grid = 0;
    if (grid == 0) {
        if (n_in != 35 || in_sizes[0] != NLAT * D || out_size != NLAT * D || ws_size < WS_END) {
            fprintf(stderr, "kernel_launch: unexpected shapes: n_in %d in0 %d out %d ws %zu (need >= %zu); nothing launched\n", n_in, n_in > 0 ? in_sizes[0] : -1, out_size, ws_size, (size_t)WS_END); grid = -1; return; }
        int dev = 0, cus = 0, per_cu = 0;
        if (hipGetDevice(&dev) != hipSuccess || hipDeviceGetAttribute(&cus, hipDeviceAttributeMultiprocessorCount, dev) != hipSuccess) { fprintf(stderr, "kernel_launch: device query failed\n"); grid = -1; return; }
        if (hipFuncSetAttribute((const void*)fwd_kernel, hipFuncAttributeMaxDynamicSharedMemorySize, LDS_BYTES) != hipSuccess) { fprintf(stderr, "kernel_launch: hipFuncSetAttribute failed\n"); grid = -1; return; }
        if (hipOccupancyMaxActiveBlocksPerMultiprocessor(&per_cu, (const void*)fwd_kernel, NTHREADS, LDS_BYTES) != hipSuccess || per_cu < 1)
            fprintf(stderr, "kernel_launch: note: occupancy query reports %d workgroups per CU\n", per_cu);
        (void)hipGetLastError();
        grid = cus;
    }
    if (grid < 0) return;
    if (hipMemsetAsync((char*)d_ws + WS_CTL, 0, CTL_ZERO_BYTES, stream) != hipSuccess) { fprintf(stderr, "kernel_launch: memset failed\n"); return; }
    Args a{};
    for (int i = 0; i < 35; ++i) a.in[i] = (const float*)d_in[i];
    a.out = (float*)d_out; a.ws = (unsigned char*)d_ws;
#if MK_PER_PHASE
    for (int p = 0; p < N_PHASES; ++p) { a.ph_lo = p; a.ph_hi = p + 1; hipLaunchKernelGGL(fwd_kernel, dim3(grid), dim3(NTHREADS), LDS_BYTES, stream, a); }
#else
    a.ph_lo = 0; a.ph_hi = N_PHASES;
    hipLaunchKernelGGL(fwd_kernel, dim3(grid), dim3(NTHREADS), LDS_BYTES, stream, a);
#endif
    const hipError_t le = hipPeekAtLastError();
    if (le != hipSuccess) fprintf(stderr, "kernel_launch: launch failed: %s\n", hipGetErrorName(le));
}
```

```cpp
#include <hip/hip_runtime.h>
#include <cstdio>
#include <cstdint>

#ifndef MK_PER_PHASE
#define MK_PER_PHASE 0
#endif

constexpr int D = 1024, NB = 8, SEQ = 4096, CTXL = 256, NLAT = NB * SEQ, NCTX = NB * CTXL, MROWS = NLAT + NCTX;
constexpr int NKEYS = CTXL + SEQ;
constexpr int NE = 16, CAP_LAT = 512, CAP_CTX = 32, EROWS = NB * CAP_LAT + NB * CAP_CTX, MOE_ROWS = NE * EROWS;
constexpr int DEPTH = 4;
constexpr float EPS = 1e-6f;
constexpr int NWAVES = 8, NTHREADS = 512;

constexpr size_t MiB = 1u << 20;
constexpr size_t WS_CTL = 0, CTL_ZERO_BYTES = 1 * MiB;
constexpr size_t WS_MOD = 1 * MiB;
constexpr size_t WS_ROPEA = 2 * MiB;
constexpr size_t WS_ROPEB = 2 * MiB + 512 * 1024;
constexpr size_t WS_WNM = 4 * MiB;
constexpr size_t MLA_W_STRIDE = 7 * MiB, MLA_WIN = 0, MLA_WUQ = 2 * MiB, MLA_WUKV = 3 * MiB + 512 * 1024, MLA_WOUT = 4 * MiB + 512 * 1024;
constexpr size_t WS_DIFF_WIN = 18 * MiB, WS_DIFF_WOUT = 24 * MiB;
constexpr size_t WS_SG_WIN = 26 * MiB, WS_SG_WOUT = 34 * MiB, WS_SG_WS = 38 * MiB;
constexpr size_t WS_WGU = 40 * MiB, WS_WDN = 104 * MiB;
constexpr size_t WS_XCTX = 136 * MiB;
constexpr size_t WS_H = 144 * MiB;
constexpr size_t WS_AFF = 212 * MiB;
constexpr size_t WS_SLOT = 215 * MiB;
constexpr size_t WS_GATE = 218 * MiB;
constexpr size_t WS_RQ = 219 * MiB;
constexpr size_t WS_R = 220 * MiB;
constexpr size_t WS_XB = WS_R + 640 * MiB;
constexpr size_t WS_END = WS_XB + 68 * MiB;
constexpr size_t R_DOWN = WS_R, R_CQN = WS_R + 68 * MiB, R_CKVN = WS_R + 102 * MiB, R_QPRE = WS_R + 120 * MiB, R_KVPRE = WS_R + 222 * MiB;
constexpr size_t R_MQ = WS_R + 358 * MiB, R_MQC = WS_R + 454 * MiB, R_MK = WS_R + 460 * MiB, R_MV = WS_R + 562 * MiB, R_AO = WS_R;
constexpr size_t R_QKV = WS_R, R_DQ = WS_R + 204 * MiB, R_DQC = WS_R + 268 * MiB, R_DK = WS_R + 272 * MiB, R_OB = WS_R + 340 * MiB, R_DAO = WS_R + 476 * MiB;
constexpr size_t R_Z = WS_R, R_VNT = WS_R + 272 * MiB, R_UV = WS_R + 408 * MiB;
constexpr size_t R_XG = WS_R, R_HID = WS_R + 136 * MiB, R_YB = WS_R + 272 * MiB;

constexpr int RING_BYTES = 131072;
constexpr int LDS_BYTES = 147456;
constexpr int MISC_OFF = LDS_BYTES - 512;

#define GAS __attribute__((address_space(1)))
#define LAS __attribute__((address_space(3)))
typedef unsigned short bf16;
typedef unsigned v4u __attribute__((ext_vector_type(4)));
typedef unsigned v2u __attribute__((ext_vector_type(2)));
typedef float f32x4 __attribute__((ext_vector_type(4)));
typedef float f32x2 __attribute__((ext_vector_type(2)));
typedef GAS unsigned gu32;
#define RLX_AGENT __ATOMIC_RELAXED, __HIP_MEMORY_SCOPE_AGENT
#define LDS_WAIT() asm volatile("s_waitcnt lgkmcnt(0)" ::: "memory")
#define VM_WAIT() asm volatile("s_waitcnt vmcnt(0)" ::: "memory")
__device__ __forceinline__ unsigned f2bf(float f) { unsigned u = __builtin_bit_cast(unsigned, f); return (u + 0x7fffu + ((u >> 16) & 1u)) >> 16; }
__device__ __forceinline__ unsigned pk2(float lo, float hi) { return f2bf(lo) | (f2bf(hi) << 16); }
__device__ __forceinline__ float bflo(unsigned w) { return __builtin_bit_cast(float, w << 16); }
__device__ __forceinline__ float bfhi(unsigned w) { return __builtin_bit_cast(float, w & 0xffff0000u); }
template <int M> __device__ __forceinline__ float shx(float v) {
    static_assert(M == 1 || M == 2 || M == 4 || M == 8 || M == 16, "shx: xor mask inside a 32-lane group");
    return __builtin_bit_cast(float, __builtin_amdgcn_ds_swizzle(__builtin_bit_cast(int, v), (M << 10) | 0x1f));
}
__device__ __forceinline__ float wave_sum(float v) {
    v += shx<1>(v); v += shx<2>(v); v += shx<4>(v); v += shx<8>(v); v += shx<16>(v);
    const unsigned a = __builtin_bit_cast(unsigned, v);
    const auto rr = __builtin_amdgcn_permlane32_swap(a, a, false, false);
    const unsigned r0 = rr[0], r1 = rr[1];
    return __uint_as_float(r0) + __uint_as_float(r1);
}
__device__ __forceinline__ int hw_lane() { int l; asm volatile("v_mbcnt_lo_u32_b32 %0, -1, 0\n\tv_mbcnt_hi_u32_b32 %0, -1, %0" : "=v"(l)); return l; }
__device__ __forceinline__ float fast_rcp(float x) { return __builtin_amdgcn_rcpf(x); }
__device__ __forceinline__ float silu_f(float x) { return x * fast_rcp(1.0f + __builtin_amdgcn_exp2f(-1.4426950408889634f * x)); }
__device__ __forceinline__ float gelu_tanh_f(float x) { const float u2 = 1.5957691216057308f * (x + 0.044715f * x * x * x); return x * fast_rcp(1.0f + __builtin_amdgcn_exp2f(-1.4426950408889634f * u2)); }

namespace pg8 {
#define PG8_LAS __attribute__((address_space(3)))
typedef unsigned short bf16_t;
typedef short bf16x8 __attribute__((ext_vector_type(8)));
typedef float f32x4 __attribute__((ext_vector_type(4)));
typedef unsigned u32x4 __attribute__((ext_vector_type(4)));
constexpr int BM = 256, BK = 64, HALF = 128, HTB = HALF * BK * 2  , STAGE_BYTES = 8 * HTB, NXCD = 8, WGM = 8;

__host__ __device__ __forceinline__ int lds_byte(int r, int c) { const int st = (r >> 4) * 2 + (c >> 5), rr = r & 15, cc = c & 31, ob = rr * 64 + cc * 2; return st * 1024 + (ob ^ (((ob >> 9) & 1) << 5)); }
__host__ __device__ __forceinline__ void stage_rc(int b, int& R, int& C) { const int st = b / 1024, sb = b % 1024, swz = sb ^ (((sb >> 9) & 1) << 5); R = (st >> 1) * 16 + swz / 64; C = (st & 1) * 32 + (swz % 64) / 2; }
__host__ __device__ __forceinline__ int perm32(int rho) { const int n = rho >> 4, i = rho & 15; return 8 * (i >> 2) + 4 * n + (i & 3); }

struct Unit { int pm, pn; };
struct Gemm { const bf16_t* A; const bf16_t* Bt; int M, N, K; int lda = 0; };

struct StaticOrder {
    int nM, nN, nwg, G, c;
    __host__ __device__ void init(int M, int N, int G_, int c_) { nM = M / BM; nN = N / BM; nwg = nM * nN; G = G_; c = c_; }
    __host__ __device__ bool next(int i, Unit& u) const {
        const long L = (long)i * G + c; if (L >= nwg) return false;
        int wgid = (int)L; { const int q = nwg / NXCD, r = nwg % NXCD, xcd = wgid % NXCD, off = wgid / NXCD; wgid = (xcd < r ? xcd * (q + 1) : r * (q + 1) + (xcd - r) * q) + off; }
        const int nig = WGM * nN, gid = wgid / nig, fm = gid * WGM, gsz = (nM - fm) < WGM ? (nM - fm) : WGM;
        u.pm = fm + ((wgid % nig) % gsz); u.pn = (wgid % nig) / gsz; return true;
    }
    __device__ __forceinline__ void a_ready(const Unit&) const {}
    __device__ __forceinline__ void done(const Unit&) const {}
};

__device__ __forceinline__ unsigned cvt_pk_bf16(float lo, float hi) { unsigned r; asm volatile("v_cvt_pk_bf16_f32 %0, %1, %2" : "=v"(r) : "v"(lo), "v"(hi)); return r; }
typedef float f32x2 __attribute__((ext_vector_type(2)));

template <int ACT> struct EpiStore {
    static constexpr bool PERM = true, AFTER_DRAIN = false;
    bf16_t* O; int ldc;
    __device__ __forceinline__ void operator()(const f32x4 (&acc)[2][2][4][2], const Unit& u, int wr, int wc, int fr, int fq) const {
        const int row0 = u.pm * BM + wr * 64 + fr, col0 = u.pn * BM + wc * 32 + 8 * fq;
#pragma unroll
        for (int ai = 0; ai < 2; ++ai)
#pragma unroll
            for (int m = 0; m < 4; ++m) { bf16_t* rowp = O + (size_t)(row0 + ai * HALF + m * 16) * ldc + col0;
#pragma unroll
                for (int bj = 0; bj < 2; ++bj) { f32x4 v0 = acc[ai][bj][m][0], v1 = acc[ai][bj][m][1];
                    if (ACT == 1) {
#pragma unroll
                        for (int i = 0; i < 4; ++i) { v0[i] = gelu_tanh_f(v0[i]); v1[i] = gelu_tanh_f(v1[i]); } }
                    u32x4 w; w.x = cvt_pk_bf16(v0[0], v0[1]); w.y = cvt_pk_bf16(v0[2], v0[3]); w.z = cvt_pk_bf16(v1[0], v1[1]); w.w = cvt_pk_bf16(v1[2], v1[3]);
                    *(u32x4*)(rowp + bj * HALF) = w; } }
    }
};
struct EpiResid {
    static constexpr bool PERM = true, AFTER_DRAIN = false;
    bf16_t* xb; const float* gmod; float mul;
    __device__ __forceinline__ void operator()(const f32x4 (&acc)[2][2][4][2], const Unit& u, int wr, int wc, int fr, int fq) const {
        const int rr = u.pm < 128 ? (u.pm >> 4) : 8;
        bf16_t* xbase = xb + (size_t)u.pm * BM * 1024;
        const int col0 = u.pn * BM + wc * 32 + 8 * fq;
        f32x4 gv[2][2];
#pragma unroll
        for (int bj = 0; bj < 2; ++bj)
#pragma unroll
            for (int n = 0; n < 2; ++n) gv[bj][n] = *(const f32x4*)(gmod + rr * 6144 + col0 + bj * HALF + 4 * n) * mul;
#pragma unroll
        for (int ai = 0; ai < 2; ++ai)
#pragma unroll
            for (int m = 0; m < 4; ++m) { bf16_t* rowp = xbase + (size_t)(ai * HALF + wr * 64 + m * 16 + fr) * 1024 + col0;
#pragma unroll
                for (int bj = 0; bj < 2; ++bj) { u32x4* p = (u32x4*)(rowp + bj * HALF); const u32x4 w = *p;
                    const f32x4 x0 = (f32x4){__builtin_bit_cast(float, w.x << 16), __builtin_bit_cast(float, w.x & 0xffff0000u), __builtin_bit_cast(float, w.y << 16), __builtin_bit_cast(float, w.y & 0xffff0000u)};
                    const f32x4 x1 = (f32x4){__builtin_bit_cast(float, w.z << 16), __builtin_bit_cast(float, w.z & 0xffff0000u), __builtin_bit_cast(float, w.w << 16), __builtin_bit_cast(float, w.w & 0xffff0000u)};
                    const f32x4 o0 = x0 + gv[bj][0] * acc[ai][bj][m][0], o1 = x1 + gv[bj][1] * acc[ai][bj][m][1];
                    u32x4 r; r.x = cvt_pk_bf16(o0[0], o0[1]); r.y = cvt_pk_bf16(o0[2], o0[3]); r.z = cvt_pk_bf16(o1[0], o1[1]); r.w = cvt_pk_bf16(o1[2], o1[3]); *p = r; } }
    }
};
struct EpiSwiGLU {
    static constexpr bool PERM = true, AFTER_DRAIN = false;
    bf16_t* O; int nct;
    __device__ __forceinline__ void operator()(const f32x4 (&acc)[2][2][4][2], const Unit& u, int wr, int wc, int fr, int fq) const {
        const int row0 = u.pm * BM + wr * 64 + fr, col0 = (u.pn % nct) * HALF + wc * 32 + 8 * fq;
#pragma unroll
        for (int ai = 0; ai < 2; ++ai)
#pragma unroll
            for (int m = 0; m < 4; ++m) { bf16_t* rowp = O + (size_t)(row0 + ai * HALF + m * 16) * 1024 + col0;
                f32x4 v0, v1;
#pragma unroll
                for (int i = 0; i < 4; ++i) { v0[i] = silu_f(acc[ai][0][m][0][i]) * acc[ai][1][m][0][i]; v1[i] = silu_f(acc[ai][0][m][1][i]) * acc[ai][1][m][1][i]; }
                u32x4 w; w.x = cvt_pk_bf16(v0[0], v0[1]); w.y = cvt_pk_bf16(v0[2], v0[3]); w.z = cvt_pk_bf16(v1[0], v1[1]); w.w = cvt_pk_bf16(v1[2], v1[3]);
                *(u32x4*)rowp = w; }
    }
};
struct EpiMoeDown {
    static constexpr bool PERM = true, AFTER_DRAIN = false;
    bf16_t* O; const float* gate;
    __device__ __forceinline__ void operator()(const f32x4 (&acc)[2][2][4][2], const Unit& u, int wr, int wc, int fr, int fq) const {
        const int row0 = u.pm * BM + wr * 64 + fr, col0 = (u.pn & 3) * BM + wc * 32 + 8 * fq;
#pragma unroll
        for (int ai = 0; ai < 2; ++ai)
#pragma unroll
            for (int m = 0; m < 4; ++m) { const int row = row0 + ai * HALF + m * 16; const float gt = gate[row]; bf16_t* rowp = O + (size_t)row * 1024 + col0;
#pragma unroll
                for (int bj = 0; bj < 2; ++bj) { const f32x4 v0 = acc[ai][bj][m][0] * gt, v1 = acc[ai][bj][m][1] * gt;
                    u32x4 w; w.x = cvt_pk_bf16(v0[0], v0[1]); w.y = cvt_pk_bf16(v0[2], v0[3]); w.z = cvt_pk_bf16(v1[0], v1[1]); w.w = cvt_pk_bf16(v1[2], v1[3]);
                    *(u32x4*)(rowp + bj * HALF) = w; } }
    }
};
struct EpiSpatial {
    static constexpr bool PERM = true, AFTER_DRAIN = false;
    bf16_t* UV; const bf16_t* Z; const float* bs;
    __device__ __forceinline__ void operator()(const f32x4 (&acc)[2][2][4][2], const Unit& u, int wr, int wc, int fr, int fq) const {
        const int g = u.pm, chunk = u.pn >> 3;
#pragma unroll
        for (int m = 0; m < 4; ++m) { const int p = wr * 64 + m * 16 + fr; const float b = bs[g * 128 + p]; const size_t tok = (size_t)chunk * 128 + p;
#pragma unroll
            for (int bj = 0; bj < 2; ++bj) { const int ch = g * 256 + bj * HALF + wc * 32 + 8 * fq;
                const u32x4 uw = *(const u32x4*)(Z + tok * 4096 + ch);
                const f32x4 a0 = acc[0][bj][m][0] + b, a1 = acc[0][bj][m][1] + b;
                u32x4 w;
                w.x = cvt_pk_bf16(a0[0] * __builtin_bit_cast(float, uw.x << 16), a0[1] * __builtin_bit_cast(float, uw.x & 0xffff0000u));
                w.y = cvt_pk_bf16(a0[2] * __builtin_bit_cast(float, uw.y << 16), a0[3] * __builtin_bit_cast(float, uw.y & 0xffff0000u));
                w.z = cvt_pk_bf16(a1[0] * __builtin_bit_cast(float, uw.z << 16), a1[1] * __builtin_bit_cast(float, uw.z & 0xffff0000u));
                w.w = cvt_pk_bf16(a1[2] * __builtin_bit_cast(float, uw.w << 16), a1[3] * __builtin_bit_cast(float, uw.w & 0xffff0000u));
                *(u32x4*)(UV + tok * 2048 + ch) = w; } }
    }
};
struct MoeOrder {
    int nrt, nct, nwg, G, c;
    __device__ void init(int nrt_, int nct_, int G_, int c_) { nrt = nrt_; nct = nct_; nwg = 16 * nrt * nct; G = G_; c = c_; }
    __device__ bool next(int i, Unit& u) const {
        const int L = i * G + c; if (L >= nwg) return false;
        const int per = nrt * nct, e = L / per, r = L % per, j = r / nrt, rt = r % nrt;
        u.pm = e * 17 + rt; u.pn = e * nct + j; return true;
    }
    __device__ __forceinline__ void a_ready(const Unit&) const {}
    __device__ __forceinline__ void done(const Unit&) const {}
};
struct SpatialOrder {
    int nwg, G, c;
    __device__ void init(int nblocks, int G_, int c_) { nwg = nblocks; G = G_; c = c_; }
    __device__ bool next(int i, Unit& u) const { const int L = i * G + c; if (L >= nwg) return false; u.pm = L & 7; u.pn = L; return true; }
    __device__ __forceinline__ void a_ready(const Unit&) const {}
    __device__ __forceinline__ void done(const Unit&) const {}
};
template <class Epi, class Sched, bool ALIGN_EPI = false, bool SP2 = false, bool GATHER = false>
__device__ __forceinline__ void gemm_phase(PG8_LAS unsigned char* lds, const Gemm g, const Sched& S, const Epi& E, int tid_in, const int* rowsrc = nullptr, PG8_LAS int* idx_lds = nullptr) {
    int tid_ = tid_in; asm volatile("" : "+v"(tid_));
    const int tid = tid_, wid = __builtin_amdgcn_readfirstlane(tid >> 6), lane = tid & 63, wr = wid >> 2, wc = wid & 3, fr = lane & 15, fq = lane >> 4;
    const int K = g.K, nt = K / BK, LDA = g.lda ? g.lda : g.K;
    unsigned voffA[2], voffB[2];
#pragma unroll
    for (int i = 0; i < 2; ++i) { int R, C; stage_rc(tid * 16 + i * 8192, R, C); const int Rb = Epi::PERM ? ((R & ~31) + perm32(R & 31)) : R;
        voffA[i] = (unsigned)(R * LDA + C) * 2u; voffB[i] = (unsigned)(Rb * K + C) * 2u; }
    const size_t kstep = (size_t)(BK * 2);
    const size_t hstep = (size_t)HALF * K * 2;
    const size_t tstep = 2 * hstep;
    const size_t hstepA = GATHER ? 0 : (size_t)HALF * LDA * 2, tstepA = 2 * hstepA;
    unsigned gA[2][2], gN[2][2], gS[2][2];
    int gR[2], gC[2];
    if constexpr (GATHER) {
#pragma unroll
        for (int i = 0; i < 2; ++i) { int R, C; stage_rc(tid * 16 + i * 8192, R, C); gR[i] = R; gC[i] = C * 2; }
        Unit u_; for (int i = 0; S.next(i, u_); ++i) if (tid < 256) idx_lds[i * 256 + tid] = rowsrc[u_.pm * BM + tid];
        asm volatile("s_waitcnt vmcnt(0) lgkmcnt(0)" ::: "memory"); __builtin_amdgcn_s_barrier(); asm volatile("" ::: "memory");
    }
#define PG8_GOFF(dst, unit_i) do { _Pragma("unroll") for (int h_ = 0; h_ < 2; ++h_) _Pragma("unroll") for (int i_ = 0; i_ < 2; ++i_) \
        dst[h_][i_] = (unsigned)idx_lds[(unit_i) * 256 + h_ * HALF + gR[i_]] * (unsigned)(LDA * 2) + (unsigned)gC[i_]; } while (0)
#define PG8_OA(h) (GATHER ? gA[h] : voffA)
#define PG8_OS(h) (GATHER ? gS[h] : voffA)
    const unsigned ldsw = (unsigned)wid * 1024u;
    const int aoff = lds_byte(wr * 64 + fr, fq * 8), boff = lds_byte(wc * 32 + fr, fq * 8);
#define PG8_SA(b, h) (((b) * 2 + (h)) * HTB)
#define PG8_SB(b, h) ((4 + (b) * 2 + (h)) * HTB)
#define PG8_STAGE(bufoff, gbase, voff) do { _Pragma("unroll") for (int _i = 0; _i < 2; ++_i) \
        __builtin_amdgcn_global_load_lds((const unsigned*)((const char*)(gbase) + (voff)[_i]), (PG8_LAS unsigned*)(lds + (bufoff) + ldsw + _i * 8192), 16, 0, 0); } while (0)
#define PG8_LDA(dst, b, h) do { _Pragma("unroll") for (int m = 0; m < 4; ++m) _Pragma("unroll") for (int k = 0; k < 2; ++k) dst[m][k] = *(const PG8_LAS bf16x8*)(lds + PG8_SA(b, h) + aoff + m * 2048 + k * 1024); } while (0)
#define PG8_LDB(dst, b, h) do { _Pragma("unroll") for (int n = 0; n < 2; ++n) _Pragma("unroll") for (int k = 0; k < 2; ++k) dst[n][k] = *(const PG8_LAS bf16x8*)(lds + PG8_SB(b, h) + boff + n * 2048 + k * 1024); } while (0)
#define PG8_MMA(ai, bj, At, Bt) do { __builtin_amdgcn_s_setprio(1); _Pragma("unroll") for (int m = 0; m < 4; ++m) _Pragma("unroll") for (int n = 0; n < 2; ++n) _Pragma("unroll") for (int k = 0; k < 2; ++k) \
        acc[ai][bj][m][n] = __builtin_amdgcn_mfma_f32_16x16x32_bf16(Bt[n][k], At[m][k], acc[ai][bj][m][n], 0, 0, 0); __builtin_amdgcn_s_setprio(0); } while (0)
#define PG8_WAIT_V(n) asm volatile("s_waitcnt vmcnt(" #n ")" ::: "memory")
#define PG8_WAIT_L(n) asm volatile("s_waitcnt lgkmcnt(" #n ")" ::: "memory")
#define PG8_BAR __builtin_amdgcn_s_barrier()
#define PG8_SCHED __builtin_amdgcn_sched_barrier(0)
    Unit cur, nxt; int ui = 0;
    if (!S.next(0, cur)) return;
    if constexpr (GATHER) { PG8_GOFF(gA, 0); }
    f32x4 acc[2][2][4][2];
#pragma unroll
    for (int a = 0; a < 2; ++a)
#pragma unroll
        for (int b = 0; b < 2; ++b)
#pragma unroll
            for (int m = 0; m < 4; ++m)
#pragma unroll
                for (int n = 0; n < 2; ++n) acc[a][b][m][n] = (f32x4){0.f, 0.f, 0.f, 0.f};
    bf16x8 At[4][2], B0[2][2], B1[2][2];
    const char* cA = (const char*)g.A + (size_t)cur.pm * tstepA; const char* cB = (const char*)g.Bt + (size_t)cur.pn * tstep;
    S.a_ready(cur);
    if constexpr (SP2) {
        PG8_STAGE(PG8_SB(0, 0), cB, voffB); PG8_STAGE(PG8_SB(0, 1), cB + hstep, voffB); PG8_STAGE(PG8_SA(0, 0), cA, PG8_OA(0)); PG8_STAGE(PG8_SA(0, 1), cA + hstepA, PG8_OA(1));
        if (wr == 1) PG8_BAR;
        PG8_WAIT_V(2); PG8_BAR;
        PG8_STAGE(PG8_SB(1, 0), cB + kstep, voffB); PG8_STAGE(PG8_SA(1, 0), cA + kstep, PG8_OA(0)); PG8_STAGE(PG8_SB(1, 1), cB + hstep + kstep, voffB);
        PG8_WAIT_V(6); PG8_BAR;
    } else {
        PG8_STAGE(PG8_SB(0, 0), cB, voffB); PG8_STAGE(PG8_SA(0, 0), cA, PG8_OA(0)); PG8_STAGE(PG8_SB(0, 1), cB + hstep, voffB); PG8_STAGE(PG8_SA(0, 1), cA + hstepA, PG8_OA(1));
        if (wr == 1) PG8_BAR;
        PG8_WAIT_V(4); PG8_BAR;
        PG8_STAGE(PG8_SB(1, 0), cB + kstep, voffB); PG8_STAGE(PG8_SA(1, 0), cA + kstep, PG8_OA(0)); PG8_STAGE(PG8_SB(1, 1), cB + hstep + kstep, voffB);
        PG8_WAIT_V(6); PG8_BAR;
    }
    for (;;) {
        const bool has_next = S.next(ui + 1, nxt);
        if constexpr (GATHER) { if (has_next) { PG8_GOFF(gN, ui + 1); } else {
#pragma unroll
            for (int h_ = 0; h_ < 2; ++h_) { gN[h_][0] = gA[h_][0]; gN[h_][1] = gA[h_][1]; } } }
        const char* nA = has_next ? (const char*)g.A + (size_t)nxt.pm * tstepA : cA; const char* nB = has_next ? (const char*)g.Bt + (size_t)nxt.pn * tstep : cB;
        for (int t = 0; t < nt; t += 2) {
            const bool last = (t == nt - 2);
            if constexpr (GATHER) {
#pragma unroll
                for (int h_ = 0; h_ < 2; ++h_) { gS[h_][0] = last ? gN[h_][0] : gA[h_][0]; gS[h_][1] = last ? gN[h_][1] : gA[h_][1]; } }
            const char* a1 = cA + (size_t)(t + 1) * kstep;
            const char* a2 = last ? nA : cA + (size_t)(t + 2) * kstep; const char* b2 = last ? nB : cB + (size_t)(t + 2) * kstep;
            const char* a3 = a2 + kstep; const char* b3 = b2 + kstep;
            if (last && has_next) S.a_ready(nxt);
            if constexpr (SP2) {
            PG8_LDB(B0, 0, 0); PG8_LDB(B1, 0, 1); PG8_SCHED; PG8_LDA(At, 0, 0); PG8_STAGE(PG8_SA(1, 1), a1 + hstepA, PG8_OA(1));
            PG8_WAIT_V(8); PG8_WAIT_L(0); PG8_BAR; PG8_MMA(0, 0, At, B0); PG8_MMA(0, 1, At, B1); PG8_BAR; PG8_SCHED;
            PG8_LDA(At, 0, 1); PG8_STAGE(PG8_SB(0, 0), b2, voffB); PG8_STAGE(PG8_SB(0, 1), b2 + hstep, voffB); PG8_STAGE(PG8_SA(0, 0), a2, PG8_OS(0));
            PG8_WAIT_V(8); PG8_WAIT_L(0); PG8_BAR; PG8_MMA(1, 0, At, B0); PG8_MMA(1, 1, At, B1); PG8_BAR; PG8_SCHED;
            PG8_LDB(B0, 1, 0); PG8_LDB(B1, 1, 1); PG8_SCHED; PG8_LDA(At, 1, 0); PG8_STAGE(PG8_SA(0, 1), a2 + hstepA, PG8_OS(1));
            PG8_WAIT_V(8); PG8_WAIT_L(0); PG8_BAR; PG8_MMA(0, 0, At, B0); PG8_MMA(0, 1, At, B1); PG8_BAR; PG8_SCHED;
            PG8_LDA(At, 1, 1); PG8_STAGE(PG8_SB(1, 0), b3, voffB); PG8_STAGE(PG8_SB(1, 1), b3 + hstep, voffB); PG8_STAGE(PG8_SA(1, 0), a3, PG8_OS(0));
            PG8_WAIT_V(8); PG8_WAIT_L(0); PG8_BAR; PG8_MMA(1, 0, At, B0); PG8_MMA(1, 1, At, B1); PG8_BAR; PG8_SCHED;
            } else {
            PG8_LDB(B0, 0, 0); PG8_SCHED; PG8_LDA(At, 0, 0); PG8_STAGE(PG8_SA(1, 1), a1 + hstepA, PG8_OA(1));
            PG8_WAIT_L(8); PG8_BAR; PG8_WAIT_L(0); PG8_MMA(0, 0, At, B0); PG8_BAR; PG8_SCHED;
            PG8_LDB(B1, 0, 1); PG8_STAGE(PG8_SB(0, 0), b2, voffB);
            PG8_BAR; PG8_WAIT_L(0); PG8_MMA(0, 1, At, B1); PG8_BAR;
            PG8_LDA(At, 0, 1); PG8_STAGE(PG8_SA(0, 0), a2, PG8_OS(0));
            PG8_BAR; PG8_WAIT_L(0); PG8_MMA(1, 0, At, B0); PG8_BAR; PG8_SCHED;
            PG8_STAGE(PG8_SB(0, 1), b2 + hstep, voffB);
            PG8_WAIT_V(6); PG8_BAR; PG8_MMA(1, 1, At, B1); PG8_BAR;
            PG8_LDB(B0, 1, 0); PG8_SCHED; PG8_LDA(At, 1, 0); PG8_STAGE(PG8_SA(0, 1), a2 + hstepA, PG8_OS(1));
            PG8_WAIT_L(8); PG8_BAR; PG8_WAIT_L(0); PG8_MMA(0, 0, At, B0); PG8_BAR; PG8_SCHED;
            PG8_LDB(B1, 1, 1); PG8_STAGE(PG8_SB(1, 0), b3, voffB);
            PG8_BAR; PG8_WAIT_L(0); PG8_MMA(0, 1, At, B1); PG8_BAR;
            PG8_LDA(At, 1, 1); PG8_STAGE(PG8_SA(1, 0), a3, PG8_OS(0));
            PG8_BAR; PG8_WAIT_L(0); PG8_MMA(1, 0, At, B0); PG8_BAR; PG8_SCHED;
            PG8_STAGE(PG8_SB(1, 1), b3 + hstep, voffB);
            PG8_WAIT_V(6); PG8_BAR; PG8_MMA(1, 1, At, B1); PG8_BAR;
            }
        }
        if constexpr (ALIGN_EPI) { if (wr == 0) PG8_BAR; }
        if constexpr (!Epi::AFTER_DRAIN) { E(acc, cur, wr, wc, fr, fq); S.done(cur); }
        if (!has_next) break;
#pragma unroll
        for (int a = 0; a < 2; ++a)
#pragma unroll
            for (int b = 0; b < 2; ++b)
#pragma unroll
                for (int m = 0; m < 4; ++m)
#pragma unroll
                    for (int n = 0; n < 2; ++n) acc[a][b][m][n] = (f32x4){0.f, 0.f, 0.f, 0.f};
        cur = nxt; cA = nA; cB = nB; ++ui;
        if constexpr (GATHER) {
#pragma unroll
            for (int h_ = 0; h_ < 2; ++h_) { gA[h_][0] = gN[h_][0]; gA[h_][1] = gN[h_][1]; } }
        if constexpr (ALIGN_EPI) { if (wr == 1) PG8_BAR; }
    }
    PG8_WAIT_V(0);
    if constexpr (!ALIGN_EPI) { if (wr == 0) PG8_BAR; }
    PG8_BAR;
    if constexpr (Epi::AFTER_DRAIN) { E.fused(acc, cur, wr, wc, fr, fq, lds, wid, lane); S.done(cur); }
#undef PG8_SA
#undef PG8_GOFF
#undef PG8_OA
#undef PG8_OS
#undef PG8_SB
#undef PG8_STAGE
#undef PG8_LDA
#undef PG8_LDB
#undef PG8_MMA
#undef PG8_WAIT_V
#undef PG8_WAIT_L
#undef PG8_BAR
#undef PG8_SCHED
}
}

namespace att {
using bf16x8 = __attribute__((ext_vector_type(8))) short;
using s16x4  = __attribute__((ext_vector_type(4))) short;
using f32x16 = __attribute__((ext_vector_type(16))) float;
using u32x4  = __attribute__((ext_vector_type(4))) unsigned;
constexpr int NW = 8, QBLK = 32, KVBLK = 64, KROWB = 256;
constexpr float THR = 8.f;
#define ATT_KSWZ(row, colB) ((row) * 256 + ((colB) ^ (((row) & 7) << 4)))
#define ATT_SBAR() __builtin_amdgcn_sched_barrier(0)
__device__ __forceinline__ int crow(int r, int hi) { return (r & 3) + 8 * (r >> 2) + 4 * hi; }
__device__ __forceinline__ unsigned cvtpk(float lo, float hi) { unsigned r; asm volatile("v_cvt_pk_bf16_f32 %0, %1, %2" : "=v"(r) : "v"(lo), "v"(hi)); return r; }
template <int DK> struct Sc { static constexpr float SCALE = (DK == 96) ? 0.10206207261596575f : 0.125f; static constexpr float C = SCALE * 1.4426950408889634f; };

template <int DK, bool OFF>
__device__ __forceinline__ void partialSM(f32x16& p0, f32x16& p1, float negMC) {
  if constexpr (OFF) {
#pragma unroll
    for (int r = 0; r < 16; ++r) p0[r] += negMC;
#pragma unroll
    for (int r = 0; r < 16; ++r) p1[r] += negMC;
  }
#pragma unroll
  for (int r = 0; r < 16; ++r) p0[r] = __builtin_amdgcn_exp2f(p0[r]);
}
__device__ __forceinline__ void finishSM(f32x16& p0, f32x16& p1, float& l_reg, bf16x8& pa0, bf16x8& pa1, bf16x8& pa2, bf16x8& pa3) {
#pragma unroll
  for (int r = 0; r < 16; ++r) p1[r] = __builtin_amdgcn_exp2f(p1[r]);
  float ps = 0;
#pragma unroll
  for (int r = 0; r < 16; ++r) ps += p0[r];
#pragma unroll
  for (int r = 0; r < 16; ++r) ps += p1[r];
  l_reg += ps;
#define ATT_PK4(P, BASE, OUT) do { unsigned a0 = cvtpk(P[BASE + 0], P[BASE + 1]), a1 = cvtpk(P[BASE + 2], P[BASE + 3]);   \
    unsigned b0 = cvtpk(P[BASE + 4], P[BASE + 5]), b1 = cvtpk(P[BASE + 6], P[BASE + 7]);                              \
    auto r0 = __builtin_amdgcn_permlane32_swap(a0, b0, false, false); auto r1 = __builtin_amdgcn_permlane32_swap(a1, b1, false, false); \
    u32x4 w = {r0[0], r1[0], r0[1], r1[1]}; OUT = *reinterpret_cast<bf16x8*>(&w); } while (0)
  ATT_PK4(p0, 0, pa0); ATT_PK4(p0, 8, pa1); ATT_PK4(p1, 0, pa2); ATT_PK4(p1, 8, pa3);
#undef ATT_PK4
}
template <int DK>
__device__ __forceinline__ void qkt(f32x16& p0, f32x16& p1, const char* Ks, const bf16x8* qr, int r32, int hi) {
  p0 = f32x16{}; p1 = f32x16{};
#pragma unroll
  for (int d0 = 0; d0 < DK / 16; ++d0) { const int cb = (d0 * 16 + hi * 8) * 2;
    const bf16x8 b0 = *reinterpret_cast<const bf16x8*>(Ks + ATT_KSWZ(r32, cb));
    const bf16x8 b1 = *reinterpret_cast<const bf16x8*>(Ks + ATT_KSWZ(32 + r32, cb));
    p0 = __builtin_amdgcn_mfma_f32_32x32x16_bf16(b0, qr[d0], p0, 0, 0, 0);
    p1 = __builtin_amdgcn_mfma_f32_32x32x16_bf16(b1, qr[d0], p1, 0, 0, 0);
  }
}
template <int DV> __device__ __forceinline__ int v_st(int k, int c) { const int kk = (k & ~0xC) | ((k & 4) << 1) | ((k & 8) >> 1); return ((kk >> 3) * (DV / 32) + (c >> 5)) * 512 + ((kk & 7) * 32 + (c & 31)) * 2; }
__device__ __forceinline__ int v_rd_base(int lane) { return ((lane & 3) << 3) | (((lane >> 2) & 3) << 6) | (((lane >> 4) & 1) << 5) | (((lane >> 5) & 1) << 8); }
template <int DV> constexpr int v_rd_off(int d0, int ks, int half) { return d0 * 512 + ks * (2 * (DV / 32) * 512) + half * ((DV / 32) * 512); }
template <int OFF> __device__ __forceinline__ s16x4 tr_read(int vb) {
  s16x4 r; asm volatile("ds_read_b64_tr_b16 %0, %1 offset:%2" : "=&v"(r) : "v"(vb), "i"(OFF) : "memory"); return r;
}
template <int DV, int D0> __device__ __forceinline__ void pv_one(f32x16& od, int vb, bf16x8 pa0, bf16x8 pa1, bf16x8 pa2, bf16x8 pa3) {
  const s16x4 l0 = tr_read<v_rd_off<DV>(D0, 0, 0)>(vb), h0 = tr_read<v_rd_off<DV>(D0, 0, 1)>(vb), l1 = tr_read<v_rd_off<DV>(D0, 1, 0)>(vb), h1 = tr_read<v_rd_off<DV>(D0, 1, 1)>(vb);
  const s16x4 l2 = tr_read<v_rd_off<DV>(D0, 2, 0)>(vb), h2 = tr_read<v_rd_off<DV>(D0, 2, 1)>(vb), l3 = tr_read<v_rd_off<DV>(D0, 3, 0)>(vb), h3 = tr_read<v_rd_off<DV>(D0, 3, 1)>(vb);
  asm volatile("s_waitcnt lgkmcnt(0)" ::: "memory"); ATT_SBAR();
#define ATT_PK(L, H) (bf16x8){L[0], L[1], L[2], L[3], H[0], H[1], H[2], H[3]}
  od = __builtin_amdgcn_mfma_f32_32x32x16_bf16(pa0, ATT_PK(l0, h0), od, 0, 0, 0);
  od = __builtin_amdgcn_mfma_f32_32x32x16_bf16(pa1, ATT_PK(l1, h1), od, 0, 0, 0);
  od = __builtin_amdgcn_mfma_f32_32x32x16_bf16(pa2, ATT_PK(l2, h2), od, 0, 0, 0);
  od = __builtin_amdgcn_mfma_f32_32x32x16_bf16(pa3, ATT_PK(l3, h3), od, 0, 0, 0);
#undef ATT_PK
}
template <int DV> __device__ __forceinline__ void pv_all(f32x16* o, int vb, bf16x8 pa0, bf16x8 pa1, bf16x8 pa2, bf16x8 pa3) {
  pv_one<DV, 0>(o[0], vb, pa0, pa1, pa2, pa3); pv_one<DV, 1>(o[1], vb, pa0, pa1, pa2, pa3);
  if constexpr (DV == 128) { pv_one<DV, 2>(o[2], vb, pa0, pa1, pa2, pa3); pv_one<DV, 3>(o[3], vb, pa0, pa1, pa2, pa3); }
}
__device__ __forceinline__ float half_pair_sum(float v) { const unsigned a = __float_as_uint(v); auto rr = __builtin_amdgcn_permlane32_swap(a, a, false, false); const unsigned r0 = rr[0], r1 = rr[1]; return __uint_as_float(r0) + __uint_as_float(r1); }
__device__ __forceinline__ void unpack_bf8(const bf16x8 w, float* f) {
#pragma unroll
  for (int i = 0; i < 8; ++i) f[i] = __uint_as_float((unsigned)(unsigned short)w[i] << 16); }
__device__ __forceinline__ bf16x8 pack_bf8(const float* f) { u32x4 w = {cvtpk(f[0], f[1]), cvtpk(f[2], f[3]), cvtpk(f[4], f[5]), cvtpk(f[6], f[7])}; return *reinterpret_cast<bf16x8*>(&w); }
struct QLoadMLA {
  const bf16* qpre;
  const float* rq;
  const float* gq;
  const float* cosA;
  __device__ __forceinline__ void load(bf16x8 (&qr)[6], int r, int hi) const {
    const bf16* src = qpre + (long)r * 1536 + hi * 8; float v[6][8]; float ss = 0.f;
#pragma unroll
    for (int d0 = 0; d0 < 6; ++d0) { unpack_bf8(*reinterpret_cast<const bf16x8*>(src + d0 * 16), v[d0]);
#pragma unroll
      for (int j = 0; j < 8; ++j) ss += v[d0][j] * v[d0][j]; }
    ss = half_pair_sum(ss);
    const float rqv = rq[r], f = Sc<96>::C * rqv / sqrtf(rqv * rqv * ss * (1.0f / 96.0f) + EPS);
#pragma unroll
    for (int d0 = 0; d0 < 6; ++d0) { const f32x4 g0 = *(const f32x4*)(gq + d0 * 16 + hi * 8), g1 = *(const f32x4*)(gq + d0 * 16 + hi * 8 + 4);
#pragma unroll
      for (int j = 0; j < 4; ++j) { v[d0][j] *= f * g0[j]; v[d0][4 + j] *= f * g1[j]; } }
    if (cosA) { const float* c = cosA + (long)r * 16 + hi * 8; const float* sn = c + 4096 * 16;
#pragma unroll
      for (int j = 0; j < 8; ++j) { const float x1 = v[4][j], x2 = v[5][j], cs = c[j], si = sn[j]; v[4][j] = x1 * cs - x2 * si; v[5][j] = x1 * si + x2 * cs; } }
#pragma unroll
    for (int d0 = 0; d0 < 6; ++d0) qr[d0] = pack_bf8(v[d0]);
  }
};
struct QLoadPlain {
  const bf16* q; int ldq;
  template <int NQ> __device__ __forceinline__ void load(bf16x8 (&qr)[NQ], int r, int hi) const {
    const bf16* src = q + (long)r * ldq + hi * 8;
#pragma unroll
    for (int d0 = 0; d0 < NQ; ++d0) qr[d0] = *reinterpret_cast<const bf16x8*>(src + d0 * 16);
  }
};
template <int DK, int DV> struct Geo {
  static constexpr int SHM_V = KVBLK * DV * 2, SHM_K = KVBLK * KROWB, SHM = 2 * SHM_V + 2 * SHM_K + NW * 64 * 4;
  static constexpr int KCPR = DK / 8, VCPR = DV / 8;
  static constexpr int NKC = KVBLK * KCPR, NVC = KVBLK * VCPR;
  static constexpr int KN = (NKC + 511) / 512, VN = NVC / 512;
  static_assert(NVC % 512 == 0 && SHM <= 131072, "attention geometry");
};

template <int DK, int DV, int SD, bool OFF, class QLoader>
__device__ __forceinline__ void body(const QLoader& QL, const bf16* __restrict__ K0, const bf16* __restrict__ K1, int ldk,
                                     const bf16* __restrict__ V0, const bf16* __restrict__ V1, int ldv, bf16* __restrict__ Ob, int ldo, int nkeys, float negMC, char* lds, int tid_in) {
  using G = Geo<DK, DV>;
  constexpr int SHM_V = G::SHM_V, SHM_K = G::SHM_K, KN = G::KN, VN = G::VN, ND = DV / 32;
  int tid_ = tid_in; asm volatile("" : "+v"(tid_));
  const int tid = tid_, wid = tid >> 6, lane = tid & 63, r32 = lane & 31, hi = lane >> 5;
  char* V_lds = lds; char* K_lds = lds + 2 * SHM_V;
  float* ws = (float*)(lds + 2 * SHM_V + 2 * SHM_K) + wid * 64; float* li_l = ws;
  float l_reg = 0; f32x16 o[ND];
#pragma unroll
  for (int d = 0; d < ND; ++d) o[d] = f32x16{};
  bf16x8 qr[DK / 16];
  QL.load(qr, wid * QBLK + r32, hi);
  int kofs[KN], kdst[KN], vofs[VN], vdst[VN];
#pragma unroll
  for (int i = 0; i < KN; ++i) { const int c = tid + 512 * i, row = (c / G::KCPR) & 63, col = (c % G::KCPR) * 8; kofs[i] = (row * ldk + col) * 2; kdst[i] = ATT_KSWZ(row, col * 2); }
#pragma unroll
  for (int i = 0; i < VN; ++i) { const int c = tid + 512 * i, row = c / G::VCPR, col = (c % G::VCPR) * 8; vofs[i] = (row * ldv + col) * 2; vdst[i] = v_st<DV>(row, col); }
  const bool k_last_ok = (tid + 512 * (KN - 1)) < G::NKC;
  const int vb0 = (int)(uintptr_t)V_lds + v_rd_base(lane);
  struct Slot { bf16x8 k[KN], v[VN]; } sr_[SD];
#define ATT_TBASE(k0, ld, P0, P1) (((k0) < 256) ? ((P0) + (long)(k0) * (ld)) : ((P1) + (long)((k0) - 256) * (ld)))
#define ATT_LD(base, ofs) (*reinterpret_cast<const bf16x8*>((const char*)(base) + (unsigned)(ofs)))
#define ATT_SLOAD(i, k0) do { const bf16* vb_ = ATT_TBASE(k0, ldv, V0, V1); const bf16* kb_ = ATT_TBASE(k0, ldk, K0, K1); \
    _Pragma("unroll") for (int _s = 0; _s < VN; ++_s) sr_[i].v[_s] = ATT_LD(vb_, vofs[_s]); \
    _Pragma("unroll") for (int _s = 0; _s < KN; ++_s) if (_s < KN - 1 || k_last_ok) sr_[i].k[_s] = ATT_LD(kb_, kofs[_s]); } while (0)
#define ATT_SWRITE(b, i) do { \
    _Pragma("unroll") for (int _s = 0; _s < VN; ++_s) *reinterpret_cast<bf16x8*>(V_lds + (b) * SHM_V + vdst[_s]) = sr_[i].v[_s]; \
    _Pragma("unroll") for (int _s = 0; _s < KN; ++_s) if (_s < KN - 1 || k_last_ok) *reinterpret_cast<bf16x8*>(K_lds + (b) * SHM_K + kdst[_s]) = sr_[i].k[_s]; } while (0)
#define ATT_SWAIT() asm volatile("s_waitcnt vmcnt(%0)" :: "n"(SD == 2 ? KN + VN : 0) : "memory")
  f32x16 pA0, pA1, pB0, pB1; bf16x8 pa0, pa1, pa2, pa3; const int NT = nkeys / KVBLK;
  constexpr int SE = 0, SO = SD - 1;
  ATT_SLOAD(SE, 0); asm volatile("s_waitcnt vmcnt(0)" ::: "memory"); ATT_SWRITE(0, SE); __syncthreads();
  qkt<DK>(pA0, pA1, K_lds, qr, r32, hi); partialSM<DK, OFF>(pA0, pA1, negMC);
  ATT_SLOAD(SO, KVBLK); if constexpr (SD == 2) { if (2 < NT) ATT_SLOAD(SE, 2 * KVBLK); }
  ATT_SWAIT(); ATT_SWRITE(1, SO); __syncthreads();
  for (int j = 1; j + 1 < NT; j += 2) {
    ATT_SBAR(); qkt<DK>(pB0, pB1, K_lds + SHM_K, qr, r32, hi);
    finishSM(pA0, pA1, l_reg, pa0, pa1, pa2, pa3); ATT_SBAR();
    ATT_SLOAD(SO, (j + SD) * KVBLK); ATT_SBAR();
    pv_all<DV>(o, vb0, pa0, pa1, pa2, pa3); partialSM<DK, OFF>(pB0, pB1, negMC);
    __syncthreads(); ATT_SWAIT(); ATT_SWRITE(0, SE);
    __syncthreads();
    ATT_SBAR(); qkt<DK>(pA0, pA1, K_lds, qr, r32, hi);
    finishSM(pB0, pB1, l_reg, pa0, pa1, pa2, pa3); ATT_SBAR();
    if (SD == 1 || j + 3 < NT) ATT_SLOAD(SE, (j + 1 + SD) * KVBLK); ATT_SBAR();
    pv_all<DV>(o, vb0 + SHM_V, pa0, pa1, pa2, pa3); partialSM<DK, OFF>(pA0, pA1, negMC);
    __syncthreads(); ATT_SWAIT(); ATT_SWRITE(1, SO);
    __syncthreads();
  }
  ATT_SBAR(); qkt<DK>(pB0, pB1, K_lds + SHM_K, qr, r32, hi);
  finishSM(pA0, pA1, l_reg, pa0, pa1, pa2, pa3); ATT_SBAR();
  pv_all<DV>(o, vb0, pa0, pa1, pa2, pa3); partialSM<DK, OFF>(pB0, pB1, negMC);
  __syncthreads();
  finishSM(pB0, pB1, l_reg, pa0, pa1, pa2, pa3); ATT_SBAR();
  pv_all<DV>(o, vb0 + SHM_V, pa0, pa1, pa2, pa3);
  { auto rr = __builtin_amdgcn_permlane32_swap(__float_as_uint(l_reg), __float_as_uint(l_reg), false, false);
    l_reg = __uint_as_float(rr[0]) + __uint_as_float(rr[1]); }
  if (hi == 0) li_l[r32] = l_reg; asm volatile("s_waitcnt lgkmcnt(0)" ::: "memory");
  float rli[16];
#pragma unroll
  for (int r = 0; r < 16; ++r) rli[r] = __builtin_amdgcn_rcpf(li_l[crow(r, hi)]);
  bf16* Ow = Ob + (long)(wid * QBLK) * ldo;
#pragma unroll
  for (int r = 0; r < 16; ++r) { const int orow = crow(r, hi);
#pragma unroll
    for (int d0 = 0; d0 < ND; ++d0) Ow[(long)orow * ldo + d0 * 32 + r32] = (bf16)f2bf(o[d0][r] * rli[r]); }
  __syncthreads();
#undef ATT_TBASE
#undef ATT_LD
#undef ATT_SLOAD
#undef ATT_SWRITE
#undef ATT_SWAIT
}
template <int DK, int DV, bool OFF, class QLoader>
__device__ __forceinline__ void body_dma(const QLoader& QL, const bf16* __restrict__ K0, const bf16* __restrict__ K1, int ldk,
                                         const bf16* __restrict__ V0, const bf16* __restrict__ V1, int ldv, bf16* __restrict__ Ob, int ldo, int nkeys, float negMC, char* lds, int tid_in) {
  using G = Geo<DK, DV>;
  constexpr int SHM_V = G::SHM_V, SHM_K = G::SHM_K, ND = DV / 32, NSL = 4;
  constexpr int KPW = (SHM_K / 1024) / NW, VPW = (SHM_V / 1024) / NW, NPW = KPW + VPW;
  static_assert(KPW == 2 && (VPW == 1 || VPW == 2) && NSL * (SHM_V + SHM_K) + NW * 256 <= 135168, "DMA geometry");
  int tid_ = tid_in; asm volatile("" : "+v"(tid_));
  const int tid = tid_, wid = __builtin_amdgcn_readfirstlane(tid >> 6), lane = tid & 63, r32 = lane & 31, hi = lane >> 5;
  char* V_lds = lds; char* K_lds = lds + NSL * SHM_V;
  float* ws = (float*)(lds + NSL * (SHM_V + SHM_K)) + wid * 64; float* li_l = ws;
  float l_reg = 0; f32x16 o[ND];
#pragma unroll
  for (int d = 0; d < ND; ++d) o[d] = f32x16{};
  bf16x8 qr[DK / 16];
  QL.load(qr, wid * QBLK + r32, hi);
  asm volatile("s_waitcnt vmcnt(0)" ::: "memory");
  unsigned koff[KPW], voff[VPW];
#pragma unroll
  for (int i = 0; i < (DK == 64 ? 1 : KPW); ++i) { const int row = (wid * KPW + i) * 4 + (lane >> 4); int c = (lane & 15) ^ (row & 7); c = (c < DK / 8) ? c : (c & 7); koff[i] = (unsigned)((row * ldk) * 2 + c * 16); }
#pragma unroll
  for (int i = 0; i < 1; ++i) { const int sidx = (wid * VPW + i) * 2 + (lane >> 5), kg = sidx / ND, st = sidx % ND, kk = kg * 8 + ((lane & 31) >> 2);
    const int k = (kk & ~0xC) | ((kk & 4) << 1) | ((kk & 8) >> 1), c = st * 32 + (lane & 3) * 8; voff[i] = (unsigned)((k * ldv + c) * 2); }
  const int vb0 = (int)(uintptr_t)V_lds + v_rd_base(lane);
  LAS unsigned* const ldsK = (LAS unsigned*)(LAS char*)K_lds + (wid * KPW) * 256; LAS unsigned* const ldsV = (LAS unsigned*)(LAS char*)V_lds + (wid * VPW) * 256;
#define ATT_TBASE(k0, ld, P0, P1) (((k0) < 256) ? ((P0) + (long)(k0) * (ld)) : ((P1) + (long)((k0) - 256) * (ld)))
#define DMA_TILE(t, slot) do { const int k0_ = (t) * KVBLK; const char* kb_ = (const char*)ATT_TBASE(k0_, ldk, K0, K1); const char* vb_ = (const char*)ATT_TBASE(k0_, ldv, V0, V1); \
    __builtin_amdgcn_global_load_lds((const unsigned*)(kb_ + koff[0]), ldsK + (slot) * (SHM_K / 4), 16, 0, 0); \
    if constexpr (DK == 64) __builtin_amdgcn_global_load_lds((const unsigned*)(kb_ + 4 * 64 * 2 + (koff[0] ^ 64u)), ldsK + (slot) * (SHM_K / 4) + 256, 16, 0, 0);     \
    else __builtin_amdgcn_global_load_lds((const unsigned*)(kb_ + koff[1]), ldsK + (slot) * (SHM_K / 4) + 256, 16, 0, 0); \
    __builtin_amdgcn_global_load_lds((const unsigned*)(vb_ + voff[0]), ldsV + (slot) * (SHM_V / 4), 16, 0, 0); \
    if constexpr (VPW == 2) __builtin_amdgcn_global_load_lds((const unsigned*)(vb_ + 128 + voff[0]), ldsV + (slot) * (SHM_V / 4) + 256, 16, 0, 0);     } while (0)
#define DMA_WAIT(last) do { if (last) asm volatile("s_waitcnt vmcnt(0)" ::: "memory"); else asm volatile("s_waitcnt vmcnt(%0)" :: "n"(NPW) : "memory"); } while (0)
  f32x16 pA0, pA1, pB0, pB1; bf16x8 pa0, pa1, pa2, pa3; const int NT = nkeys / KVBLK;
  DMA_TILE(0, 0); DMA_TILE(1, 1); DMA_WAIT(false); __syncthreads(); if (2 < NT) DMA_TILE(2, 2);
  qkt<DK>(pA0, pA1, K_lds, qr, r32, hi); partialSM<DK, OFF>(pA0, pA1, negMC);
#define DMA_ITER(j, PN0, PN1, PO0, PO1, KS, VS, DS) do { \
    DMA_WAIT((j) + 1 >= NT); __syncthreads(); if ((j) + 2 < NT) DMA_TILE((j) + 2, DS); \
    qkt<DK>(PN0, PN1, K_lds + (KS) * SHM_K, qr, r32, hi); \
    finishSM(PO0, PO1, l_reg, pa0, pa1, pa2, pa3); \
    pv_all<DV>(o, vb0 + (VS) * SHM_V, pa0, pa1, pa2, pa3); partialSM<DK, OFF>(PN0, PN1, negMC); } while (0)
  for (int j = 1; j < NT; j += 4) {
    DMA_ITER(j, pB0, pB1, pA0, pA1, 1, 0, 3);
    if (j + 1 < NT) DMA_ITER(j + 1, pA0, pA1, pB0, pB1, 2, 1, 0);
    if (j + 2 < NT) DMA_ITER(j + 2, pB0, pB1, pA0, pA1, 3, 2, 1);
    if (j + 3 < NT) DMA_ITER(j + 3, pA0, pA1, pB0, pB1, 0, 3, 2);
  }
  finishSM(pB0, pB1, l_reg, pa0, pa1, pa2, pa3); ATT_SBAR();
  pv_all<DV>(o, vb0 + 3 * SHM_V, pa0, pa1, pa2, pa3);
  { auto rr = __builtin_amdgcn_permlane32_swap(__float_as_uint(l_reg), __float_as_uint(l_reg), false, false);
    const unsigned r0 = rr[0], r1 = rr[1]; l_reg = __uint_as_float(r0) + __uint_as_float(r1); }
  const int lane_e = hw_lane(), r32e = lane_e & 31, hie = lane_e >> 5;
  if (hie == 0) li_l[r32e] = l_reg; asm volatile("s_waitcnt lgkmcnt(0)" ::: "memory");
  float rli[16];
#pragma unroll
  for (int r = 0; r < 16; ++r) rli[r] = __builtin_amdgcn_rcpf(li_l[crow(r, hie)]);
  bf16* Ow = Ob + (long)(wid * QBLK) * ldo;
#pragma unroll
  for (int r = 0; r < 16; ++r) { const int orow = crow(r, hie);
#pragma unroll
    for (int d0 = 0; d0 < ND; ++d0) Ow[(long)orow * ldo + d0 * 32 + r32e] = (bf16)f2bf(o[d0][r] * rli[r]); }
  __syncthreads();
#undef ATT_TBASE
#undef DMA_TILE
#undef DMA_WAIT
#undef DMA_ITER
}
}

#define XB_TMO      128
#define XB_XCNT(j)  (256  + 64 * (j))
#define XB_XSUB(j)  (1280 + 64 * (j))
#define XB_XGEN(j)  (2304 + 64 * (j))
#define XB_TOP      3328
#define XB_TOPGEN   3392
#define XCD_BAR_WORDS 3456
#define XB_SPIN_CAP (1u << 18)

__device__ __forceinline__ unsigned xb_ld(unsigned* p)              { return __hip_atomic_load(p, __ATOMIC_RELAXED, __HIP_MEMORY_SCOPE_AGENT); }
__device__ __forceinline__ unsigned xb_add(unsigned* p, unsigned v) { return __hip_atomic_fetch_add(p, v, __ATOMIC_RELAXED, __HIP_MEMORY_SCOPE_AGENT); }
__device__ __forceinline__ unsigned xb_xcc_id() { return (unsigned)__builtin_amdgcn_s_getreg((3 << 11) | 20) & 0xFu; }
#define XB_SPIN(cond, bar) do { unsigned _sp = 0; while (cond) { __builtin_amdgcn_s_sleep(1); \
    if ((++_sp & 255u) == 0u) { if (xb_ld(&(bar)[XB_TMO])) break; if (_sp > XB_SPIN_CAP) { atomicAdd(&(bar)[XB_TMO], 1u); break; } } } } while (0)

struct XcdBarrier {
    int wave;
    unsigned* bar; unsigned x;
    volatile LAS unsigned* st;
};

__device__ __forceinline__ XcdBarrier xcd_barrier_post(unsigned* bar, volatile LAS unsigned* st) {
    XcdBarrier b; b.wave = 0; b.bar = bar; b.x = xb_xcc_id(); b.st = st;
    if (threadIdx.x == 0) (void)xb_add(&bar[XB_XCNT(b.x)], 1u);
    return b;
}
__device__ __forceinline__ void xcd_barrier_complete(unsigned* bar, unsigned x, unsigned& nloc, unsigned& nx) {
    const unsigned G = gridDim.x * gridDim.y * gridDim.z;
    unsigned sum, cnt, mine, sp = 0u;
    for (;;) {
        sum = 0u; cnt = 0u; mine = 0u;
#pragma unroll
        for (unsigned j = 0; j < 16; ++j) { const unsigned c = xb_ld(&bar[XB_XCNT(j)]); sum += c; cnt += (c > 0u) ? 1u : 0u; mine = (j == x) ? c : mine; }
        if (sum == G) break;
        __builtin_amdgcn_s_sleep(1);
        if ((++sp & 255u) == 0u) { if (xb_ld(&bar[XB_TMO])) break; if (sp > XB_SPIN_CAP) { atomicAdd(&bar[XB_TMO], 1u); break; } }
    }
    nloc = mine > 0u ? mine : 1u; nx = cnt > 0u ? cnt : 1u;
}

__device__ __forceinline__ void xcd_barrier(const XcdBarrier& b) {
    asm volatile("s_waitcnt vmcnt(0)" ::: "memory");
    __syncthreads();
    if (b.wave == 0 && hw_lane() == 0) {
        size_t zb_ = 0; asm volatile("" : "+s"(zb_));
        unsigned* bar = b.bar + zb_;
        __builtin_amdgcn_s_waitcnt(0);
        unsigned nloc = b.st[0], nx = b.st[1];
        if (nloc == 0u) { xcd_barrier_complete(bar, b.x, nloc, nx); b.st[0] = nloc; b.st[1] = nx; }
        const unsigned old = xb_add(&bar[XB_XSUB(b.x)], 1u);
        const unsigned gen = old / nloc;
        if (old + 1u == (gen + 1u) * nloc) {
            __builtin_amdgcn_fence(__ATOMIC_RELEASE, "agent");
            asm volatile("s_waitcnt vmcnt(0)" ::: "memory");
            const unsigned og = xb_add(&bar[XB_TOP], 1u);
            const unsigned tg = og / nx;
            if (og + 1u == (tg + 1u) * nx) xb_add(&bar[XB_TOPGEN], 1u);
            else XB_SPIN(xb_ld(&bar[XB_TOPGEN]) == tg, bar);
            __builtin_amdgcn_fence(__ATOMIC_ACQUIRE, "agent");
            xb_add(&bar[XB_XGEN(b.x)], 1u);
            asm volatile("s_waitcnt vmcnt(0)" ::: "memory");
        } else {
            XB_SPIN(xb_ld(&bar[XB_XGEN(b.x)]) == gen, bar);
            __builtin_amdgcn_fence(__ATOMIC_ACQUIRE, "agent");
            asm volatile("s_waitcnt vmcnt(0)" ::: "memory");
        }
    }
    __syncthreads();
}

struct Args { const float* in[35]; float* out; unsigned char* ws; int ph_lo, ph_hi; };
enum { I_X = 0, I_C, I_CTX, I_CCTX, I_ADAW, I_ADAB, I_NMIX, I_NFFN, I_MLA_WIN, I_MLA_QNG, I_MLA_WUQ, I_MLA_KVNG, I_MLA_WUKV, I_MLA_QN, I_MLA_KN, I_MLA_WOUT,
       I_DF_WIN, I_DF_QN, I_DF_KN, I_DF_LQ1, I_DF_LK1, I_DF_LQ2, I_DF_LK2, I_DF_SUBG, I_DF_WOUT, I_SG_WIN, I_SG_LNG, I_SG_LNB, I_SG_WS, I_SG_BS, I_SG_WOUT,
       I_ROUTER, I_WGATE, I_WUP, I_WDOWN };
struct Frame {
    LAS unsigned char* lds;
    int tid, lane, wave, vcu, G;
    unsigned char* ws; float* out;
};
struct InPtrs {
    volatile LAS unsigned* tab;
    __device__ __forceinline__ const float* operator[](int i) const {
        const unsigned lo = __builtin_amdgcn_readfirstlane(tab[2 * i]), hi = __builtin_amdgcn_readfirstlane(tab[2 * i + 1]);
        return (const float*)(const GAS float*)(((unsigned long long)hi << 32) | lo);
    }
};
__device__ __forceinline__ bf16* xb_row(const Frame& F, int row) { return (bf16*)(F.ws + WS_XB) + (size_t)row * D; }

constexpr int TR_SROW = 136, TR_WAVE_BYTES = 64 * TR_SROW;
typedef short tr_v4i16 __attribute__((ext_vector_type(4)));
__device__ __forceinline__ void transpose_item(const float* W, int N, int k0, int n0, int ncols  , bf16* WT, int K, int drow0, LAS unsigned char* scr, int lane, const float* kscale = nullptr  ) {
    const int r4 = lane >> 4, c4 = (lane & 15) * 4;
    const bool ld_ok = c4 < ncols;
    f32x4 v[16];
    const float* src = W + (size_t)(k0 + r4) * N + n0 + c4;
#pragma unroll
    for (int i = 0; i < 16; ++i) v[i] = ld_ok ? __builtin_nontemporal_load((const f32x4*)(src + (size_t)(4 * i) * N)) : (f32x4){0.f, 0.f, 0.f, 0.f};
#pragma unroll
    for (int i = 0; i < 16; ++i) { if (kscale) v[i] = v[i] * kscale[k0 + 4 * i + r4]; v2u w; w.x = pk2(v[i].x, v[i].y); w.y = pk2(v[i].z, v[i].w); *(LAS v2u*)(scr + (4 * i + r4) * TR_SROW + c4 * 2) = w; }
    LDS_WAIT(); asm volatile("" ::: "memory");
    const LAS unsigned char* rb = scr + ((lane >> 2) & 3) * TR_SROW + ((lane >> 4) * 16 + (lane & 3) * 4) * 2;
    v2u o[16];
#pragma unroll
    for (int k4 = 0; k4 < 16; ++k4) { const tr_v4i16 t = __builtin_amdgcn_ds_read_tr16_b64_v4i16((LAS tr_v4i16*)(rb + k4 * 4 * TR_SROW)); o[k4] = __builtin_bit_cast(v2u, t); }
    LDS_WAIT(); asm volatile("" ::: "memory");
    if (lane < ncols) { v4u* dst = (v4u*)(WT + (size_t)(drow0 + lane) * K + k0);
#pragma unroll
        for (int j = 0; j < 8; ++j) dst[j] = (v4u){o[2 * j].x, o[2 * j].y, o[2 * j + 1].x, o[2 * j + 1].y}; }
}
__device__ __forceinline__ int tr_items(int K, int N) { return (K / 64) * ((N + 63) / 64); }
__device__ __forceinline__ void tr_run(const float* W, int K, int N, bf16* WT, int r, LAS unsigned char* scr, int lane, const float* kscale = nullptr) {
    const int nblk = (N + 63) / 64, kb = r / nblk, nb = r % nblk, k0 = kb * 64, n0 = nb * 64;
    transpose_item(W, N, k0, n0, (N - n0) < 64 ? (N - n0) : 64, WT, K, n0, scr, lane, kscale);
}

__device__ __forceinline__ void p0_prologue(Frame& F, const InPtrs& A) {
    {
        LAS float* sv = (LAS float*)F.lds;
        LAS float* red = (LAS float*)(F.lds + 36864);
        bool have = false;
        for (int it = blockIdx.x; it < 96; it += F.G) {
            if (!have) {
                for (int i = F.tid; i < 9 * 1024; i += NTHREADS) { const int r = i >> 10, k = i & 1023; const float v = r < 8 ? A[I_C][r * 1024 + k] : A[I_CCTX][k]; sv[i] = v / (1.0f + __expf(-v)); }
                __syncthreads(); have = true;
            }
            const int layer = it / 24, cb = it % 24, col = cb * 256 + 4 * F.lane, kbase = F.wave * 128;
            const float* W = A[I_ADAW] + (size_t)layer * 1024 * 6144 + col;
            f32x4 acc[9];
#pragma unroll
            for (int r = 0; r < 9; ++r) acc[r] = (f32x4){0.f, 0.f, 0.f, 0.f};
#pragma unroll 4
            for (int k = 0; k < 128; ++k) { const f32x4 w = *(const f32x4*)(W + (size_t)(kbase + k) * 6144);
#pragma unroll
                for (int r = 0; r < 9; ++r) acc[r] += w * sv[r * 1024 + kbase + k]; }
#pragma unroll
            for (int r = 0; r < 9; ++r) *(LAS f32x4*)(red + (F.wave * 9 + r) * 256 + 4 * F.lane) = acc[r];
            __syncthreads();
            float* MODp = (float*)(F.ws + WS_MOD) + (size_t)layer * 9 * 6144;
            for (int o = F.tid; o < 9 * 256; o += NTHREADS) { const int r = o >> 8, cc = o & 255; float s = 0.f;
#pragma unroll
                for (int w = 0; w < 8; ++w) s += red[(w * 9 + r) * 256 + cc];
                MODp[r * 6144 + cb * 256 + cc] = s + A[I_ADAB][layer * 6144 + cb * 256 + cc]; }
            __syncthreads();
        }
        __syncthreads();
    }
    const int gtid = F.vcu * NTHREADS + F.tid, GT = F.G * NTHREADS;
    {
        float* ca = (float*)(F.ws + WS_ROPEA); float* sa = ca + 4096 * 16; float* cb = (float*)(F.ws + WS_ROPEB); float* sb = cb + 4096 * 32;
        for (int i = gtid; i < 4096 * 16; i += GT) { const int t = i >> 4, j = i & 15, f = j & 7; const float pos = (float)(j < 8 ? (t >> 6) : (t & 63));
            const float inv = powf(10000.0f, -(float)f / 8.0f), ang = pos * inv; ca[i] = cosf(ang); sa[i] = sinf(ang); }
        for (int i = gtid; i < 4096 * 32; i += GT) { const int t = i >> 5, j = i & 31, f = j & 15; const float pos = (float)(j < 16 ? (t >> 6) : (t & 63));
            const float inv = powf(10000.0f, -(float)f / 16.0f), ang = pos * inv; cb[i] = cosf(ang); sb[i] = sinf(ang); }
    }
    {
        for (int j = 0; j < 2; ++j) { v4u* z = (v4u*)(F.ws + WS_WNM + j * MLA_W_STRIDE + MLA_WIN + (size_t)800 * 1024 * 2);
            for (int i = gtid; i < 224 * 1024 * 2 / 16; i += GT) z[i] = (v4u){0u, 0u, 0u, 0u}; }
        bf16* wsA = (bf16*)(F.ws + WS_SG_WS); const float* wsrc = A[I_SG_WS];
        for (int i = gtid; i < 8 * 256 * 128 / 2; i += GT) { const int e0 = i * 2, g = e0 >> 15, p = (e0 >> 7) & 255, q = e0 & 127;
            unsigned w = 0u; if (p < 128) { const float* s = wsrc + ((size_t)g * 128 + p) * 128 + q; w = pk2(s[0], s[1]); }
            ((unsigned*)wsA)[i] = w; }
    }
    {
        LAS unsigned char* scr = F.lds + F.wave * TR_WAVE_BYTES;
        const int gw = F.vcu * NWAVES + F.wave, NGW = F.G * NWAVES;
        const int n_win = tr_items(1024, 800), n_wuq = tr_items(512, 1536), n_wukv = tr_items(256, 2048), n_wout = tr_items(1024, 1024);
        const int n_mla = n_win + n_wuq + n_wukv + n_wout;
        const int n_dwin = tr_items(1024, 3072), n_dwout = tr_items(1024, 1024), n_swin = tr_items(1024, 4096), n_swout = tr_items(2048, 1024);
        const int total = 2 * n_mla + n_dwin + n_dwout + n_swin + n_swout;
        for (int it = gw; it < total; it += NGW) {
            int r = it;
            if (r < 2 * n_mla) { const int j = r / n_mla; r -= j * n_mla; unsigned char* wb = F.ws + WS_WNM + j * MLA_W_STRIDE;
                if (r < n_win) { tr_run(A[I_MLA_WIN] + (size_t)j * 1024 * 800, 1024, 800, (bf16*)(wb + MLA_WIN), r, scr, F.lane); continue; } r -= n_win;
                if (r < n_wuq) { tr_run(A[I_MLA_WUQ] + (size_t)j * 512 * 1536, 512, 1536, (bf16*)(wb + MLA_WUQ), r, scr, F.lane, A[I_MLA_QNG] + j * 512); continue; } r -= n_wuq;
                if (r < n_wukv) { tr_run(A[I_MLA_WUKV] + (size_t)j * 256 * 2048, 256, 2048, (bf16*)(wb + MLA_WUKV), r, scr, F.lane, A[I_MLA_KVNG] + j * 256); continue; } r -= n_wukv;
                tr_run(A[I_MLA_WOUT] + (size_t)j * 1024 * 1024, 1024, 1024, (bf16*)(wb + MLA_WOUT), r, scr, F.lane); continue; }
            r -= 2 * n_mla;
            if (r < n_dwin) { tr_run(A[I_DF_WIN], 1024, 3072, (bf16*)(F.ws + WS_DIFF_WIN), r, scr, F.lane); continue; } r -= n_dwin;
            if (r < n_dwout) { tr_run(A[I_DF_WOUT], 1024, 1024, (bf16*)(F.ws + WS_DIFF_WOUT), r, scr, F.lane); continue; } r -= n_dwout;
            if (r < n_swin) { tr_run(A[I_SG_WIN], 1024, 4096, (bf16*)(F.ws + WS_SG_WIN), r, scr, F.lane); continue; } r -= n_swin;
            tr_run(A[I_SG_WOUT], 2048, 1024, (bf16*)(F.ws + WS_SG_WOUT), r, scr, F.lane);
        }
    }
}
__device__ __forceinline__ void moe_weight_item(Frame& F, const InPtrs& A, int layer, int it, LAS unsigned char* scr) {
    constexpr int PER = 16 * 16;
    const int which = it / (16 * PER), r0 = it % (16 * PER), e = r0 / PER, r = r0 % PER, kb = r >> 4, nb = r & 15, k0 = kb * 64, n0 = nb * 64;
    const size_t eoff = ((size_t)layer * 16 + e) * 1024 * 1024;
    if (which == 0) transpose_item(A[I_WGATE] + eoff, 1024, k0, n0, 64, (bf16*)(F.ws + WS_WGU), 1024, e * 2048 + (n0 >> 7) * 256 + (n0 & 127), scr, F.lane);
    else if (which == 1) transpose_item(A[I_WUP] + eoff, 1024, k0, n0, 64, (bf16*)(F.ws + WS_WGU), 1024, e * 2048 + (n0 >> 7) * 256 + 128 + (n0 & 127), scr, F.lane);
    else transpose_item(A[I_WDOWN] + eoff, 1024, k0, n0, 64, (bf16*)(F.ws + WS_WDN), 1024, e * 1024 + n0, scr, F.lane);
}
constexpr int MOE_CONV_ITEMS = 3 * 16 * 16 * 16;
__device__ __forceinline__ void moe_weight_items(Frame& F, const InPtrs& A, int layer) {
    LAS unsigned char* scr = F.lds + F.wave * TR_WAVE_BYTES;
    const int gw = F.vcu * NWAVES + F.wave, NGW = F.G * NWAVES;
    for (int it = gw; it < MOE_CONV_ITEMS; it += NGW) moe_weight_item(F, A, layer, it, scr);
}
constexpr int CONV_LDS_OFF = 69632;
__device__ __forceinline__ int conv_rounds(const Frame& F) { return F.G >= 256 ? 6 : (F.G >= 128 ? 12 : (MOE_CONV_ITEMS + F.G * NWAVES - 1) / (F.G * NWAVES)); }
__device__ __forceinline__ void moe_weight_round(Frame& F, const InPtrs& A, int layer, int round) {
    const int it = round * (F.G * NWAVES) + F.vcu * NWAVES + F.wave;
    Frame Fc = F; { int l_ = F.lane; asm volatile("" : "+v"(l_)); Fc.lane = l_; }
    if (it < MOE_CONV_ITEMS) moe_weight_item(Fc, A, layer, it, F.lds + CONV_LDS_OFF + F.wave * TR_WAVE_BYTES);
}
template <bool FFN, bool FIRST>
__device__ __forceinline__ void norm_phase(Frame& F, const InPtrs& A, int layer, bool combine, int nrows, float cmul = 1.0f) {
    constexpr bool first = FIRST;
    const int gw = F.vcu * NWAVES + F.wave, NGW = F.G * NWAVES, lane = F.lane;
    const float* MOD = (const float*)(F.ws + WS_MOD);
    LAS float* rT = (LAS float*)F.lds;
    if (FFN) {
        const float* R = A[I_ROUTER] + (size_t)layer * 1024 * 16;
        for (int i = F.tid; i < 16 * 1024; i += NTHREADS) { const int k = i >> 4, e = i & 15; rT[e * 1024 + k] = R[i]; }
        __syncthreads();
    }
#define NPC(q) (8 * (64 * ((q) >> 1) + lane) + 4 * ((q) & 1))
    const float* gvec = (FFN ? A[I_NFFN] : A[I_NMIX]) + layer * 1024;
    f32x4 gn[4];
#pragma unroll
    for (int j = 0; j < 4; ++j) gn[j] = *(const f32x4*)(gvec + NPC(j));
    const bf16* YB = (const bf16*)(F.ws + R_YB);
    const int* SLOT = (const int*)(F.ws + WS_SLOT);
    const float* A_x = first ? A[I_X] : nullptr; const float* A_c = first ? A[I_CTX] : nullptr;
    f32x4 xaf[4], xbf[4]; v4u xab[2], xbb[2]; int sla = -1, slb = -1;
    v4u wB[4][2], wC[4][2]; int sB[4] = {-1, -1, -1, -1}, sC[4] = {-1, -1, -1, -1}; unsigned restB = 0u, restC = 0u;
#define NP_LOADX(mm, XF, XB_, SL) do { if (first) { const float* src_ = (mm) < NLAT ? A_x + (size_t)(mm) * D : A_c + (size_t)((mm) - NLAT) * D; \
        _Pragma("unroll") for (int j = 0; j < 4; ++j) XF[j] = *(const f32x4*)(src_ + NPC(j)); } \
      else { const bf16* src_ = xb_row(F, (mm)); _Pragma("unroll") for (int k = 0; k < 2; ++k) XB_[k] = *(const v4u*)(src_ + NPC(2 * k)); } \
      if (combine) SL = SLOT[(size_t)(mm) * 16 + (lane & 15)]; } while (0)
#define NP_LOADW(SL, W, SI, REST) do { unsigned msk_ = (unsigned)(__ballot((SL) >= 0) & 0xffffull); \
        _Pragma("unroll") for (int q = 0; q < 4; ++q) { SI[q] = -1; if (msk_) { const int e_ = __builtin_ctz(msk_); msk_ &= msk_ - 1u; SI[q] = __builtin_amdgcn_readlane((SL), e_); } } \
        REST = msk_; \
        _Pragma("unroll") for (int q = 0; q < 4; ++q) if (SI[q] >= 0) { const bf16* y_ = YB + (size_t)SI[q] * 1024; \
            _Pragma("unroll") for (int k = 0; k < 2; ++k) W[q][k] = *(const v4u*)(y_ + NPC(2 * k)); } } while (0)
    if (gw < nrows) { NP_LOADX(gw, xbf, xbb, slb); }
    if (gw + NGW < nrows) { NP_LOADX(gw + NGW, xaf, xab, sla); }
    if (combine && gw < nrows) { NP_LOADW(slb, wB, sB, restB); }
    for (int m = gw; m < nrows; m += NGW) {
        const bool lat = m < NLAT; const int rr = lat ? (m >> 12) : 8;
        f32x4 v[4]; const int slc = slb;
#pragma unroll
        for (int k = 0; k < 2; ++k) { v[2 * k] = first ? xbf[2 * k] : (f32x4){bflo(xbb[k].x), bfhi(xbb[k].x), bflo(xbb[k].y), bfhi(xbb[k].y)}; v[2 * k + 1] = first ? xbf[2 * k + 1] : (f32x4){bflo(xbb[k].z), bfhi(xbb[k].z), bflo(xbb[k].w), bfhi(xbb[k].w)}; }
#pragma unroll
        for (int q = 0; q < 4; ++q) { sC[q] = sB[q]; wC[q][0] = wB[q][0]; wC[q][1] = wB[q][1]; }
        restC = restB;
#pragma unroll
        for (int j = 0; j < 4; ++j) xbf[j] = xaf[j];
        xbb[0] = xab[0]; xbb[1] = xab[1];
        slb = sla;
        { const int m2 = m + 2 * NGW; if (m2 < nrows) { NP_LOADX(m2, xaf, xab, sla); } }
        if (combine) { if (m + NGW < nrows) { NP_LOADW(slb, wB, sB, restB); } }
        if (combine) {
            f32x4 acc[4];
#pragma unroll
            for (int j = 0; j < 4; ++j) acc[j] = (f32x4){0.f, 0.f, 0.f, 0.f};
#pragma unroll
            for (int q = 0; q < 4; ++q) if (sC[q] >= 0) {
#pragma unroll
                for (int k = 0; k < 2; ++k) { acc[2 * k] += (f32x4){bflo(wC[q][k].x), bfhi(wC[q][k].x), bflo(wC[q][k].y), bfhi(wC[q][k].y)}; acc[2 * k + 1] += (f32x4){bflo(wC[q][k].z), bfhi(wC[q][k].z), bflo(wC[q][k].w), bfhi(wC[q][k].w)}; } }
            while (restC) {
                const int e = __builtin_ctz(restC); restC &= restC - 1u; const int sidx = __builtin_amdgcn_readlane(slc, e);
                const bf16* y = YB + (size_t)sidx * 1024;
#pragma unroll
                for (int k = 0; k < 2; ++k) { const v4u w = *(const v4u*)(y + NPC(2 * k)); acc[2 * k] += (f32x4){bflo(w.x), bfhi(w.x), bflo(w.y), bfhi(w.y)}; acc[2 * k + 1] += (f32x4){bflo(w.z), bfhi(w.z), bflo(w.w), bfhi(w.w)}; }
            }
            const float* g2 = MOD + ((size_t)(layer - 1) * 9 + rr) * 6144 + 5120;
#pragma unroll
            for (int j = 0; j < 4; ++j) v[j] += *(const f32x4*)(g2 + NPC(j)) * acc[j] * cmul;
        }
        if (first || combine) { bf16* dst = xb_row(F, m);
#pragma unroll
            for (int k = 0; k < 2; ++k) { v4u w; w.x = pk2(v[2 * k].x, v[2 * k].y); w.y = pk2(v[2 * k].z, v[2 * k].w); w.z = pk2(v[2 * k + 1].x, v[2 * k + 1].y); w.w = pk2(v[2 * k + 1].z, v[2 * k + 1].w);
                *(v4u*)(dst + NPC(2 * k)) = w;
                v[2 * k] = (f32x4){bflo(w.x), bfhi(w.x), bflo(w.y), bfhi(w.y)}; v[2 * k + 1] = (f32x4){bflo(w.z), bfhi(w.z), bflo(w.w), bfhi(w.w)}; } }
        float ss = 0.f;
#pragma unroll
        for (int j = 0; j < 4; ++j) ss += (v[j].x * v[j].x + v[j].y * v[j].y) + (v[j].z * v[j].z + v[j].w * v[j].w);
        const float r = 1.0f / sqrtf(wave_sum(ss) * (1.0f / D) + EPS);
        const float* mrow = MOD + ((size_t)layer * 9 + rr) * 6144 + (FFN ? 3072 : 0);
        f32x4 h[4];
#pragma unroll
        for (int j = 0; j < 4; ++j) { const f32x4 sh = *(const f32x4*)(mrow + NPC(j)), sc = *(const f32x4*)(mrow + 1024 + NPC(j));
            h[j] = (v[j] * r * gn[j]) * (sc + 1.0f) + sh; }
        bf16* hrow = (bf16*)(F.ws + WS_H) + (size_t)m * D;
#pragma unroll
        for (int k = 0; k < 2; ++k) { v4u w; w.x = pk2(h[2 * k].x, h[2 * k].y); w.y = pk2(h[2 * k].z, h[2 * k].w); w.z = pk2(h[2 * k + 1].x, h[2 * k + 1].y); w.w = pk2(h[2 * k + 1].z, h[2 * k + 1].w); *(v4u*)(hrow + NPC(2 * k)) = w; }
        if (FFN) {
            float lg[16];
            LAS float* rTm = rT + 8 * lane; asm volatile("" : "+v"(rTm));
#pragma unroll
            for (int e = 0; e < 16; ++e) { float s = 0.f;
#pragma unroll
                for (int j = 0; j < 4; ++j) { const f32x4 w = *(const LAS f32x4*)(rTm + e * 1024 + 512 * (j >> 1) + 4 * (j & 1)); s += (h[j].x * w.x + h[j].y * w.y) + (h[j].z * w.z + h[j].w * w.w); }
                lg[e] = wave_sum(s); }
            float mx = lg[0];
#pragma unroll
            for (int e = 1; e < 16; ++e) mx = fmaxf(mx, lg[e]);
            float den = 0.f;
#pragma unroll
            for (int e = 0; e < 16; ++e) { lg[e] = expf(lg[e] - mx); den += lg[e]; }
            float mine = 0.f;
#pragma unroll
            for (int e = 0; e < 16; ++e) mine = (lane == e) ? lg[e] : mine;
            if (lane < 16) { ((float*)(F.ws + WS_AFF))[(size_t)m * 16 + lane] = mine / den; ((int*)(F.ws + WS_SLOT))[(size_t)m * 16 + lane] = -1; }
        }
    }
}
#undef NP_LOADX
#undef NP_LOADW
#undef NPC
__device__ __forceinline__ void final_phase(Frame& F, int layer) {
    const int gw = F.vcu * NWAVES + F.wave, NGW = F.G * NWAVES, lane = F.lane;
    const float* MOD = (const float*)(F.ws + WS_MOD);
    const bf16* YB = (const bf16*)(F.ws + R_YB); const int* SLOT = (const int*)(F.ws + WS_SLOT);
    v2u vn[4]; int sln = -1;
    if (gw < NLAT) { const bf16* src = xb_row(F, gw);
#pragma unroll
        for (int j = 0; j < 4; ++j) vn[j] = *(const v2u*)(src + 4 * (64 * j + lane));
        sln = SLOT[(size_t)gw * 16 + (lane & 15)]; }
    for (int m = gw; m < NLAT; m += NGW) {
        float* xr = F.out + (size_t)m * D; const int rr = m >> 12;
        f32x4 v[4]; const int sl = sln;
#pragma unroll
        for (int j = 0; j < 4; ++j) v[j] = (f32x4){bflo(vn[j].x), bfhi(vn[j].x), bflo(vn[j].y), bfhi(vn[j].y)};
        { const int mn = m + NGW; if (mn < NLAT) { const bf16* src = xb_row(F, mn);
#pragma unroll
            for (int j = 0; j < 4; ++j) vn[j] = *(const v2u*)(src + 4 * (64 * j + lane));
            sln = SLOT[(size_t)mn * 16 + (lane & 15)]; } }
        f32x4 acc[4];
#pragma unroll
        for (int j = 0; j < 4; ++j) acc[j] = (f32x4){0.f, 0.f, 0.f, 0.f};
        unsigned msk = (unsigned)(__ballot(sl >= 0) & 0xffffull);
        while (msk) {
            int sidx[4]; v2u w[4][4];
#pragma unroll
            for (int q = 0; q < 4; ++q) { sidx[q] = -1; if (msk) { const int e = __builtin_ctz(msk); msk &= msk - 1u; sidx[q] = __builtin_amdgcn_readlane(sl, e); } }
#pragma unroll
            for (int q = 0; q < 4; ++q) if (sidx[q] >= 0) { const bf16* y = YB + (size_t)sidx[q] * 1024;
#pragma unroll
                for (int j = 0; j < 4; ++j) w[q][j] = *(const v2u*)(y + 4 * (64 * j + lane)); }
#pragma unroll
            for (int q = 0; q < 4; ++q) if (sidx[q] >= 0) {
#pragma unroll
                for (int j = 0; j < 4; ++j) acc[j] += (f32x4){bflo(w[q][j].x), bfhi(w[q][j].x), bflo(w[q][j].y), bfhi(w[q][j].y)}; }
        }
        const float* g2 = MOD + ((size_t)layer * 9 + rr) * 6144 + 5120;
#pragma unroll
        for (int j = 0; j < 4; ++j) *(f32x4*)(xr + 4 * (64 * j + lane)) = v[j] + *(const f32x4*)(g2 + 4 * (64 * j + lane)) * acc[j];
    }
}
__device__ __forceinline__ void unpack8(const v4u w, float* f) { f[0] = bflo(w.x); f[1] = bfhi(w.x); f[2] = bflo(w.y); f[3] = bfhi(w.y); f[4] = bflo(w.z); f[5] = bfhi(w.z); f[6] = bflo(w.w); f[7] = bfhi(w.w); }
__device__ __forceinline__ v4u pack8(const float* f) { v4u w; w.x = pk2(f[0], f[1]); w.y = pk2(f[2], f[3]); w.z = pk2(f[4], f[5]); w.w = pk2(f[6], f[7]); return w; }
__device__ __forceinline__ void unpack4(const v2u w, float* f) { f[0] = bflo(w.x); f[1] = bfhi(w.x); f[2] = bflo(w.y); f[3] = bfhi(w.y); }
__device__ __forceinline__ v2u pack4(const float* f) { v2u w; w.x = pk2(f[0], f[1]); w.y = pk2(f[2], f[3]); return w; }

struct MfRow { v4u cq; v2u ckv; v4u k0, k1; v2u kr0, kr1; v4u v0, v1; f32x4 cs, sn; };
__device__ __forceinline__ void mf_load(MfRow& R, int m, const bf16* KVPRE, const bf16* DOWN, const float* ca, const float* sa, int lane, int h, int p) {
    const bf16* dr = DOWN + (size_t)m * 1024;
    R.cq = *(const v4u*)(dr + 8 * lane); R.ckv = *(const v2u*)(dr + 512 + 4 * lane);
    const bf16* s = KVPRE + (size_t)m * 2048 + h * 128; const bf16* kr = dr + 768;
    { const v4u* pp = (const v4u*)(s + 16 * p); R.k0 = pp[0]; R.k1 = pp[1]; R.kr0 = *(const v2u*)(kr + 4 * p); R.kr1 = *(const v2u*)(kr + 16 + 4 * p); }
    { const v4u* vs = (const v4u*)(s + 64 + 16 * p); R.v0 = vs[0]; R.v1 = vs[1]; }
    if (m < NLAT) { const int t = m & 4095; R.cs = *(const f32x4*)(ca + t * 16 + 4 * p); R.sn = *(const f32x4*)(sa + t * 16 + 4 * p); }
    else { R.cs = (f32x4){1.f, 1.f, 1.f, 1.f}; R.sn = (f32x4){0.f, 0.f, 0.f, 0.f}; }
}
__device__ __forceinline__ void mla_finish_phase(Frame& F, const InPtrs& A, int j) {
    const int gw = F.vcu * NWAVES + F.wave, NGW = F.G * NWAVES, lane = F.lane, h = lane >> 2, p = lane & 3;
    const bf16* DOWN = (const bf16*)(F.ws + R_DOWN); const bf16* KVPRE = (const bf16*)(F.ws + R_KVPRE);
    bf16* MK = (bf16*)(F.ws + R_MK); bf16* MV = (bf16*)(F.ws + R_MV); float* RQ = (float*)(F.ws + WS_RQ);
    const float* ca = (const float*)(F.ws + WS_ROPEA); const float* sa = ca + 4096 * 16;
    float gk[24];
    { const float* k = A[I_MLA_KN] + j * 96;
#pragma unroll
      for (int i = 0; i < 16; ++i) gk[i] = k[16 * p + i];
#pragma unroll
      for (int i = 0; i < 4; ++i) { gk[16 + i] = k[64 + 4 * p + i]; gk[20 + i] = k[80 + 4 * p + i]; } }
    MfRow N;
    if (gw < MROWS) mf_load(N, gw, KVPRE, DOWN, ca, sa, lane, h, p);
    for (int m = gw; m < MROWS; m += NGW) {
        const MfRow R = N;
        { const int mn = m + NGW; if (mn < MROWS) mf_load(N, mn, KVPRE, DOWN, ca, sa, lane, h, p); }
        const bool lat = m < NLAT; const int b = lat ? (m >> 12) : ((m - NLAT) >> 8), t = lat ? (m & 4095) : ((m - NLAT) & 255);
        float c8[8], c4[4]; unpack8(R.cq, c8); unpack4(R.ckv, c4);
        float sq = 0.f, skv = 0.f;
#pragma unroll
        for (int i = 0; i < 8; ++i) sq += c8[i] * c8[i];
#pragma unroll
        for (int i = 0; i < 4; ++i) skv += c4[i] * c4[i];
        sq = wave_sum(sq); skv = wave_sum(skv);
        const float rq = 1.0f / sqrtf(sq * (1.0f / 512.0f) + EPS), rkv = 1.0f / sqrtf(skv * (1.0f / 256.0f) + EPS);
        if (lane == 0) RQ[m] = rq;
        float v[24]; unpack8(R.k0, v); unpack8(R.k1, v + 8); unpack4(R.kr0, v + 16); unpack4(R.kr1, v + 20);
#pragma unroll
        for (int i = 0; i < 16; ++i) v[i] *= rkv;
        float ss = 0.f;
#pragma unroll
        for (int i = 0; i < 24; ++i) ss += v[i] * v[i];
        ss += shx<1>(ss); ss += shx<2>(ss);
        const float r = 1.0f / sqrtf(ss * (1.0f / 96.0f) + EPS);
#pragma unroll
        for (int i = 0; i < 24; ++i) v[i] = v[i] * r * gk[i];
#pragma unroll
        for (int i = 0; i < 4; ++i) { const float x1 = v[16 + i], x2 = v[20 + i]; v[16 + i] = x1 * R.cs[i] - x2 * R.sn[i]; v[20 + i] = x1 * R.sn[i] + x2 * R.cs[i]; }
        const int key = lat ? 256 + t : t;
        bf16* d = MK + (((size_t)b * 16 + h) * NKEYS + key) * 96;
        { v4u* o = (v4u*)(d + 16 * p); o[0] = pack8(v); o[1] = pack8(v + 8); *(v2u*)(d + 64 + 4 * p) = pack4(v + 16); *(v2u*)(d + 80 + 4 * p) = pack4(v + 20); }
        float vv[16]; unpack8(R.v0, vv); unpack8(R.v1, vv + 8);
#pragma unroll
        for (int i = 0; i < 16; ++i) vv[i] *= rkv;
        v4u* vd = (v4u*)(MV + (((size_t)b * 16 + h) * NKEYS + key) * 64 + 16 * p);
        vd[0] = pack8(vv); vd[1] = pack8(vv + 8);
    }
}
struct DqRow { v4u q0, q1, k0, k1; f32x4 c0, c1, s0, s1; };
__device__ __forceinline__ void dq_load(DqRow& R, int m, const bf16* QKV, const float* cb, const float* sb, int u, int p) {
    const bf16* s = QKV + (size_t)m * 3072 + u * 64;
    R.q0 = *(const v4u*)(s + 8 * p); R.q1 = *(const v4u*)(s + 32 + 8 * p); R.k0 = *(const v4u*)(s + 1024 + 8 * p); R.k1 = *(const v4u*)(s + 1024 + 32 + 8 * p);
    if (m < NLAT) { const int t = m & 4095; R.c0 = *(const f32x4*)(cb + t * 32 + 8 * p); R.c1 = *(const f32x4*)(cb + t * 32 + 8 * p + 4); R.s0 = *(const f32x4*)(sb + t * 32 + 8 * p); R.s1 = *(const f32x4*)(sb + t * 32 + 8 * p + 4); }
    else { R.c0 = R.c1 = (f32x4){1.f, 1.f, 1.f, 1.f}; R.s0 = R.s1 = (f32x4){0.f, 0.f, 0.f, 0.f}; }
}
__device__ __forceinline__ void diff_finish_qk_phase(Frame& F, const InPtrs& A) {
    const int gw = F.vcu * NWAVES + F.wave, NGW = F.G * NWAVES, lane = F.lane, u = lane >> 2, p = lane & 3;
    const bf16* QKV = (const bf16*)(F.ws + R_QKV);
    bf16* DQ = (bf16*)(F.ws + R_DQ); bf16* DQC = (bf16*)(F.ws + R_DQC); bf16* DK = (bf16*)(F.ws + R_DK);
    const float* cb = (const float*)(F.ws + WS_ROPEB); const float* sb = cb + 4096 * 32;
    float gq[16], gk[16];
    { const float* qn = A[I_DF_QN]; const float* kn = A[I_DF_KN];
#pragma unroll
      for (int i = 0; i < 8; ++i) { gq[i] = qn[8 * p + i] * att::Sc<64>::C; gq[8 + i] = qn[32 + 8 * p + i] * att::Sc<64>::C; gk[i] = kn[8 * p + i]; gk[8 + i] = kn[32 + 8 * p + i]; } }
    DqRow N;
    if (gw < MROWS) dq_load(N, gw, QKV, cb, sb, u, p);
    for (int m = gw; m < MROWS; m += NGW) {
        const DqRow R = N;
        { const int mn = m + NGW; if (mn < MROWS) dq_load(N, mn, QKV, cb, sb, u, p); }
        const bool lat = m < NLAT; const int b = lat ? (m >> 12) : ((m - NLAT) >> 8), t = lat ? (m & 4095) : ((m - NLAT) & 255);
        float cs[8], sn[8];
#pragma unroll
        for (int i = 0; i < 4; ++i) { cs[i] = R.c0[i]; cs[4 + i] = R.c1[i]; sn[i] = R.s0[i]; sn[4 + i] = R.s1[i]; }
#pragma unroll
        for (int isk = 0; isk < 2; ++isk) {
            float v[16]; unpack8(isk ? R.k0 : R.q0, v); unpack8(isk ? R.k1 : R.q1, v + 8);
            float ss = 0.f;
#pragma unroll
            for (int i = 0; i < 16; ++i) ss += v[i] * v[i];
            ss += shx<1>(ss); ss += shx<2>(ss);
            const float r = 1.0f / sqrtf(ss * (1.0f / 64.0f) + EPS);
#pragma unroll
            for (int i = 0; i < 16; ++i) v[i] = v[i] * r * (isk ? gk[i] : gq[i]);
#pragma unroll
            for (int i = 0; i < 8; ++i) { const float x1 = v[i], x2 = v[8 + i]; v[i] = x1 * cs[i] - x2 * sn[i]; v[8 + i] = x1 * sn[i] + x2 * cs[i]; }
            bf16* d;
            if (isk) d = DK + (((size_t)b * 16 + u) * NKEYS + (lat ? 256 + t : t)) * 64;
            else d = lat ? DQ + (((size_t)b * 16 + u) * 4096 + t) * 64 : DQC + (((size_t)b * 16 + u) * 256 + t) * 64;
            *(v4u*)(d + 8 * p) = pack8(v); *(v4u*)(d + 32 + 8 * p) = pack8(v + 8);
        }
    }
}
__device__ __forceinline__ void diff_finish_o_phase(Frame& F, const InPtrs& A, float lam_init) {
    const int gw = F.vcu * NWAVES + F.wave, NGW = F.G * NWAVES, lane = F.lane, h = lane >> 3, p = lane & 7;
    const bf16* OB = (const bf16*)(F.ws + R_OB); bf16* AO = (bf16*)(F.ws + R_DAO);
    const float d1 = wave_sum(A[I_DF_LQ1][lane] * A[I_DF_LK1][lane]), d2 = wave_sum(A[I_DF_LQ2][lane] * A[I_DF_LK2][lane]);
    const float lam = expf(d1) - expf(d2) + lam_init, post = 1.0f - lam_init;
    float g[16];
    { const float* sg = A[I_DF_SUBG];
#pragma unroll
      for (int i = 0; i < 16; ++i) g[i] = sg[16 * p + i] * post; }
    v4u n0 = (v4u){0u, 0u, 0u, 0u}, n1 = n0, n2 = n0, n3 = n0;
    if (gw < MROWS) { const bf16* s0 = OB + (size_t)gw * 2048 + (2 * h) * 128 + 16 * p; n0 = ((const v4u*)s0)[0]; n1 = ((const v4u*)s0)[1]; n2 = ((const v4u*)(s0 + 128))[0]; n3 = ((const v4u*)(s0 + 128))[1]; }
    for (int m = gw; m < MROWS; m += NGW) {
        const v4u c0 = n0, c1 = n1, c2 = n2, c3 = n3;
        { const int mn = m + NGW; if (mn < MROWS) { const bf16* s0 = OB + (size_t)mn * 2048 + (2 * h) * 128 + 16 * p; n0 = ((const v4u*)s0)[0]; n1 = ((const v4u*)s0)[1]; n2 = ((const v4u*)(s0 + 128))[0]; n3 = ((const v4u*)(s0 + 128))[1]; } }
        float a[16], c[16];
        unpack8(c0, a); unpack8(c1, a + 8); unpack8(c2, c); unpack8(c3, c + 8);
        float ss = 0.f;
#pragma unroll
        for (int i = 0; i < 16; ++i) { a[i] = a[i] - lam * c[i]; ss += a[i] * a[i]; }
        ss += shx<1>(ss); ss += shx<2>(ss); ss += shx<4>(ss);
        const float r = 1.0f / sqrtf(ss * (1.0f / 128.0f) + EPS);
#pragma unroll
        for (int i = 0; i < 16; ++i) a[i] = a[i] * r * g[i];
        v4u* o = (v4u*)(AO + (size_t)m * 1024 + h * 128 + 16 * p); o[0] = pack8(a); o[1] = pack8(a + 8);
    }
}
__device__ __forceinline__ void sg_ln_item(Frame& F, const InPtrs& A, int chunk, int g_lo, int g_hi) {
    const bf16* Z = (const bf16*)(F.ws + R_Z); bf16* VNT = (bf16*)(F.ws + R_VNT);
    LAS float* st = (LAS float*)F.lds;
    LAS unsigned short* T = (LAS unsigned short*)(F.lds + 1024);
    constexpr int TS = 258;
    const int lane = F.lane, tid = F.tid;
    {
        const bf16* vr0 = Z + ((size_t)chunk * 128 + F.wave * 16) * 4096 + 2048;
        v4u nx[4];
#pragma unroll
        for (int i = 0; i < 4; ++i) nx[i] = *(const v4u*)(vr0 + 8 * (lane + 64 * i));
        for (int qi = 0; qi < 16; ++qi) {
            float x[32];
#pragma unroll
            for (int i = 0; i < 4; ++i) unpack8(nx[i], x + 8 * i);
            if (qi < 15) {
#pragma unroll
                for (int i = 0; i < 4; ++i) nx[i] = *(const v4u*)(vr0 + (size_t)(qi + 1) * 4096 + 8 * (lane + 64 * i)); }
            float s = 0.f;
#pragma unroll
            for (int i = 0; i < 32; ++i) s += x[i];
            const float mean = wave_sum(s) * (1.0f / 2048.0f); float s2 = 0.f;
#pragma unroll
            for (int i = 0; i < 32; ++i) { const float d = x[i] - mean; s2 += d * d; }
            const float rstd = 1.0f / sqrtf(wave_sum(s2) * (1.0f / 2048.0f) + EPS);
            const int q = F.wave * 16 + qi;
            if (lane == 0) { st[2 * q] = mean; st[2 * q + 1] = rstd; }
        }
    }
    __syncthreads();
    for (int g = g_lo; g < g_hi; ++g) {
        v4u xin[8];
#pragma unroll
        for (int i = 0; i < 8; ++i) { const int id = tid + 512 * i, q = id >> 5, c0 = (id & 31) * 8; xin[i] = *(const v4u*)(Z + ((size_t)chunk * 128 + q) * 4096 + 2048 + g * 256 + c0); }
#pragma unroll
        for (int i = 0; i < 8; ++i) { const int id = tid + 512 * i, q = id >> 5, c0 = (id & 31) * 8;
            float x[8]; unpack8(xin[i], x);
            const float mean = st[2 * q], rstd = st[2 * q + 1];
            const float* lg = A[I_SG_LNG] + g * 256 + c0; const float* lb = A[I_SG_LNB] + g * 256 + c0;
#pragma unroll
            for (int k = 0; k < 8; ++k) T[q * TS + c0 + k] = (unsigned short)f2bf((x[k] - mean) * rstd * lg[k] + lb[k]); }
        __syncthreads();
#pragma unroll
        for (int i = 0; i < 8; ++i) { const int id = tid + 512 * i, c = id >> 4, q0 = (id & 15) * 8;
            v4u w; w.x = (unsigned)T[(q0 + 0) * TS + c] | ((unsigned)T[(q0 + 1) * TS + c] << 16); w.y = (unsigned)T[(q0 + 2) * TS + c] | ((unsigned)T[(q0 + 3) * TS + c] << 16);
            w.z = (unsigned)T[(q0 + 4) * TS + c] | ((unsigned)T[(q0 + 5) * TS + c] << 16); w.w = (unsigned)T[(q0 + 6) * TS + c] | ((unsigned)T[(q0 + 7) * TS + c] << 16);
            *(v4u*)(VNT + (((size_t)chunk * 8 + g) * 256 + c) * 128 + q0) = w; }
        __syncthreads();
    }
}
__device__ __forceinline__ void sg_ln_phase(Frame& F, const InPtrs& A) {
    constexpr int NCH = MROWS / 128;
    const int full = (NCH / F.G) * F.G;
    for (int chunk = F.vcu; chunk < full; chunk += F.G) sg_ln_item(F, A, chunk, 0, 8);
    for (int it = F.vcu; it < (NCH - full) * 8; it += F.G) sg_ln_item(F, A, full + (it >> 3), it & 7, (it & 7) + 1);
}
__device__ __forceinline__ void topk_phase(Frame& F, int ngroups) {
    const float* AFF = (const float*)(F.ws + WS_AFF); int* SLOT = (int*)(F.ws + WS_SLOT); float* GATE = (float*)(F.ws + WS_GATE);
    int* ROWSRC = (int*)(F.ws + R_XG);
    LAS unsigned* cnt = (LAS unsigned*)F.lds;
    LAS unsigned* cgt = cnt + 16;
    LAS unsigned* ceq = cnt + 80;
    LAS unsigned* tot = cnt + 144;
    LAS int* selrow = (LAS int*)(cnt + 160);
    const int tid = F.tid, lane = F.lane, wave = F.wave;
    for (int task = blockIdx.x; task < ngroups; task += F.G) {
        const bool lat = task < 128; const int gi = lat ? task : task - 128, b = gi >> 4, e = gi & 15;
        const int N = lat ? 4096 : 256, K = lat ? CAP_LAT : CAP_CTX, row0 = lat ? b * 4096 : NLAT + b * 256;
        const int pbase = e * EROWS + (lat ? b * CAP_LAT : NB * CAP_LAT + b * CAP_CTX);
        unsigned key[8]; bool valid[8];
#pragma unroll
        for (int i = 0; i < 8; ++i) { const int t = tid + 512 * i; valid[i] = t < N; key[i] = valid[i] ? __float_as_uint(AFF[(size_t)(row0 + t) * 16 + e]) : 0u; }
        unsigned prefix = 0u;
        for (int bit = 30; bit >= 0; --bit) {
            const unsigned cand = prefix | (1u << bit); unsigned c = 0;
#pragma unroll
            for (int i = 0; i < 8; ++i) c += (unsigned)__builtin_popcountll(__ballot(valid[i] && key[i] >= cand));
            LAS unsigned* cb = cnt + 8 * (bit & 1);
            if (lane == 0) cb[wave] = c;
            __syncthreads();
            unsigned total = 0;
#pragma unroll
            for (int w = 0; w < 8; ++w) total += cb[w];
            if (total >= (unsigned)K) prefix = cand;
        }
        const unsigned T = prefix;
        unsigned long long bgt[8], beq[8];
#pragma unroll
        for (int i = 0; i < 8; ++i) { bgt[i] = __ballot(valid[i] && key[i] > T); beq[i] = __ballot(valid[i] && key[i] == T);
            if (lane == 0) { cgt[i * 8 + wave] = (unsigned)__builtin_popcountll(bgt[i]); ceq[i * 8 + wave] = (unsigned)__builtin_popcountll(beq[i]); } }
        __syncthreads();
        if (wave == 0) {
            unsigned pa = 0u, pq = 0u, ta = 0u, tq = 0u;
            for (int k = 0; k < 64; ++k) { const unsigned a = cgt[k], q = ceq[k]; ta += a; tq += q; if (k < lane) { pa += a; pq += q; } }
            LDS_WAIT();
            cgt[lane] = pa; ceq[lane] = pq;
            if (lane == 63) { tot[0] = ta; tot[1] = tq; }
        }
        __syncthreads();
        const unsigned n_gt = tot[0], need_eq = (unsigned)K - n_gt;
        const unsigned long long lmask = (1ull << lane) - 1ull;
#pragma unroll
        for (int i = 0; i < 8; ++i) {
            const bool isgt = (bgt[i] >> lane) & 1ull, iseq = (beq[i] >> lane) & 1ull;
            const unsigned pg = cgt[i * 8 + wave] + (unsigned)__builtin_popcountll(bgt[i] & lmask), pe = ceq[i * 8 + wave] + (unsigned)__builtin_popcountll(beq[i] & lmask);
            const bool sel = isgt || (iseq && pe < need_eq);
            if (sel) { const unsigned pos = isgt ? pg : n_gt + pe; const int row = row0 + tid + 512 * i;
                SLOT[(size_t)row * 16 + e] = pbase + (int)pos; GATE[pbase + pos] = __uint_as_float(key[i]); ROWSRC[pbase + pos] = row; }
        }
        __syncthreads();
        __syncthreads();
    }
}

template <int DK> __device__ __forceinline__ float att_bound(const float* gq, const float* gk, int n, int lane) {
    float mq = 0.f, mk = 0.f;
    for (int i = lane; i < n; i += 64) { mq = fmaxf(mq, fabsf(gq[i])); mk = fmaxf(mk, fabsf(gk[i])); }
    mq = fmaxf(mq, shx<1>(mq)); mq = fmaxf(mq, shx<2>(mq)); mq = fmaxf(mq, shx<4>(mq)); mq = fmaxf(mq, shx<8>(mq)); mq = fmaxf(mq, shx<16>(mq));
    mk = fmaxf(mk, shx<1>(mk)); mk = fmaxf(mk, shx<2>(mk)); mk = fmaxf(mk, shx<4>(mk)); mk = fmaxf(mk, shx<8>(mk)); mk = fmaxf(mk, shx<16>(mk));
    mq = fmaxf(__builtin_bit_cast(float, __builtin_amdgcn_readlane(__builtin_bit_cast(int, mq), 0)), __builtin_bit_cast(float, __builtin_amdgcn_readlane(__builtin_bit_cast(int, mq), 32)));
    mk = fmaxf(__builtin_bit_cast(float, __builtin_amdgcn_readlane(__builtin_bit_cast(int, mk), 0)), __builtin_bit_cast(float, __builtin_amdgcn_readlane(__builtin_bit_cast(int, mk), 32)));
    const float bound = sqrtf((float)DK) * mq * mk;
    return __builtin_bit_cast(float, __builtin_amdgcn_readfirstlane(__builtin_bit_cast(int, bound)));
}
__device__ __forceinline__ void mla_attn_phase(Frame& F, const InPtrs& A, int jl, bool do_ctx, int conv_layer) {
    int cround = 0;
    const bf16* QPRE = (const bf16*)(F.ws + R_QPRE); const float* RQ = (const float*)(F.ws + WS_RQ); const bf16* MK = (const bf16*)(F.ws + R_MK); const bf16* MV = (const bf16*)(F.ws + R_MV);
    bf16* AO = (bf16*)(F.ws + R_AO);
    const float* gq = A[I_MLA_QN] + jl * 96; const float* ropeA = (const float*)(F.ws + WS_ROPEA);
    const float bound = att_bound<96>(gq, A[I_MLA_KN] + jl * 96, 96, F.lane);
    const bool use_off = bound > 60.0f;
    const int nunits = 2048 + (do_ctx ? 128 : 0);
    for (int u = F.vcu; u < nunits; u += F.G) {
        const bool lat = u < 2048; const int bh = lat ? (u >> 4) : (u - 2048), qb = lat ? (u & 15) : 0, b = bh >> 4, h = bh & 15;
        const int row0 = lat ? b * 4096 + qb * 256 : NLAT + b * 256;
        const att::QLoadMLA QL{QPRE + (size_t)row0 * 1536 + h * 96, RQ + row0, gq, lat ? ropeA + (size_t)(qb * 256) * 16 : nullptr};
        const bf16* Kp = MK + (size_t)bh * NKEYS * 96; const bf16* Vp = MV + (size_t)bh * NKEYS * 64;
        bf16* Op = AO + (size_t)row0 * 1024 + h * 64;
        if (!use_off) att::body_dma<96, 64, false>(QL, Kp, Kp + 256 * 96, 96, Vp, Vp + 256 * 64, 64, Op, 1024, lat ? NKEYS : 256, 0.f, (char*)F.lds, F.tid);
        else { int bi_ = __builtin_amdgcn_readfirstlane(__builtin_bit_cast(int, bound)); asm volatile("" : "+s"(bi_)); const float nm_ = -fminf(__builtin_bit_cast(float, bi_), 30.0f) * 1.4426950408889634f;     att::body<96, 64, 2, true>(QL, Kp, Kp + 256 * 96, 96, Vp, Vp + 256 * 64, 64, Op, 1024, lat ? NKEYS : 256, nm_, (char*)F.lds, F.tid); }
        if (conv_layer >= 0 && cround < conv_rounds(F)) { moe_weight_round(F, A, conv_layer, cround); ++cround; __syncthreads(); }
    }
    if (conv_layer >= 0) for (; cround < conv_rounds(F); ++cround) moe_weight_round(F, A, conv_layer, cround);
}
__device__ __forceinline__ void diff_attn_phase(Frame& F, const InPtrs& A, bool do_ctx, int conv_layer) {
    int cround = 0;
    const bf16* DQ = (const bf16*)(F.ws + R_DQ); const bf16* DQC = (const bf16*)(F.ws + R_DQC); const bf16* DKp = (const bf16*)(F.ws + R_DK); const bf16* QKV = (const bf16*)(F.ws + R_QKV);
    bf16* OB = (bf16*)(F.ws + R_OB);
    const float bound = att_bound<64>(A[I_DF_QN], A[I_DF_KN], 64, F.lane);
    const bool use_off = bound > 60.0f;
    const int nunits = 2048 + (do_ctx ? 128 : 0);
    for (int u = F.vcu; u < nunits; u += F.G) {
        const bool lat = u < 2048; const int bh = lat ? (u >> 4) : (u - 2048), qb = lat ? (u & 15) : 0, b = bh >> 4, vh = bh & 15, h = vh >> 1;
        const bf16* Qp = lat ? DQ + ((size_t)bh * 4096 + qb * 256) * 64 : DQC + (size_t)bh * 256 * 64;
        const bf16* Kp = DKp + (size_t)bh * NKEYS * 64;
        const bf16* V0 = QKV + (size_t)(NLAT + b * 256) * 3072 + 2048 + h * 128; const bf16* V1 = QKV + (size_t)(b * 4096) * 3072 + 2048 + h * 128;
        bf16* Op = OB + (size_t)(lat ? b * 4096 + qb * 256 : NLAT + b * 256) * 2048 + vh * 128;
        const att::QLoadPlain QL{Qp, 64};
        if (!use_off) att::body_dma<64, 128, false>(QL, Kp, Kp + 256 * 64, 64, V0, V1, 3072, Op, 2048, lat ? NKEYS : 256, 0.f, (char*)F.lds, F.tid);
        else { int bi_ = __builtin_amdgcn_readfirstlane(__builtin_bit_cast(int, bound)); asm volatile("" : "+s"(bi_)); const float nm_ = -fminf(__builtin_bit_cast(float, bi_), 30.0f) * 1.4426950408889634f;     att::body<64, 128, 1, true>(QL, Kp, Kp + 256 * 64, 64, V0, V1, 3072, Op, 2048, lat ? NKEYS : 256, nm_, (char*)F.lds, F.tid); }
        if (conv_layer >= 0 && cround < conv_rounds(F)) { moe_weight_round(F, A, conv_layer, cround); ++cround; __syncthreads(); }
    }
    if (conv_layer >= 0) for (; cround < conv_rounds(F); ++cround) moe_weight_round(F, A, conv_layer, cround);
}

#ifndef PG8_SP2
#define PG8_SP2 true
#endif
#ifndef PG8_ALIGN
#define PG8_ALIGN true
#endif
#define GEMM_CALL(EPI, ORD, g, S, E) pg8::gemm_phase<EPI, ORD, PG8_ALIGN, PG8_SP2>(F.lds, g, S, E, F.tid)

__global__ void __launch_bounds__(NTHREADS, 2) fwd_kernel(Args args) {
    extern __shared__ __attribute__((aligned(16))) unsigned char lds[];
    Frame FM;
    FM.lds = (LAS unsigned char*)lds;
    FM.tid = threadIdx.x; FM.lane = FM.tid & 63; FM.wave = __builtin_amdgcn_readfirstlane(FM.tid >> 6);
    FM.G = gridDim.x; { const int bx = blockIdx.x; FM.vcu = (FM.G % 8 == 0) ? (bx % 8) * (FM.G / 8) + bx / 8 : bx; }
    FM.ws = args.ws; FM.out = args.out;
    volatile LAS unsigned* MISC = (volatile LAS unsigned*)(FM.lds + MISC_OFF);
    if (FM.tid < 16) MISC[FM.tid] = 0u;
    if (FM.tid < 35) { const unsigned long long p = (unsigned long long)args.in[FM.tid]; MISC[16 + 2 * FM.tid] = (unsigned)p; MISC[17 + 2 * FM.tid] = (unsigned)(p >> 32); }
    __syncthreads();
    InPtrs A; A.tab = MISC + 16;
    XcdBarrier bar = xcd_barrier_post((unsigned*)(FM.ws + WS_CTL) + 4096, MISC + 8); bar.wave = FM.wave;
    const int lo = args.ph_lo, hi = args.ph_hi;
    int ph = 0;
#ifndef PHASE_MASK
#define PHASE_MASK 0xFFFFFFFFu
#endif
#define EN(b) ((PHASE_MASK >> (b)) & 1u)
#ifndef REP_MASK
#define REP_MASK 0u
#endif
#ifndef BAR_REP
#define BAR_REP 1
#endif
#define REPN(b) (((REP_MASK >> (b)) & 1u) ? 2 : 1)
#define PH_BEGIN if (ph >= lo && ph < hi) { Frame F = FM; { int t_ = FM.wave * 64 + hw_lane(); asm volatile("" : "+v"(t_)); F.tid = t_; F.lane = t_ & 63; F.wave = __builtin_amdgcn_readfirstlane(t_ >> 6); \
        size_t z_ = 0; asm volatile("" : "+s"(z_), "+s"(F.vcu), "+s"(F.G)); F.ws = FM.ws + z_; F.out = FM.out + z_; } \
        const float* MOD = (const float*)(F.ws + WS_MOD); bf16* H = (bf16*)(F.ws + WS_H); (void)MOD; (void)H;
#define PH_END   if (ph + 1 < hi) { for (int br_ = 0; br_ < BAR_REP; ++br_) xcd_barrier(bar); } } ++ph;

    PH_BEGIN for (int rep_ = 0; rep_ < REPN(0); ++rep_) if (EN(0)) p0_prologue(F, A); PH_END

    for (int layer = 0; layer < DEPTH; ++layer) {
        const int kind = layer % 3, jl = layer / 3;
        const bool last = layer == DEPTH - 1, ctx_out = !last;
        const int rows_out = ctx_out ? MROWS : NLAT;

        PH_BEGIN for (int rep_ = 0; rep_ < REPN(1); ++rep_) if (EN(1)) { if (layer == 0 && rep_ == 0) norm_phase<false, true>(F, A, layer, false, MROWS); else norm_phase<false, false>(F, A, layer, layer > 0, MROWS, rep_ == 0 ? 1.0f : 0.0f); } PH_END

        if (kind == 0) {
            const size_t wboff = WS_WNM + jl * MLA_W_STRIDE;
#define wb (F.ws + wboff)
            PH_BEGIN for (int rep_ = 0; rep_ < REPN(2); ++rep_) if (EN(2)) { pg8::Gemm g{H, (const bf16*)(wb + MLA_WIN), MROWS, 1024, 1024}; pg8::StaticOrder S; S.init(MROWS, 1024, F.G, (int)blockIdx.x);
                pg8::EpiStore<0> E{(bf16*)(F.ws + R_DOWN), 1024}; GEMM_CALL(pg8::EpiStore<0>, pg8::StaticOrder, g, S, E); } PH_END
            PH_BEGIN for (int rep_ = 0; rep_ < REPN(2); ++rep_) if (EN(2)) { { pg8::Gemm g{(const bf16*)(F.ws + R_DOWN), (const bf16*)(wb + MLA_WUQ), rows_out, 1536, 512, 1024}; pg8::StaticOrder S; S.init(rows_out, 1536, F.G, (int)blockIdx.x);
                         pg8::EpiStore<0> E{(bf16*)(F.ws + R_QPRE), 1536}; GEMM_CALL(pg8::EpiStore<0>, pg8::StaticOrder, g, S, E); }
                       __syncthreads();
                       { pg8::Gemm g{(const bf16*)(F.ws + R_DOWN) + 512, (const bf16*)(wb + MLA_WUKV), MROWS, 2048, 256, 1024}; pg8::StaticOrder S; S.init(MROWS, 2048, F.G, (int)blockIdx.x);
                         pg8::EpiStore<0> E{(bf16*)(F.ws + R_KVPRE), 2048}; GEMM_CALL(pg8::EpiStore<0>, pg8::StaticOrder, g, S, E); } } PH_END
            PH_BEGIN for (int rep_ = 0; rep_ < REPN(3); ++rep_) if (EN(3)) mla_finish_phase(F, A, jl); PH_END
            PH_BEGIN for (int rep_ = 0; rep_ < REPN(4); ++rep_) if (EN(4)) mla_attn_phase(F, A, jl, ctx_out, (EN(15) && rep_ == 0) ? layer : -1); PH_END
            PH_BEGIN for (int rep_ = 0; rep_ < REPN(14); ++rep_) if (EN(14)) { pg8::Gemm g{(const bf16*)(F.ws + R_AO), (const bf16*)(wb + MLA_WOUT), rows_out, 1024, 1024}; pg8::StaticOrder S; S.init(rows_out, 1024, F.G, (int)blockIdx.x);
                pg8::EpiResid E{(bf16*)(F.ws + WS_XB), MOD + (size_t)layer * 9 * 6144 + 2048, rep_ == 0 ? 1.0f : 0.0f}; GEMM_CALL(pg8::EpiResid, pg8::StaticOrder, g, S, E); } PH_END
#undef wb
        } else if (kind == 1) {
            PH_BEGIN for (int rep_ = 0; rep_ < REPN(12); ++rep_) if (EN(12)) { pg8::Gemm g{H, (const bf16*)(F.ws + WS_DIFF_WIN), MROWS, 3072, 1024}; pg8::StaticOrder S; S.init(MROWS, 3072, F.G, (int)blockIdx.x);
                pg8::EpiStore<0> E{(bf16*)(F.ws + R_QKV), 3072}; GEMM_CALL(pg8::EpiStore<0>, pg8::StaticOrder, g, S, E); } PH_END
            PH_BEGIN for (int rep_ = 0; rep_ < REPN(5); ++rep_) if (EN(5)) diff_finish_qk_phase(F, A); PH_END
            PH_BEGIN for (int rep_ = 0; rep_ < REPN(6); ++rep_) if (EN(6)) diff_attn_phase(F, A, ctx_out, (EN(15) && rep_ == 0) ? layer : -1); PH_END
            PH_BEGIN for (int rep_ = 0; rep_ < REPN(5); ++rep_) if (EN(5)) diff_finish_o_phase(F, A, 0.8f - 0.6f * expf(-0.3f * (float)layer)); PH_END
            PH_BEGIN for (int rep_ = 0; rep_ < REPN(14); ++rep_) if (EN(14)) { pg8::Gemm g{(const bf16*)(F.ws + R_DAO), (const bf16*)(F.ws + WS_DIFF_WOUT), rows_out, 1024, 1024}; pg8::StaticOrder S; S.init(rows_out, 1024, F.G, (int)blockIdx.x);
                pg8::EpiResid E{(bf16*)(F.ws + WS_XB), MOD + (size_t)layer * 9 * 6144 + 2048, rep_ == 0 ? 1.0f : 0.0f}; GEMM_CALL(pg8::EpiResid, pg8::StaticOrder, g, S, E); } PH_END
        } else {
            PH_BEGIN for (int rep_ = 0; rep_ < REPN(13); ++rep_) if (EN(13)) { pg8::Gemm g{H, (const bf16*)(F.ws + WS_SG_WIN), MROWS, 4096, 1024}; pg8::StaticOrder S; S.init(MROWS, 4096, F.G, (int)blockIdx.x);
                pg8::EpiStore<1> E{(bf16*)(F.ws + R_Z), 4096}; GEMM_CALL(pg8::EpiStore<1>, pg8::StaticOrder, g, S, E); } PH_END
            PH_BEGIN for (int rep_ = 0; rep_ < REPN(7); ++rep_) if (EN(7)) sg_ln_phase(F, A); PH_END
            PH_BEGIN for (int rep_ = 0; rep_ < REPN(13); ++rep_) if (EN(13)) { pg8::Gemm g{(const bf16*)(F.ws + WS_SG_WS), (const bf16*)(F.ws + R_VNT), 2048, 0, 128}; pg8::SpatialOrder S; S.init((MROWS / 128) * 8, F.G, F.vcu);
                pg8::EpiSpatial E{(bf16*)(F.ws + R_UV), (const bf16*)(F.ws + R_Z), A[I_SG_BS]}; GEMM_CALL(pg8::EpiSpatial, pg8::SpatialOrder, g, S, E); } PH_END
            PH_BEGIN for (int rep_ = 0; rep_ < REPN(14); ++rep_) if (EN(14)) { pg8::Gemm g{(const bf16*)(F.ws + R_UV), (const bf16*)(F.ws + WS_SG_WOUT), rows_out, 1024, 2048}; pg8::StaticOrder S; S.init(rows_out, 1024, F.G, (int)blockIdx.x);
                pg8::EpiResid E{(bf16*)(F.ws + WS_XB), MOD + (size_t)layer * 9 * 6144 + 2048, rep_ == 0 ? 1.0f : 0.0f}; GEMM_CALL(pg8::EpiResid, pg8::StaticOrder, g, S, E); } PH_END
        }

        PH_BEGIN { for (int rep_ = 0; rep_ < REPN(8); ++rep_) if (EN(8)) { norm_phase<true, false>(F, A, layer, false, rows_out); __syncthreads(); } for (int rep_ = 0; rep_ < REPN(15); ++rep_) if (EN(15) && kind == 2) { moe_weight_items(F, A, layer); __syncthreads(); } } PH_END
        PH_BEGIN for (int rep_ = 0; rep_ < REPN(9); ++rep_) if (EN(9)) topk_phase(F, ctx_out ? 256 : 128); PH_END
        PH_BEGIN for (int rep_ = 0; rep_ < REPN(10); ++rep_) if (EN(10)) { pg8::Gemm g{H, (const bf16*)(F.ws + WS_WGU), MOE_ROWS, 0, 1024}; pg8::MoeOrder S; S.init(ctx_out ? 17 : 16, 8, F.G, F.vcu);
            pg8::EpiSwiGLU E{(bf16*)(F.ws + R_HID), 8}; pg8::gemm_phase<pg8::EpiSwiGLU, pg8::MoeOrder, PG8_ALIGN, PG8_SP2, true>(F.lds, g, S, E, F.tid, (const int*)(F.ws + R_XG), (LAS int*)(F.lds + RING_BYTES)); } PH_END
        PH_BEGIN for (int rep_ = 0; rep_ < REPN(10); ++rep_) if (EN(10)) { pg8::Gemm g{(const bf16*)(F.ws + R_HID), (const bf16*)(F.ws + WS_WDN), MOE_ROWS, 0, 1024}; pg8::MoeOrder S; S.init(ctx_out ? 17 : 16, 4, F.G, F.vcu);
            pg8::EpiMoeDown E{(bf16*)(F.ws + R_YB), (const float*)(F.ws + WS_GATE)}; GEMM_CALL(pg8::EpiMoeDown, pg8::MoeOrder, g, S, E); } PH_END
    }
    PH_BEGIN for (int rep_ = 0; rep_ < REPN(11); ++rep_) if (EN(11)) final_phase(F, DEPTH - 1); PH_END
#undef PH_BEGIN
#undef PH_END
}
constexpr int N_PHASES = 1 + (1 + 5 + 4) + (1 + 5 + 4) + (1 + 4 + 4) + (1 + 5 + 4) + 1;

extern "C" void kernel_launch(void* const* d_in, const int* in_sizes, int n_in, void* d_out, int out_size, void* d_ws, size_t ws_size, hipStream_t stream) {
    static int grid = 0;
    if (grid == 0) {
        if (n_in != 35 || in_sizes[0] != NLAT * D || out_size != NLAT * D || ws_size < WS_END) {
            fprintf(stderr, "kernel_launch: unexpected shapes: n_in %d in0 %d out %d ws %zu (need >= %zu); nothing launched\n", n_in, n_in > 0 ? in_sizes[0] : -1, out_size, ws_size, (size_t)WS_END); grid = -1; return; }
        int dev = 0, cus = 0, per_cu = 0;
        if (hipGetDevice(&dev) != hipSuccess || hipDeviceGetAttribute(&cus, hipDeviceAttributeMultiprocessorCount, dev) != hipSuccess) { fprintf(stderr, "kernel_launch: device query failed\n"); grid = -1; return; }
        if (hipFuncSetAttribute((const void*)fwd_kernel, hipFuncAttributeMaxDynamicSharedMemorySize, LDS_BYTES) != hipSuccess) { fprintf(stderr, "kernel_launch: hipFuncSetAttribute failed\n"); grid = -1; return; }
        if (hipOccupancyMaxActiveBlocksPerMultiprocessor(&per_cu, (const void*)fwd_kernel, NTHREADS, LDS_BYTES) != hipSuccess || per_cu < 1)
            fprintf(stderr, "kernel_launch: note: occupancy query reports %d workgroups per CU\n", per_cu);
        (void)hipGetLastError();
        grid = cus;
    }
    if (grid < 0) return;
    if (hipMemsetAsync((char*)d_ws + WS_CTL, 0, CTL_ZERO_BYTES, stream) != hipSuccess) { fprintf(stderr, "kernel_launch: memset failed\n"); return; }
    Args a{};
    for (int i = 0; i < 35; ++i) a.in[i] = (const float*)d_in[i];
    a.out = (float*)d_out; a.ws = (unsigned char*)d_ws;
#if MK_PER_PHASE
    for (int p = 0; p < N_PHASES; ++p) { a.ph_lo = p; a.ph_hi = p + 1; hipLaunchKernelGGL(fwd_kernel, dim3(grid), dim3(NTHREADS), LDS_BYTES, stream, a); }
#else
    a.ph_lo = 0; a.ph_hi = N_PHASES;
    hipLaunchKernelGGL(fwd_kernel, dim3(grid), dim3(NTHREADS), LDS_BYTES, stream, a);
#endif
    const hipError_t le = hipPeekAtLastError();
    if (le != hipSuccess) fprintf(stderr, "kernel_launch: launch failed: %s\n", hipGetErrorName(le));
}
```

```cpp
#include <type_traits>
#include <hip/hip_runtime.h>
#include <cstdio>
#include <cstdint>

#ifndef MK_PER_PHASE
#define MK_PER_PHASE 0
#endif

constexpr int D = 1024, NB = 8, SEQ = 4096, CTXL = 256, NLAT = NB * SEQ, NCTX = NB * CTXL, MROWS = NLAT + NCTX;
constexpr int NKEYS = CTXL + SEQ;
constexpr int NE = 16, CAP_LAT = 512, CAP_CTX = 32, EROWS = NB * CAP_LAT + NB * CAP_CTX, MOE_ROWS = NE * EROWS;
constexpr int DEPTH = 4;
constexpr float EPS = 1e-6f;
constexpr int NWAVES = 8, NTHREADS = 512;

constexpr size_t MiB = 1u << 20;
constexpr size_t WS_CTL = 0, CTL_ZERO_BYTES = 1 * MiB;
constexpr size_t WS_MOD = 1 * MiB;
constexpr size_t WS_ROPEA = 2 * MiB;
constexpr size_t WS_ROPEB = 2 * MiB + 512 * 1024;
constexpr size_t WS_WNM = 4 * MiB;
constexpr size_t MLA_W_STRIDE = 7 * MiB, MLA_WIN = 0, MLA_WUQ = 2 * MiB, MLA_WUKV = 3 * MiB + 512 * 1024, MLA_WOUT = 4 * MiB + 512 * 1024;
constexpr size_t WS_DIFF_WIN = 18 * MiB, WS_DIFF_WOUT = 24 * MiB;
constexpr size_t WS_SG_WIN = 26 * MiB, WS_SG_WOUT = 34 * MiB, WS_SG_WS = 38 * MiB;
constexpr size_t WS_WGU = 40 * MiB, WS_WDN = 104 * MiB;
constexpr size_t WS_XCTX = 136 * MiB;
constexpr size_t WS_H = 144 * MiB;
constexpr size_t WS_AFF = 212 * MiB;
constexpr size_t WS_SLOT = 215 * MiB;
constexpr size_t WS_GATE = 218 * MiB;
constexpr size_t WS_RQ = 219 * MiB;
constexpr size_t WS_R = 220 * MiB;
constexpr size_t WS_XB = WS_R + 640 * MiB;
constexpr size_t WS_END = WS_XB + 68 * MiB;
constexpr size_t R_DOWN = WS_R, R_CQN = WS_R + 68 * MiB, R_CKVN = WS_R + 102 * MiB, R_QPRE = WS_R + 120 * MiB, R_KVPRE = WS_R + 222 * MiB;
constexpr size_t R_MQ = WS_R + 358 * MiB, R_MQC = WS_R + 454 * MiB, R_MK = WS_R + 460 * MiB, R_MV = WS_R + 562 * MiB, R_AO = WS_R;
constexpr size_t R_QKV = WS_R, R_DQ = WS_R + 204 * MiB, R_DQC = WS_R + 268 * MiB, R_DK = WS_R + 272 * MiB, R_OB = WS_R + 340 * MiB, R_DAO = WS_R + 476 * MiB;
constexpr size_t R_Z = WS_R, R_VNT = WS_R + 272 * MiB, R_UV = WS_R + 408 * MiB;
constexpr size_t R_XG = WS_R, R_HID = WS_R + 136 * MiB, R_YB = WS_R + 272 * MiB;

constexpr int RING_BYTES = 131072;
constexpr int LDS_BYTES = 147456;
constexpr int MISC_OFF = LDS_BYTES - 512;

#define GAS __attribute__((address_space(1)))
#define LAS __attribute__((address_space(3)))
typedef unsigned short bf16;
typedef unsigned v4u __attribute__((ext_vector_type(4)));
typedef unsigned v2u __attribute__((ext_vector_type(2)));
typedef float f32x4 __attribute__((ext_vector_type(4)));
typedef float f32x2 __attribute__((ext_vector_type(2)));
typedef GAS unsigned gu32;
#define RLX_AGENT __ATOMIC_RELAXED, __HIP_MEMORY_SCOPE_AGENT
#define LDS_WAIT() asm volatile("s_waitcnt lgkmcnt(0)" ::: "memory")
#define VM_WAIT() asm volatile("s_waitcnt vmcnt(0)" ::: "memory")
__device__ __forceinline__ unsigned f2bf(float f) { unsigned u = __builtin_bit_cast(unsigned, f); return (u + 0x7fffu + ((u >> 16) & 1u)) >> 16; }
__device__ __forceinline__ unsigned pk2(float lo, float hi) { return f2bf(lo) | (f2bf(hi) << 16); }
__device__ __forceinline__ float bflo(unsigned w) { return __builtin_bit_cast(float, w << 16); }
__device__ __forceinline__ float bfhi(unsigned w) { return __builtin_bit_cast(float, w & 0xffff0000u); }
template <int M> __device__ __forceinline__ float shx(float v) {
    static_assert(M == 1 || M == 2 || M == 4 || M == 8 || M == 16, "shx: xor mask inside a 32-lane group");
    return __builtin_bit_cast(float, __builtin_amdgcn_ds_swizzle(__builtin_bit_cast(int, v), (M << 10) | 0x1f));
}
__device__ __forceinline__ float wave_sum(float v) {
    v += shx<1>(v); v += shx<2>(v); v += shx<4>(v); v += shx<8>(v); v += shx<16>(v);
    const unsigned a = __builtin_bit_cast(unsigned, v);
    const auto rr = __builtin_amdgcn_permlane32_swap(a, a, false, false);
    const unsigned r0 = rr[0], r1 = rr[1];
    return __uint_as_float(r0) + __uint_as_float(r1);
}
__device__ __forceinline__ int hw_lane() { int l; asm volatile("v_mbcnt_lo_u32_b32 %0, -1, 0\n\tv_mbcnt_hi_u32_b32 %0, -1, %0" : "=v"(l)); return l; }
__device__ __forceinline__ float fast_rcp(float x) { return __builtin_amdgcn_rcpf(x); }
__device__ __forceinline__ float silu_f(float x) { return x * fast_rcp(1.0f + __builtin_amdgcn_exp2f(-1.4426950408889634f * x)); }
__device__ __forceinline__ float gelu_tanh_f(float x) { const float u2 = 1.5957691216057308f * (x + 0.044715f * x * x * x); return x * fast_rcp(1.0f + __builtin_amdgcn_exp2f(-1.4426950408889634f * u2)); }

namespace pg8 {
#define PG8_LAS __attribute__((address_space(3)))
typedef unsigned short bf16_t;
typedef short bf16x8 __attribute__((ext_vector_type(8)));
typedef float f32x4 __attribute__((ext_vector_type(4)));
typedef unsigned u32x4 __attribute__((ext_vector_type(4)));
constexpr int BM = 256, BK = 64, HALF = 128, HTB = HALF * BK * 2  , STAGE_BYTES = 8 * HTB, NXCD = 8, WGM = 8;

__host__ __device__ __forceinline__ int lds_byte(int r, int c) { const int st = (r >> 4) * 2 + (c >> 5), rr = r & 15, cc = c & 31, ob = rr * 64 + cc * 2; return st * 1024 + (ob ^ (((ob >> 9) & 1) << 5)); }
__host__ __device__ __forceinline__ void stage_rc(int b, int& R, int& C) { const int st = b / 1024, sb = b % 1024, swz = sb ^ (((sb >> 9) & 1) << 5); R = (st >> 1) * 16 + swz / 64; C = (st & 1) * 32 + (swz % 64) / 2; }
__host__ __device__ __forceinline__ int perm32(int rho) { const int n = rho >> 4, i = rho & 15; return 8 * (i >> 2) + 4 * n + (i & 3); }

struct Unit { int pm, pn; };
struct Gemm { const bf16_t* A; const bf16_t* Bt; int M, N, K; int lda = 0; };

struct StaticOrder {
    int nM, nN, nwg, G, c;
    __host__ __device__ void init(int M, int N, int G_, int c_) { nM = M / BM; nN = N / BM; nwg = nM * nN; G = G_; c = c_; }
    __host__ __device__ bool next(int i, Unit& u) const {
        const long L = (long)i * G + c; if (L >= nwg) return false;
        int wgid = (int)L; { const int q = nwg / NXCD, r = nwg % NXCD, xcd = wgid % NXCD, off = wgid / NXCD; wgid = (xcd < r ? xcd * (q + 1) : r * (q + 1) + (xcd - r) * q) + off; }
        const int nig = WGM * nN, gid = wgid / nig, fm = gid * WGM, gsz = (nM - fm) < WGM ? (nM - fm) : WGM;
        u.pm = fm + ((wgid % nig) % gsz); u.pn = (wgid % nig) / gsz; return true;
    }
    __device__ __forceinline__ void a_ready(const Unit&) const {}
    __device__ __forceinline__ void done(const Unit&) const {}
};

__device__ __forceinline__ unsigned cvt_pk_bf16(float lo, float hi) { unsigned r; asm volatile("v_cvt_pk_bf16_f32 %0, %1, %2" : "=v"(r) : "v"(lo), "v"(hi)); return r; }
typedef float f32x2 __attribute__((ext_vector_type(2)));

template <int ACT> struct EpiStore {
    static constexpr bool PERM = true, AFTER_DRAIN = false;
    bf16_t* O; int ldc;
    __device__ __forceinline__ void operator()(const f32x4 (&acc)[2][2][4][2], const Unit& u, int wr, int wc, int fr, int fq) const {
        const int row0 = u.pm * BM + wr * 64 + fr, col0 = u.pn * BM + wc * 32 + 8 * fq;
#pragma unroll
        for (int ai = 0; ai < 2; ++ai)
#pragma unroll
            for (int m = 0; m < 4; ++m) { bf16_t* rowp = O + (size_t)(row0 + ai * HALF + m * 16) * ldc + col0;
#pragma unroll
                for (int bj = 0; bj < 2; ++bj) { f32x4 v0 = acc[ai][bj][m][0], v1 = acc[ai][bj][m][1];
                    if (ACT == 1) {
#pragma unroll
                        for (int i = 0; i < 4; ++i) { v0[i] = gelu_tanh_f(v0[i]); v1[i] = gelu_tanh_f(v1[i]); } }
                    u32x4 w; w.x = cvt_pk_bf16(v0[0], v0[1]); w.y = cvt_pk_bf16(v0[2], v0[3]); w.z = cvt_pk_bf16(v1[0], v1[1]); w.w = cvt_pk_bf16(v1[2], v1[3]);
                    *(u32x4*)(rowp + bj * HALF) = w; } }
    }
};
struct EpiResid {
    static constexpr bool PERM = true, AFTER_DRAIN = false;
    bf16_t* xb; const float* gmod; float mul;
    __device__ __forceinline__ void operator()(const f32x4 (&acc)[2][2][4][2], const Unit& u, int wr, int wc, int fr, int fq) const {
        const int rr = u.pm < 128 ? (u.pm >> 4) : 8;
        bf16_t* xbase = xb + (size_t)u.pm * BM * 1024;
        const int col0 = u.pn * BM + wc * 32 + 8 * fq;
        f32x4 gv[2][2];
#pragma unroll
        for (int bj = 0; bj < 2; ++bj)
#pragma unroll
            for (int n = 0; n < 2; ++n) gv[bj][n] = *(const f32x4*)(gmod + rr * 6144 + col0 + bj * HALF + 4 * n) * mul;
#pragma unroll
        for (int ai = 0; ai < 2; ++ai)
#pragma unroll
            for (int m = 0; m < 4; ++m) { bf16_t* rowp = xbase + (size_t)(ai * HALF + wr * 64 + m * 16 + fr) * 1024 + col0;
#pragma unroll
                for (int bj = 0; bj < 2; ++bj) { u32x4* p = (u32x4*)(rowp + bj * HALF); const u32x4 w = *p;
                    const f32x4 x0 = (f32x4){__builtin_bit_cast(float, w.x << 16), __builtin_bit_cast(float, w.x & 0xffff0000u), __builtin_bit_cast(float, w.y << 16), __builtin_bit_cast(float, w.y & 0xffff0000u)};
                    const f32x4 x1 = (f32x4){__builtin_bit_cast(float, w.z << 16), __builtin_bit_cast(float, w.z & 0xffff0000u), __builtin_bit_cast(float, w.w << 16), __builtin_bit_cast(float, w.w & 0xffff0000u)};
                    const f32x4 o0 = x0 + gv[bj][0] * acc[ai][bj][m][0], o1 = x1 + gv[bj][1] * acc[ai][bj][m][1];
                    u32x4 r; r.x = cvt_pk_bf16(o0[0], o0[1]); r.y = cvt_pk_bf16(o0[2], o0[3]); r.z = cvt_pk_bf16(o1[0], o1[1]); r.w = cvt_pk_bf16(o1[2], o1[3]); *p = r; } }
    }
};
struct EpiSwiGLU {
    static constexpr bool PERM = true, AFTER_DRAIN = false;
    bf16_t* O; int nct;
    __device__ __forceinline__ void operator()(const f32x4 (&acc)[2][2][4][2], const Unit& u, int wr, int wc, int fr, int fq) const {
        const int row0 = u.pm * BM + wr * 64 + fr, col0 = (u.pn % nct) * HALF + wc * 32 + 8 * fq;
#pragma unroll
        for (int ai = 0; ai < 2; ++ai)
#pragma unroll
            for (int m = 0; m < 4; ++m) { bf16_t* rowp = O + (size_t)(row0 + ai * HALF + m * 16) * 1024 + col0;
                f32x4 v0, v1;
#pragma unroll
                for (int i = 0; i < 4; ++i) { v0[i] = silu_f(acc[ai][0][m][0][i]) * acc[ai][1][m][0][i]; v1[i] = silu_f(acc[ai][0][m][1][i]) * acc[ai][1][m][1][i]; }
                u32x4 w; w.x = cvt_pk_bf16(v0[0], v0[1]); w.y = cvt_pk_bf16(v0[2], v0[3]); w.z = cvt_pk_bf16(v1[0], v1[1]); w.w = cvt_pk_bf16(v1[2], v1[3]);
                *(u32x4*)rowp = w; }
    }
};
struct EpiMoeDown {
    static constexpr bool PERM = true, AFTER_DRAIN = false;
    bf16_t* O; const float* gate;
    __device__ __forceinline__ void operator()(const f32x4 (&acc)[2][2][4][2], const Unit& u, int wr, int wc, int fr, int fq) const {
        const int row0 = u.pm * BM + wr * 64 + fr, col0 = (u.pn & 3) * BM + wc * 32 + 8 * fq;
#pragma unroll
        for (int ai = 0; ai < 2; ++ai)
#pragma unroll
            for (int m = 0; m < 4; ++m) { const int row = row0 + ai * HALF + m * 16; const float gt = gate[row]; bf16_t* rowp = O + (size_t)row * 1024 + col0;
#pragma unroll
                for (int bj = 0; bj < 2; ++bj) { const f32x4 v0 = acc[ai][bj][m][0] * gt, v1 = acc[ai][bj][m][1] * gt;
                    u32x4 w; w.x = cvt_pk_bf16(v0[0], v0[1]); w.y = cvt_pk_bf16(v0[2], v0[3]); w.z = cvt_pk_bf16(v1[0], v1[1]); w.w = cvt_pk_bf16(v1[2], v1[3]);
                    *(u32x4*)(rowp + bj * HALF) = w; } }
    }
};
struct EpiSpatial {
    static constexpr bool PERM = true, AFTER_DRAIN = false;
    bf16_t* UV; const bf16_t* Z; const float* bs;
    __device__ __forceinline__ void operator()(const f32x4 (&acc)[2][2][4][2], const Unit& u, int wr, int wc, int fr, int fq) const {
        const int g = u.pm, chunk = u.pn >> 3;
#pragma unroll
        for (int m = 0; m < 4; ++m) { const int p = wr * 64 + m * 16 + fr; const float b = bs[g * 128 + p]; const size_t tok = (size_t)chunk * 128 + p;
#pragma unroll
            for (int bj = 0; bj < 2; ++bj) { const int ch = g * 256 + bj * HALF + wc * 32 + 8 * fq;
                const u32x4 uw = *(const u32x4*)(Z + tok * 4096 + ch);
                const f32x4 a0 = acc[0][bj][m][0] + b, a1 = acc[0][bj][m][1] + b;
                u32x4 w;
                w.x = cvt_pk_bf16(a0[0] * __builtin_bit_cast(float, uw.x << 16), a0[1] * __builtin_bit_cast(float, uw.x & 0xffff0000u));
                w.y = cvt_pk_bf16(a0[2] * __builtin_bit_cast(float, uw.y << 16), a0[3] * __builtin_bit_cast(float, uw.y & 0xffff0000u));
                w.z = cvt_pk_bf16(a1[0] * __builtin_bit_cast(float, uw.z << 16), a1[1] * __builtin_bit_cast(float, uw.z & 0xffff0000u));
                w.w = cvt_pk_bf16(a1[2] * __builtin_bit_cast(float, uw.w << 16), a1[3] * __builtin_bit_cast(float, uw.w & 0xffff0000u));
                *(u32x4*)(UV + tok * 2048 + ch) = w; } }
    }
};
struct MoeOrder {
    int nrt, nct, nwg, G, c;
    __device__ void init(int nrt_, int nct_, int G_, int c_) { nrt = nrt_; nct = nct_; nwg = 16 * nrt * nct; G = G_; c = c_; }
    __device__ bool next(int i, Unit& u) const {
        const int L = i * G + c; if (L >= nwg) return false;
        const int per = nrt * nct, e = L / per, r = L % per, j = r / nrt, rt = r % nrt;
        u.pm = e * 17 + rt; u.pn = e * nct + j; return true;
    }
    __device__ __forceinline__ void a_ready(const Unit&) const {}
    __device__ __forceinline__ void done(const Unit&) const {}
};
struct SpatialOrder {
    int nwg, G, c;
    __device__ void init(int nblocks, int G_, int c_) { nwg = nblocks; G = G_; c = c_; }
    __device__ bool next(int i, Unit& u) const { const int L = i * G + c; if (L >= nwg) return false; u.pm = L & 7; u.pn = L; return true; }
    __device__ __forceinline__ void a_ready(const Unit&) const {}
    __device__ __forceinline__ void done(const Unit&) const {}
};
template <class Epi, class Sched, bool ALIGN_EPI = false, bool SP2 = false, bool GATHER = false>
__device__ __forceinline__ void gemm_phase(PG8_LAS unsigned char* lds, const Gemm g, const Sched& S, const Epi& E, int tid_in, const int* rowsrc = nullptr, PG8_LAS int* idx_lds = nullptr) {
    int tid_ = tid_in; asm volatile("" : "+v"(tid_));
    const int tid = tid_, wid = __builtin_amdgcn_readfirstlane(tid >> 6), lane = tid & 63, wr = wid >> 2, wc = wid & 3, fr = lane & 15, fq = lane >> 4;
    const int K = g.K, nt = K / BK, LDA = g.lda ? g.lda : g.K;
    unsigned voffA[2], voffB[2];
#pragma unroll
    for (int i = 0; i < 2; ++i) { int R, C; stage_rc(tid * 16 + i * 8192, R, C); const int Rb = Epi::PERM ? ((R & ~31) + perm32(R & 31)) : R;
        voffA[i] = (unsigned)(R * LDA + C) * 2u; voffB[i] = (unsigned)(Rb * K + C) * 2u; }
    const size_t kstep = (size_t)(BK * 2);
    const size_t hstep = (size_t)HALF * K * 2;
    const size_t tstep = 2 * hstep;
    const size_t hstepA = GATHER ? 0 : (size_t)HALF * LDA * 2, tstepA = 2 * hstepA;
    unsigned gA[2][2], gN[2][2], gS[2][2];
    int gR[2], gC[2];
    if constexpr (GATHER) {
#pragma unroll
        for (int i = 0; i < 2; ++i) { int R, C; stage_rc(tid * 16 + i * 8192, R, C); gR[i] = R; gC[i] = C * 2; }
        Unit u_; for (int i = 0; S.next(i, u_); ++i) if (tid < 256) idx_lds[i * 256 + tid] = rowsrc[u_.pm * BM + tid];
        asm volatile("s_waitcnt vmcnt(0) lgkmcnt(0)" ::: "memory"); __builtin_amdgcn_s_barrier(); asm volatile("" ::: "memory");
    }
#define PG8_GOFF(dst, unit_i) do { _Pragma("unroll") for (int h_ = 0; h_ < 2; ++h_) _Pragma("unroll") for (int i_ = 0; i_ < 2; ++i_) \
        dst[h_][i_] = (unsigned)idx_lds[(unit_i) * 256 + h_ * HALF + gR[i_]] * (unsigned)(LDA * 2) + (unsigned)gC[i_]; } while (0)
#define PG8_OA(h) (GATHER ? gA[h] : voffA)
#define PG8_OS(h) (GATHER ? gS[h] : voffA)
    const unsigned ldsw = (unsigned)wid * 1024u;
    const int aoff = lds_byte(wr * 64 + fr, fq * 8), boff = lds_byte(wc * 32 + fr, fq * 8);
#define PG8_SA(b, h) (((b) * 2 + (h)) * HTB)
#define PG8_SB(b, h) ((4 + (b) * 2 + (h)) * HTB)
#define PG8_STAGE(bufoff, gbase, voff) do { _Pragma("unroll") for (int _i = 0; _i < 2; ++_i) \
        __builtin_amdgcn_global_load_lds((const unsigned*)((const char*)(gbase) + (voff)[_i]), (PG8_LAS unsigned*)(lds + (bufoff) + ldsw + _i * 8192), 16, 0, 0); } while (0)
#define PG8_LDA(dst, b, h) do { _Pragma("unroll") for (int m = 0; m < 4; ++m) _Pragma("unroll") for (int k = 0; k < 2; ++k) dst[m][k] = *(const PG8_LAS bf16x8*)(lds + PG8_SA(b, h) + aoff + m * 2048 + k * 1024); } while (0)
#define PG8_LDB(dst, b, h) do { _Pragma("unroll") for (int n = 0; n < 2; ++n) _Pragma("unroll") for (int k = 0; k < 2; ++k) dst[n][k] = *(const PG8_LAS bf16x8*)(lds + PG8_SB(b, h) + boff + n * 2048 + k * 1024); } while (0)
#define PG8_MMA(ai, bj, At, Bt) do { __builtin_amdgcn_s_setprio(1); _Pragma("unroll") for (int m = 0; m < 4; ++m) _Pragma("unroll") for (int n = 0; n < 2; ++n) _Pragma("unroll") for (int k = 0; k < 2; ++k) \
        acc[ai][bj][m][n] = __builtin_amdgcn_mfma_f32_16x16x32_bf16(Bt[n][k], At[m][k], acc[ai][bj][m][n], 0, 0, 0); __builtin_amdgcn_s_setprio(0); } while (0)
#define PG8_WAIT_V(n) asm volatile("s_waitcnt vmcnt(" #n ")" ::: "memory")
#define PG8_WAIT_L(n) asm volatile("s_waitcnt lgkmcnt(" #n ")" ::: "memory")
#define PG8_BAR __builtin_amdgcn_s_barrier()
#define PG8_SCHED __builtin_amdgcn_sched_barrier(0)
    Unit cur, nxt; int ui = 0;
    if (!S.next(0, cur)) return;
    if constexpr (GATHER) { PG8_GOFF(gA, 0); }
    f32x4 acc[2][2][4][2];
#pragma unroll
    for (int a = 0; a < 2; ++a)
#pragma unroll
        for (int b = 0; b < 2; ++b)
#pragma unroll
            for (int m = 0; m < 4; ++m)
#pragma unroll
                for (int n = 0; n < 2; ++n) acc[a][b][m][n] = (f32x4){0.f, 0.f, 0.f, 0.f};
    bf16x8 At[4][2], B0[2][2], B1[2][2];
    const char* cA = (const char*)g.A + (size_t)cur.pm * tstepA; const char* cB = (const char*)g.Bt + (size_t)cur.pn * tstep;
    S.a_ready(cur);
    if constexpr (SP2) {
        PG8_STAGE(PG8_SB(0, 0), cB, voffB); PG8_STAGE(PG8_SB(0, 1), cB + hstep, voffB); PG8_STAGE(PG8_SA(0, 0), cA, PG8_OA(0)); PG8_STAGE(PG8_SA(0, 1), cA + hstepA, PG8_OA(1));
        if (wr == 1) PG8_BAR;
        PG8_WAIT_V(2); PG8_BAR;
        PG8_STAGE(PG8_SB(1, 0), cB + kstep, voffB); PG8_STAGE(PG8_SA(1, 0), cA + kstep, PG8_OA(0)); PG8_STAGE(PG8_SB(1, 1), cB + hstep + kstep, voffB);
        PG8_WAIT_V(6); PG8_BAR;
    } else {
        PG8_STAGE(PG8_SB(0, 0), cB, voffB); PG8_STAGE(PG8_SA(0, 0), cA, PG8_OA(0)); PG8_STAGE(PG8_SB(0, 1), cB + hstep, voffB); PG8_STAGE(PG8_SA(0, 1), cA + hstepA, PG8_OA(1));
        if (wr == 1) PG8_BAR;
        PG8_WAIT_V(4); PG8_BAR;
        PG8_STAGE(PG8_SB(1, 0), cB + kstep, voffB); PG8_STAGE(PG8_SA(1, 0), cA + kstep, PG8_OA(0)); PG8_STAGE(PG8_SB(1, 1), cB + hstep + kstep, voffB);
        PG8_WAIT_V(6); PG8_BAR;
    }
    for (;;) {
        const bool has_next = S.next(ui + 1, nxt);
        if constexpr (GATHER) { if (has_next) { PG8_GOFF(gN, ui + 1); } else {
#pragma unroll
            for (int h_ = 0; h_ < 2; ++h_) { gN[h_][0] = gA[h_][0]; gN[h_][1] = gA[h_][1]; } } }
        const char* nA = has_next ? (const char*)g.A + (size_t)nxt.pm * tstepA : cA; const char* nB = has_next ? (const char*)g.Bt + (size_t)nxt.pn * tstep : cB;
        for (int t = 0; t < nt; t += 2) {
            const bool last = (t == nt - 2);
            if constexpr (GATHER) {
#pragma unroll
                for (int h_ = 0; h_ < 2; ++h_) { gS[h_][0] = last ? gN[h_][0] : gA[h_][0]; gS[h_][1] = last ? gN[h_][1] : gA[h_][1]; } }
            const char* a1 = cA + (size_t)(t + 1) * kstep;
            const char* a2 = last ? nA : cA + (size_t)(t + 2) * kstep; const char* b2 = last ? nB : cB + (size_t)(t + 2) * kstep;
            const char* a3 = a2 + kstep; const char* b3 = b2 + kstep;
            if (last && has_next) S.a_ready(nxt);
            if constexpr (SP2) {
            PG8_LDB(B0, 0, 0); PG8_LDB(B1, 0, 1); PG8_SCHED; PG8_LDA(At, 0, 0); PG8_STAGE(PG8_SA(1, 1), a1 + hstepA, PG8_OA(1));
            PG8_WAIT_V(8); PG8_WAIT_L(0); PG8_BAR; PG8_MMA(0, 0, At, B0); PG8_MMA(0, 1, At, B1); PG8_BAR; PG8_SCHED;
            PG8_LDA(At, 0, 1); PG8_STAGE(PG8_SB(0, 0), b2, voffB); PG8_STAGE(PG8_SB(0, 1), b2 + hstep, voffB); PG8_STAGE(PG8_SA(0, 0), a2, PG8_OS(0));
            PG8_WAIT_V(8); PG8_WAIT_L(0); PG8_BAR; PG8_MMA(1, 0, At, B0); PG8_MMA(1, 1, At, B1); PG8_BAR; PG8_SCHED;
            PG8_LDB(B0, 1, 0); PG8_LDB(B1, 1, 1); PG8_SCHED; PG8_LDA(At, 1, 0); PG8_STAGE(PG8_SA(0, 1), a2 + hstepA, PG8_OS(1));
            PG8_WAIT_V(8); PG8_WAIT_L(0); PG8_BAR; PG8_MMA(0, 0, At, B0); PG8_MMA(0, 1, At, B1); PG8_BAR; PG8_SCHED;
            PG8_LDA(At, 1, 1); PG8_STAGE(PG8_SB(1, 0), b3, voffB); PG8_STAGE(PG8_SB(1, 1), b3 + hstep, voffB); PG8_STAGE(PG8_SA(1, 0), a3, PG8_OS(0));
            PG8_WAIT_V(8); PG8_WAIT_L(0); PG8_BAR; PG8_MMA(1, 0, At, B0); PG8_MMA(1, 1, At, B1); PG8_BAR; PG8_SCHED;
            } else {
            PG8_LDB(B0, 0, 0); PG8_SCHED; PG8_LDA(At, 0, 0); PG8_STAGE(PG8_SA(1, 1), a1 + hstepA, PG8_OA(1));
            PG8_WAIT_L(8); PG8_BAR; PG8_WAIT_L(0); PG8_MMA(0, 0, At, B0); PG8_BAR; PG8_SCHED;
            PG8_LDB(B1, 0, 1); PG8_STAGE(PG8_SB(0, 0), b2, voffB);
            PG8_BAR; PG8_WAIT_L(0); PG8_MMA(0, 1, At, B1); PG8_BAR;
            PG8_LDA(At, 0, 1); PG8_STAGE(PG8_SA(0, 0), a2, PG8_OS(0));
            PG8_BAR; PG8_WAIT_L(0); PG8_MMA(1, 0, At, B0); PG8_BAR; PG8_SCHED;
            PG8_STAGE(PG8_SB(0, 1), b2 + hstep, voffB);
            PG8_WAIT_V(6); PG8_BAR; PG8_MMA(1, 1, At, B1); PG8_BAR;
            PG8_LDB(B0, 1, 0); PG8_SCHED; PG8_LDA(At, 1, 0); PG8_STAGE(PG8_SA(0, 1), a2 + hstepA, PG8_OS(1));
            PG8_WAIT_L(8); PG8_BAR; PG8_WAIT_L(0); PG8_MMA(0, 0, At, B0); PG8_BAR; PG8_SCHED;
            PG8_LDB(B1, 1, 1); PG8_STAGE(PG8_SB(1, 0), b3, voffB);
            PG8_BAR; PG8_WAIT_L(0); PG8_MMA(0, 1, At, B1); PG8_BAR;
            PG8_LDA(At, 1, 1); PG8_STAGE(PG8_SA(1, 0), a3, PG8_OS(0));
            PG8_BAR; PG8_WAIT_L(0); PG8_MMA(1, 0, At, B0); PG8_BAR; PG8_SCHED;
            PG8_STAGE(PG8_SB(1, 1), b3 + hstep, voffB);
            PG8_WAIT_V(6); PG8_BAR; PG8_MMA(1, 1, At, B1); PG8_BAR;
            }
        }
        if constexpr (ALIGN_EPI) { if (wr == 0) PG8_BAR; }
        if constexpr (!Epi::AFTER_DRAIN) { E(acc, cur, wr, wc, fr, fq); S.done(cur); }
        if (!has_next) break;
#pragma unroll
        for (int a = 0; a < 2; ++a)
#pragma unroll
            for (int b = 0; b < 2; ++b)
#pragma unroll
                for (int m = 0; m < 4; ++m)
#pragma unroll
                    for (int n = 0; n < 2; ++n) acc[a][b][m][n] = (f32x4){0.f, 0.f, 0.f, 0.f};
        cur = nxt; cA = nA; cB = nB; ++ui;
        if constexpr (GATHER) {
#pragma unroll
            for (int h_ = 0; h_ < 2; ++h_) { gA[h_][0] = gN[h_][0]; gA[h_][1] = gN[h_][1]; } }
        if constexpr (ALIGN_EPI) { if (wr == 1) PG8_BAR; }
    }
    PG8_WAIT_V(0);
    if constexpr (!ALIGN_EPI) { if (wr == 0) PG8_BAR; }
    PG8_BAR;
    if constexpr (Epi::AFTER_DRAIN) { E.fused(acc, cur, wr, wc, fr, fq, lds, wid, lane); S.done(cur); }
#undef PG8_SA
#undef PG8_GOFF
#undef PG8_OA
#undef PG8_OS
#undef PG8_SB
#undef PG8_STAGE
#undef PG8_LDA
#undef PG8_LDB
#undef PG8_MMA
#undef PG8_WAIT_V
#undef PG8_WAIT_L
#undef PG8_BAR
#undef PG8_SCHED
}
}

namespace att {
using bf16x8 = __attribute__((ext_vector_type(8))) short;
using s16x4  = __attribute__((ext_vector_type(4))) short;
using f32x16 = __attribute__((ext_vector_type(16))) float;
using u32x4  = __attribute__((ext_vector_type(4))) unsigned;
constexpr int NW = 8, QBLK = 32, KVBLK = 64, KROWB = 256;
constexpr float THR = 8.f;
#define ATT_KSWZ(row, colB) ((row) * 256 + ((colB) ^ (((row) & 7) << 4)))
#define ATT_SBAR() __builtin_amdgcn_sched_barrier(0)
__device__ __forceinline__ int crow(int r, int hi) { return (r & 3) + 8 * (r >> 2) + 4 * hi; }
__device__ __forceinline__ unsigned cvtpk(float lo, float hi) { unsigned r; asm volatile("v_cvt_pk_bf16_f32 %0, %1, %2" : "=v"(r) : "v"(lo), "v"(hi)); return r; }
template <int DK> struct Sc { static constexpr float SCALE = (DK == 96) ? 0.10206207261596575f : 0.125f; static constexpr float C = SCALE * 1.4426950408889634f; };

template <int DK, bool OFF>
__device__ __forceinline__ void partialSM(f32x16& p0, f32x16& p1, float negMC) {
  if constexpr (OFF) {
#pragma unroll
    for (int r = 0; r < 16; ++r) p0[r] += negMC;
#pragma unroll
    for (int r = 0; r < 16; ++r) p1[r] += negMC;
  }
#pragma unroll
  for (int r = 0; r < 16; ++r) p0[r] = __builtin_amdgcn_exp2f(p0[r]);
}
__device__ __forceinline__ void finishSM(f32x16& p0, f32x16& p1, float& l_reg, bf16x8& pa0, bf16x8& pa1, bf16x8& pa2, bf16x8& pa3) {
#pragma unroll
  for (int r = 0; r < 16; ++r) p1[r] = __builtin_amdgcn_exp2f(p1[r]);
  float ps = 0;
#pragma unroll
  for (int r = 0; r < 16; ++r) ps += p0[r];
#pragma unroll
  for (int r = 0; r < 16; ++r) ps += p1[r];
  l_reg += ps;
#define ATT_PK4(P, BASE, OUT) do { unsigned a0 = cvtpk(P[BASE + 0], P[BASE + 1]), a1 = cvtpk(P[BASE + 2], P[BASE + 3]);   \
    unsigned b0 = cvtpk(P[BASE + 4], P[BASE + 5]), b1 = cvtpk(P[BASE + 6], P[BASE + 7]);                              \
    auto r0 = __builtin_amdgcn_permlane32_swap(a0, b0, false, false); auto r1 = __builtin_amdgcn_permlane32_swap(a1, b1, false, false); \
    u32x4 w = {r0[0], r1[0], r0[1], r1[1]}; OUT = *reinterpret_cast<bf16x8*>(&w); } while (0)
  ATT_PK4(p0, 0, pa0); ATT_PK4(p0, 8, pa1); ATT_PK4(p1, 0, pa2); ATT_PK4(p1, 8, pa3);
#undef ATT_PK4
}
template <int DK>
__device__ __forceinline__ void qkt(f32x16& p0, f32x16& p1, const char* Ks, const bf16x8* qr, int r32, int hi) {
  p0 = f32x16{}; p1 = f32x16{};
#pragma unroll
  for (int d0 = 0; d0 < DK / 16; ++d0) { const int cb = (d0 * 16 + hi * 8) * 2;
    const bf16x8 b0 = *reinterpret_cast<const bf16x8*>(Ks + ATT_KSWZ(r32, cb));
    const bf16x8 b1 = *reinterpret_cast<const bf16x8*>(Ks + ATT_KSWZ(32 + r32, cb));
    p0 = __builtin_amdgcn_mfma_f32_32x32x16_bf16(b0, qr[d0], p0, 0, 0, 0);
    p1 = __builtin_amdgcn_mfma_f32_32x32x16_bf16(b1, qr[d0], p1, 0, 0, 0);
  }
}
template <int DV> __device__ __forceinline__ int v_st(int k, int c) { const int kk = (k & ~0xC) | ((k & 4) << 1) | ((k & 8) >> 1); return ((kk >> 3) * (DV / 32) + (c >> 5)) * 512 + ((kk & 7) * 32 + (c & 31)) * 2; }
__device__ __forceinline__ int v_rd_base(int lane) { return ((lane & 3) << 3) | (((lane >> 2) & 3) << 6) | (((lane >> 4) & 1) << 5) | (((lane >> 5) & 1) << 8); }
template <int DV> constexpr int v_rd_off(int d0, int ks, int half) { return d0 * 512 + ks * (2 * (DV / 32) * 512) + half * ((DV / 32) * 512); }
template <int OFF> __device__ __forceinline__ s16x4 tr_read(int vb) {
  s16x4 r; asm volatile("ds_read_b64_tr_b16 %0, %1 offset:%2" : "=&v"(r) : "v"(vb), "i"(OFF) : "memory"); return r;
}
template <int DV, int D0> __device__ __forceinline__ void pv_one(f32x16& od, int vb, bf16x8 pa0, bf16x8 pa1, bf16x8 pa2, bf16x8 pa3) {
  const s16x4 l0 = tr_read<v_rd_off<DV>(D0, 0, 0)>(vb), h0 = tr_read<v_rd_off<DV>(D0, 0, 1)>(vb), l1 = tr_read<v_rd_off<DV>(D0, 1, 0)>(vb), h1 = tr_read<v_rd_off<DV>(D0, 1, 1)>(vb);
  const s16x4 l2 = tr_read<v_rd_off<DV>(D0, 2, 0)>(vb), h2 = tr_read<v_rd_off<DV>(D0, 2, 1)>(vb), l3 = tr_read<v_rd_off<DV>(D0, 3, 0)>(vb), h3 = tr_read<v_rd_off<DV>(D0, 3, 1)>(vb);
  asm volatile("s_waitcnt lgkmcnt(0)" ::: "memory"); ATT_SBAR();
#define ATT_PK(L, H) (bf16x8){L[0], L[1], L[2], L[3], H[0], H[1], H[2], H[3]}
  od = __builtin_amdgcn_mfma_f32_32x32x16_bf16(pa0, ATT_PK(l0, h0), od, 0, 0, 0);
  od = __builtin_amdgcn_mfma_f32_32x32x16_bf16(pa1, ATT_PK(l1, h1), od, 0, 0, 0);
  od = __builtin_amdgcn_mfma_f32_32x32x16_bf16(pa2, ATT_PK(l2, h2), od, 0, 0, 0);
  od = __builtin_amdgcn_mfma_f32_32x32x16_bf16(pa3, ATT_PK(l3, h3), od, 0, 0, 0);
#undef ATT_PK
}
template <int DV> __device__ __forceinline__ void pv_all(f32x16* o, int vb, bf16x8 pa0, bf16x8 pa1, bf16x8 pa2, bf16x8 pa3) {
  pv_one<DV, 0>(o[0], vb, pa0, pa1, pa2, pa3); pv_one<DV, 1>(o[1], vb, pa0, pa1, pa2, pa3);
  if constexpr (DV == 128) { pv_one<DV, 2>(o[2], vb, pa0, pa1, pa2, pa3); pv_one<DV, 3>(o[3], vb, pa0, pa1, pa2, pa3); }
}
__device__ __forceinline__ float half_pair_sum(float v) { const unsigned a = __float_as_uint(v); auto rr = __builtin_amdgcn_permlane32_swap(a, a, false, false); const unsigned r0 = rr[0], r1 = rr[1]; return __uint_as_float(r0) + __uint_as_float(r1); }
__device__ __forceinline__ void unpack_bf8(const bf16x8 w, float* f) {
#pragma unroll
  for (int i = 0; i < 8; ++i) f[i] = __uint_as_float((unsigned)(unsigned short)w[i] << 16); }
__device__ __forceinline__ bf16x8 pack_bf8(const float* f) { u32x4 w = {cvtpk(f[0], f[1]), cvtpk(f[2], f[3]), cvtpk(f[4], f[5]), cvtpk(f[6], f[7])}; return *reinterpret_cast<bf16x8*>(&w); }
struct QLoadMLA {
  const bf16* qpre;
  const float* rq;
  const float* gq;
  const float* cosA;
  __device__ __forceinline__ void load(bf16x8 (&qr)[6], int r, int hi) const {
    const bf16* src = qpre + (long)r * 1536 + hi * 8; float v[6][8]; float ss = 0.f;
#pragma unroll
    for (int d0 = 0; d0 < 6; ++d0) { unpack_bf8(*reinterpret_cast<const bf16x8*>(src + d0 * 16), v[d0]);
#pragma unroll
      for (int j = 0; j < 8; ++j) ss += v[d0][j] * v[d0][j]; }
    ss = half_pair_sum(ss);
    const float rqv = rq[r], f = Sc<96>::C * rqv / sqrtf(rqv * rqv * ss * (1.0f / 96.0f) + EPS);
#pragma unroll
    for (int d0 = 0; d0 < 6; ++d0) { const f32x4 g0 = *(const f32x4*)(gq + d0 * 16 + hi * 8), g1 = *(const f32x4*)(gq + d0 * 16 + hi * 8 + 4);
#pragma unroll
      for (int j = 0; j < 4; ++j) { v[d0][j] *= f * g0[j]; v[d0][4 + j] *= f * g1[j]; } }
    if (cosA) { const float* c = cosA + (long)r * 16 + hi * 8; const float* sn = c + 4096 * 16;
#pragma unroll
      for (int j = 0; j < 8; ++j) { const float x1 = v[4][j], x2 = v[5][j], cs = c[j], si = sn[j]; v[4][j] = x1 * cs - x2 * si; v[5][j] = x1 * si + x2 * cs; } }
#pragma unroll
    for (int d0 = 0; d0 < 6; ++d0) qr[d0] = pack_bf8(v[d0]);
  }
};
struct QLoadPlain {
  const bf16* q; int ldq;
  template <int NQ> __device__ __forceinline__ void load(bf16x8 (&qr)[NQ], int r, int hi) const {
    const bf16* src = q + (long)r * ldq + hi * 8;
#pragma unroll
    for (int d0 = 0; d0 < NQ; ++d0) qr[d0] = *reinterpret_cast<const bf16x8*>(src + d0 * 16);
  }
};
template <int DK, int DV> struct Geo {
  static constexpr int SHM_V = KVBLK * DV * 2, SHM_K = KVBLK * KROWB, SHM = 2 * SHM_V + 2 * SHM_K + NW * 64 * 4;
  static constexpr int KCPR = DK / 8, VCPR = DV / 8;
  static constexpr int NKC = KVBLK * KCPR, NVC = KVBLK * VCPR;
  static constexpr int KN = (NKC + 511) / 512, VN = NVC / 512;
  static_assert(NVC % 512 == 0 && SHM <= 131072, "attention geometry");
};

template <int DK, int DV, int SD, bool OFF, class QLoader>
__device__ __forceinline__ void body(const QLoader& QL, const bf16* __restrict__ K0, const bf16* __restrict__ K1, int ldk,
                                     const bf16* __restrict__ V0, const bf16* __restrict__ V1, int ldv, bf16* __restrict__ Ob, int ldo, int nkeys, float negMC, char* lds, int tid_in) {
  using G = Geo<DK, DV>;
  constexpr int SHM_V = G::SHM_V, SHM_K = G::SHM_K, KN = G::KN, VN = G::VN, ND = DV / 32;
  int tid_ = tid_in; asm volatile("" : "+v"(tid_));
  const int tid = tid_, wid = tid >> 6, lane = tid & 63, r32 = lane & 31, hi = lane >> 5;
  char* V_lds = lds; char* K_lds = lds + 2 * SHM_V;
  float* ws = (float*)(lds + 2 * SHM_V + 2 * SHM_K) + wid * 64; float* li_l = ws;
  float l_reg = 0; f32x16 o[ND];
#pragma unroll
  for (int d = 0; d < ND; ++d) o[d] = f32x16{};
  bf16x8 qr[DK / 16];
  QL.load(qr, wid * QBLK + r32, hi);
  int kofs[KN], kdst[KN], vofs[VN], vdst[VN];
#pragma unroll
  for (int i = 0; i < KN; ++i) { const int c = tid + 512 * i, row = (c / G::KCPR) & 63, col = (c % G::KCPR) * 8; kofs[i] = (row * ldk + col) * 2; kdst[i] = ATT_KSWZ(row, col * 2); }
#pragma unroll
  for (int i = 0; i < VN; ++i) { const int c = tid + 512 * i, row = c / G::VCPR, col = (c % G::VCPR) * 8; vofs[i] = (row * ldv + col) * 2; vdst[i] = v_st<DV>(row, col); }
  const bool k_last_ok = (tid + 512 * (KN - 1)) < G::NKC;
  const int vb0 = (int)(uintptr_t)V_lds + v_rd_base(lane);
  struct Slot { bf16x8 k[KN], v[VN]; } sr_[SD];
#define ATT_TBASE(k0, ld, P0, P1) (((k0) < 256) ? ((P0) + (long)(k0) * (ld)) : ((P1) + (long)((k0) - 256) * (ld)))
#define ATT_LD(base, ofs) (*reinterpret_cast<const bf16x8*>((const char*)(base) + (unsigned)(ofs)))
#define ATT_SLOAD(i, k0) do { const bf16* vb_ = ATT_TBASE(k0, ldv, V0, V1); const bf16* kb_ = ATT_TBASE(k0, ldk, K0, K1); \
    _Pragma("unroll") for (int _s = 0; _s < VN; ++_s) sr_[i].v[_s] = ATT_LD(vb_, vofs[_s]); \
    _Pragma("unroll") for (int _s = 0; _s < KN; ++_s) if (_s < KN - 1 || k_last_ok) sr_[i].k[_s] = ATT_LD(kb_, kofs[_s]); } while (0)
#define ATT_SWRITE(b, i) do { \
    _Pragma("unroll") for (int _s = 0; _s < VN; ++_s) *reinterpret_cast<bf16x8*>(V_lds + (b) * SHM_V + vdst[_s]) = sr_[i].v[_s]; \
    _Pragma("unroll") for (int _s = 0; _s < KN; ++_s) if (_s < KN - 1 || k_last_ok) *reinterpret_cast<bf16x8*>(K_lds + (b) * SHM_K + kdst[_s]) = sr_[i].k[_s]; } while (0)
#define ATT_SWAIT() asm volatile("s_waitcnt vmcnt(%0)" :: "n"(SD == 2 ? KN + VN : 0) : "memory")
  f32x16 pA0, pA1, pB0, pB1; bf16x8 pa0, pa1, pa2, pa3; const int NT = nkeys / KVBLK;
  constexpr int SE = 0, SO = SD - 1;
  ATT_SLOAD(SE, 0); asm volatile("s_waitcnt vmcnt(0)" ::: "memory"); ATT_SWRITE(0, SE); __syncthreads();
  qkt<DK>(pA0, pA1, K_lds, qr, r32, hi); partialSM<DK, OFF>(pA0, pA1, negMC);
  ATT_SLOAD(SO, KVBLK); if constexpr (SD == 2) { if (2 < NT) ATT_SLOAD(SE, 2 * KVBLK); }
  ATT_SWAIT(); ATT_SWRITE(1, SO); __syncthreads();
  for (int j = 1; j + 1 < NT; j += 2) {
    ATT_SBAR(); qkt<DK>(pB0, pB1, K_lds + SHM_K, qr, r32, hi);
    finishSM(pA0, pA1, l_reg, pa0, pa1, pa2, pa3); ATT_SBAR();
    ATT_SLOAD(SO, (j + SD) * KVBLK); ATT_SBAR();
    pv_all<DV>(o, vb0, pa0, pa1, pa2, pa3); partialSM<DK, OFF>(pB0, pB1, negMC);
    __syncthreads(); ATT_SWAIT(); ATT_SWRITE(0, SE);
    __syncthreads();
    ATT_SBAR(); qkt<DK>(pA0, pA1, K_lds, qr, r32, hi);
    finishSM(pB0, pB1, l_reg, pa0, pa1, pa2, pa3); ATT_SBAR();
    if (SD == 1 || j + 3 < NT) ATT_SLOAD(SE, (j + 1 + SD) * KVBLK); ATT_SBAR();
    pv_all<DV>(o, vb0 + SHM_V, pa0, pa1, pa2, pa3); partialSM<DK, OFF>(pA0, pA1, negMC);
    __syncthreads(); ATT_SWAIT(); ATT_SWRITE(1, SO);
    __syncthreads();
  }
  ATT_SBAR(); qkt<DK>(pB0, pB1, K_lds + SHM_K, qr, r32, hi);
  finishSM(pA0, pA1, l_reg, pa0, pa1, pa2, pa3); ATT_SBAR();
  pv_all<DV>(o, vb0, pa0, pa1, pa2, pa3); partialSM<DK, OFF>(pB0, pB1, negMC);
  __syncthreads();
  finishSM(pB0, pB1, l_reg, pa0, pa1, pa2, pa3); ATT_SBAR();
  pv_all<DV>(o, vb0 + SHM_V, pa0, pa1, pa2, pa3);
  { auto rr = __builtin_amdgcn_permlane32_swap(__float_as_uint(l_reg), __float_as_uint(l_reg), false, false);
    l_reg = __uint_as_float(rr[0]) + __uint_as_float(rr[1]); }
  if (hi == 0) li_l[r32] = l_reg; asm volatile("s_waitcnt lgkmcnt(0)" ::: "memory");
  float rli[16];
#pragma unroll
  for (int r = 0; r < 16; ++r) rli[r] = __builtin_amdgcn_rcpf(li_l[crow(r, hi)]);
  bf16* Ow = Ob + (long)(wid * QBLK) * ldo;
#pragma unroll
  for (int r = 0; r < 16; ++r) { const int orow = crow(r, hi);
#pragma unroll
    for (int d0 = 0; d0 < ND; ++d0) Ow[(long)orow * ldo + d0 * 32 + r32] = (bf16)f2bf(o[d0][r] * rli[r]); }
  __syncthreads();
#undef ATT_TBASE
#undef ATT_LD
#undef ATT_SLOAD
#undef ATT_SWRITE
#undef ATT_SWAIT
}
template <int I, int N, class F> __device__ __forceinline__ void sfor(F&& f) { if constexpr (I < N) { f(std::integral_constant<int, I>{}); sfor<I + 1, N>(f); } }
template <int N> __device__ __forceinline__ void lgkm_wait8(s16x4* v) { asm volatile("s_waitcnt lgkmcnt(%8)" : "+v"(v[0]), "+v"(v[1]), "+v"(v[2]), "+v"(v[3]), "+v"(v[4]), "+v"(v[5]), "+v"(v[6]), "+v"(v[7]) : "n"(N) : "memory"); }
template <int DV, int GRP> __device__ __forceinline__ void v_group_read(s16x4* vf, int vb) {
  sfor<0, 8>([&](auto ic) { constexpr int j = decltype(ic)::value; vf[j] = tr_read<v_rd_off<DV>(GRP, j / 2, j % 2)>(vb); });
}
__device__ __forceinline__ void pv_group(f32x16& od, const s16x4* vf, bf16x8 pa0, bf16x8 pa1, bf16x8 pa2, bf16x8 pa3) {
#define ATT_PK(L, H) (bf16x8){L[0], L[1], L[2], L[3], H[0], H[1], H[2], H[3]}
  od = __builtin_amdgcn_mfma_f32_32x32x16_bf16(pa0, ATT_PK(vf[0], vf[1]), od, 0, 0, 0);
  od = __builtin_amdgcn_mfma_f32_32x32x16_bf16(pa1, ATT_PK(vf[2], vf[3]), od, 0, 0, 0);
  od = __builtin_amdgcn_mfma_f32_32x32x16_bf16(pa2, ATT_PK(vf[4], vf[5]), od, 0, 0, 0);
  od = __builtin_amdgcn_mfma_f32_32x32x16_bf16(pa3, ATT_PK(vf[6], vf[7]), od, 0, 0, 0);
#undef ATT_PK
}
template <int DV> __device__ __forceinline__ void pv_all_pipe(f32x16* o, int vb, bf16x8 pa0, bf16x8 pa1, bf16x8 pa2, bf16x8 pa3) {
  s16x4 va[8], vc[8];
  v_group_read<DV, 0>(va, vb); v_group_read<DV, 1>(vc, vb);
  lgkm_wait8<8>(va); pv_group(o[0], va, pa0, pa1, pa2, pa3);
  if constexpr (DV == 128) {
    s16x4 vd[8], ve[8];
    v_group_read<DV, 2>(vd, vb);
    lgkm_wait8<8>(vc); pv_group(o[1], vc, pa0, pa1, pa2, pa3);
    v_group_read<DV, 3>(ve, vb);
    lgkm_wait8<8>(vd); pv_group(o[2], vd, pa0, pa1, pa2, pa3);
    lgkm_wait8<0>(ve); pv_group(o[3], ve, pa0, pa1, pa2, pa3);
  } else { lgkm_wait8<0>(vc); pv_group(o[1], vc, pa0, pa1, pa2, pa3); }
}

template <int DK, int DV, bool OFF, class QLoader>
__device__ __forceinline__ void body_dma(const QLoader& QL, const bf16* __restrict__ K0, const bf16* __restrict__ K1, int ldk,
                                         const bf16* __restrict__ V0, const bf16* __restrict__ V1, int ldv, bf16* __restrict__ Ob, int ldo, int nkeys, float negMC, char* lds, int tid_in) {
  using G = Geo<DK, DV>;
  constexpr int SHM_V = G::SHM_V, SHM_K = G::SHM_K, ND = DV / 32, NSL = 4;
  constexpr int KPW = (SHM_K / 1024) / NW, VPW = (SHM_V / 1024) / NW, NPW = KPW + VPW;
  static_assert(KPW == 2 && (VPW == 1 || VPW == 2) && NSL * (SHM_V + SHM_K) + NW * 256 <= 135168, "DMA geometry");
  int tid_ = tid_in; asm volatile("" : "+v"(tid_));
  const int tid = tid_, wid = __builtin_amdgcn_readfirstlane(tid >> 6), lane = tid & 63, r32 = lane & 31, hi = lane >> 5;
  char* V_lds = lds; char* K_lds = lds + NSL * SHM_V;
  float* ws = (float*)(lds + NSL * (SHM_V + SHM_K)) + wid * 64; float* li_l = ws;
  float l_reg = 0; f32x16 o[ND];
#pragma unroll
  for (int d = 0; d < ND; ++d) o[d] = f32x16{};
  bf16x8 qr[DK / 16];
  QL.load(qr, wid * QBLK + r32, hi);
  asm volatile("s_waitcnt vmcnt(0)" ::: "memory");
  unsigned koff[KPW], voff[VPW];
#pragma unroll
  for (int i = 0; i < (DK == 64 ? 1 : KPW); ++i) { const int row = (wid * KPW + i) * 4 + (lane >> 4); int c = (lane & 15) ^ (row & 7); c = (c < DK / 8) ? c : (c & 7); koff[i] = (unsigned)((row * ldk) * 2 + c * 16); }
#pragma unroll
  for (int i = 0; i < 1; ++i) { const int sidx = (wid * VPW + i) * 2 + (lane >> 5), kg = sidx / ND, st = sidx % ND, kk = kg * 8 + ((lane & 31) >> 2);
    const int k = (kk & ~0xC) | ((kk & 4) << 1) | ((kk & 8) >> 1), c = st * 32 + (lane & 3) * 8; voff[i] = (unsigned)((k * ldv + c) * 2); }
  const int vb0 = (int)(uintptr_t)V_lds + v_rd_base(lane);
  LAS unsigned* const ldsK = (LAS unsigned*)(LAS char*)K_lds + (wid * KPW) * 256; LAS unsigned* const ldsV = (LAS unsigned*)(LAS char*)V_lds + (wid * VPW) * 256;
#define ATT_TBASE(k0, ld, P0, P1) (((k0) < 256) ? ((P0) + (long)(k0) * (ld)) : ((P1) + (long)((k0) - 256) * (ld)))
#define DMA_TILE(t, slot) do { const int k0_ = (t) * KVBLK; const char* kb_ = (const char*)ATT_TBASE(k0_, ldk, K0, K1); const char* vb_ = (const char*)ATT_TBASE(k0_, ldv, V0, V1); \
    __builtin_amdgcn_global_load_lds((const unsigned*)(kb_ + koff[0]), ldsK + (slot) * (SHM_K / 4), 16, 0, 0); \
    if constexpr (DK == 64) __builtin_amdgcn_global_load_lds((const unsigned*)(kb_ + 4 * 64 * 2 + (koff[0] ^ 64u)), ldsK + (slot) * (SHM_K / 4) + 256, 16, 0, 0);     \
    else __builtin_amdgcn_global_load_lds((const unsigned*)(kb_ + koff[1]), ldsK + (slot) * (SHM_K / 4) + 256, 16, 0, 0); \
    __builtin_amdgcn_global_load_lds((const unsigned*)(vb_ + voff[0]), ldsV + (slot) * (SHM_V / 4), 16, 0, 0); \
    if constexpr (VPW == 2) __builtin_amdgcn_global_load_lds((const unsigned*)(vb_ + 128 + voff[0]), ldsV + (slot) * (SHM_V / 4) + 256, 16, 0, 0);     } while (0)
#define DMA_WAIT(last) do { if (last) asm volatile("s_waitcnt vmcnt(0)" ::: "memory"); else asm volatile("s_waitcnt vmcnt(%0)" :: "n"(NPW) : "memory"); } while (0)
  f32x16 pA0, pA1, pB0, pB1; bf16x8 pa0, pa1, pa2, pa3; const int NT = nkeys / KVBLK;
  DMA_TILE(0, 0); DMA_TILE(1, 1); DMA_WAIT(false); __syncthreads(); if (2 < NT) DMA_TILE(2, 2);
  qkt<DK>(pA0, pA1, K_lds, qr, r32, hi); partialSM<DK, OFF>(pA0, pA1, negMC);
#define DMA_ITER(j, PN0, PN1, PO0, PO1, KS, VS, DS) do { \
    DMA_WAIT((j) + 1 >= NT); __syncthreads(); if ((j) + 2 < NT) DMA_TILE((j) + 2, DS); \
    qkt<DK>(PN0, PN1, K_lds + (KS) * SHM_K, qr, r32, hi); \
    finishSM(PO0, PO1, l_reg, pa0, pa1, pa2, pa3); \
    pv_all_pipe<DV>(o, vb0 + (VS) * SHM_V, pa0, pa1, pa2, pa3); partialSM<DK, OFF>(PN0, PN1, negMC); } while (0)
  for (int j = 1; j < NT; j += 4) {
    DMA_ITER(j, pB0, pB1, pA0, pA1, 1, 0, 3);
    if (j + 1 < NT) DMA_ITER(j + 1, pA0, pA1, pB0, pB1, 2, 1, 0);
    if (j + 2 < NT) DMA_ITER(j + 2, pB0, pB1, pA0, pA1, 3, 2, 1);
    if (j + 3 < NT) DMA_ITER(j + 3, pA0, pA1, pB0, pB1, 0, 3, 2);
  }
  finishSM(pB0, pB1, l_reg, pa0, pa1, pa2, pa3); ATT_SBAR();
  pv_all_pipe<DV>(o, vb0 + 3 * SHM_V, pa0, pa1, pa2, pa3);
  { auto rr = __builtin_amdgcn_permlane32_swap(__float_as_uint(l_reg), __float_as_uint(l_reg), false, false);
    const unsigned r0 = rr[0], r1 = rr[1]; l_reg = __uint_as_float(r0) + __uint_as_float(r1); }
  const int lane_e = hw_lane(), r32e = lane_e & 31, hie = lane_e >> 5;
  if (hie == 0) li_l[r32e] = l_reg; asm volatile("s_waitcnt lgkmcnt(0)" ::: "memory");
  float rli[16];
#pragma unroll
  for (int r = 0; r < 16; ++r) rli[r] = __builtin_amdgcn_rcpf(li_l[crow(r, hie)]);
  bf16* Ow = Ob + (long)(wid * QBLK) * ldo;
#pragma unroll
  for (int r = 0; r < 16; ++r) { const int orow = crow(r, hie);
#pragma unroll
    for (int d0 = 0; d0 < ND; ++d0) Ow[(long)orow * ldo + d0 * 32 + r32e] = (bf16)f2bf(o[d0][r] * rli[r]); }
  __syncthreads();
#undef ATT_TBASE
#undef DMA_TILE
#undef DMA_WAIT
#undef DMA_ITER
}
}

#define XB_TMO      128
#define XB_XCNT(j)  (256  + 64 * (j))
#define XB_XSUB(j)  (1280 + 64 * (j))
#define XB_XGEN(j)  (2304 + 64 * (j))
#define XB_TOP      3328
#define XB_TOPGEN   3392
#define XCD_BAR_WORDS 3456
#define XB_SPIN_CAP (1u << 18)

__device__ __forceinline__ unsigned xb_ld(unsigned* p)              { return __hip_atomic_load(p, __ATOMIC_RELAXED, __HIP_MEMORY_SCOPE_AGENT); }
__device__ __forceinline__ unsigned xb_add(unsigned* p, unsigned v) { return __hip_atomic_fetch_add(p, v, __ATOMIC_RELAXED, __HIP_MEMORY_SCOPE_AGENT); }
__device__ __forceinline__ unsigned xb_xcc_id() { return (unsigned)__builtin_amdgcn_s_getreg((3 << 11) | 20) & 0xFu; }
#define XB_SPIN(cond, bar) do { unsigned _sp = 0; while (cond) { __builtin_amdgcn_s_sleep(1); \
    if ((++_sp & 255u) == 0u) { if (xb_ld(&(bar)[XB_TMO])) break; if (_sp > XB_SPIN_CAP) { atomicAdd(&(bar)[XB_TMO], 1u); break; } } } } while (0)

struct XcdBarrier {
    int wave;
    unsigned* bar; unsigned x;
    volatile LAS unsigned* st;
};

__device__ __forceinline__ XcdBarrier xcd_barrier_post(unsigned* bar, volatile LAS unsigned* st) {
    XcdBarrier b; b.wave = 0; b.bar = bar; b.x = xb_xcc_id(); b.st = st;
    if (threadIdx.x == 0) (void)xb_add(&bar[XB_XCNT(b.x)], 1u);
    return b;
}
__device__ __forceinline__ void xcd_barrier_complete(unsigned* bar, unsigned x, unsigned& nloc, unsigned& nx) {
    const unsigned G = gridDim.x * gridDim.y * gridDim.z;
    unsigned sum, cnt, mine, sp = 0u;
    for (;;) {
        sum = 0u; cnt = 0u; mine = 0u;
#pragma unroll
        for (unsigned j = 0; j < 16; ++j) { const unsigned c = xb_ld(&bar[XB_XCNT(j)]); sum += c; cnt += (c > 0u) ? 1u : 0u; mine = (j == x) ? c : mine; }
        if (sum == G) break;
        __builtin_amdgcn_s_sleep(1);
        if ((++sp & 255u) == 0u) { if (xb_ld(&bar[XB_TMO])) break; if (sp > XB_SPIN_CAP) { atomicAdd(&bar[XB_TMO], 1u); break; } }
    }
    nloc = mine > 0u ? mine : 1u; nx = cnt > 0u ? cnt : 1u;
}

__device__ __forceinline__ void xcd_barrier(const XcdBarrier& b) {
    asm volatile("s_waitcnt vmcnt(0)" ::: "memory");
    __syncthreads();
    if (b.wave == 0 && hw_lane() == 0) {
        size_t zb_ = 0; asm volatile("" : "+s"(zb_));
        unsigned* bar = b.bar + zb_;
        __builtin_amdgcn_s_waitcnt(0);
        unsigned nloc = b.st[0], nx = b.st[1];
        if (nloc == 0u) { xcd_barrier_complete(bar, b.x, nloc, nx); b.st[0] = nloc; b.st[1] = nx; }
        const unsigned old = xb_add(&bar[XB_XSUB(b.x)], 1u);
        const unsigned gen = old / nloc;
        if (old + 1u == (gen + 1u) * nloc) {
            __builtin_amdgcn_fence(__ATOMIC_RELEASE, "agent");
            asm volatile("s_waitcnt vmcnt(0)" ::: "memory");
            const unsigned og = xb_add(&bar[XB_TOP], 1u);
            const unsigned tg = og / nx;
            if (og + 1u == (tg + 1u) * nx) xb_add(&bar[XB_TOPGEN], 1u);
            else XB_SPIN(xb_ld(&bar[XB_TOPGEN]) == tg, bar);
            __builtin_amdgcn_fence(__ATOMIC_ACQUIRE, "agent");
            xb_add(&bar[XB_XGEN(b.x)], 1u);
            asm volatile("s_waitcnt vmcnt(0)" ::: "memory");
        } else {
            XB_SPIN(xb_ld(&bar[XB_XGEN(b.x)]) == gen, bar);
            __builtin_amdgcn_fence(__ATOMIC_ACQUIRE, "agent");
            asm volatile("s_waitcnt vmcnt(0)" ::: "memory");
        }
    }
    __syncthreads();
}

struct Args { const float* in[35]; float* out; unsigned char* ws; int ph_lo, ph_hi; };
enum { I_X = 0, I_C, I_CTX, I_CCTX, I_ADAW, I_ADAB, I_NMIX, I_NFFN, I_MLA_WIN, I_MLA_QNG, I_MLA_WUQ, I_MLA_KVNG, I_MLA_WUKV, I_MLA_QN, I_MLA_KN, I_MLA_WOUT,
       I_DF_WIN, I_DF_QN, I_DF_KN, I_DF_LQ1, I_DF_LK1, I_DF_LQ2, I_DF_LK2, I_DF_SUBG, I_DF_WOUT, I_SG_WIN, I_SG_LNG, I_SG_LNB, I_SG_WS, I_SG_BS, I_SG_WOUT,
       I_ROUTER, I_WGATE, I_WUP, I_WDOWN };
struct Frame {
    LAS unsigned char* lds;
    int tid, lane, wave, vcu, G;
    unsigned char* ws; float* out;
};
struct InPtrs {
    volatile LAS unsigned* tab;
    __device__ __forceinline__ const float* operator[](int i) const {
        const unsigned lo = __builtin_amdgcn_readfirstlane(tab[2 * i]), hi = __builtin_amdgcn_readfirstlane(tab[2 * i + 1]);
        return (const float*)(const GAS float*)(((unsigned long long)hi << 32) | lo);
    }
};
__device__ __forceinline__ bf16* xb_row(const Frame& F, int row) { return (bf16*)(F.ws + WS_XB) + (size_t)row * D; }

constexpr int TR_SROW = 136, TR_WAVE_BYTES = 64 * TR_SROW;
typedef short tr_v4i16 __attribute__((ext_vector_type(4)));
__device__ __forceinline__ void transpose_item(const float* W, int N, int k0, int n0, int ncols  , bf16* WT, int K, int drow0, LAS unsigned char* scr, int lane, const float* kscale = nullptr  ) {
    const int r4 = lane >> 4, c4 = (lane & 15) * 4;
    const bool ld_ok = c4 < ncols;
    f32x4 v[16];
    const float* src = W + (size_t)(k0 + r4) * N + n0 + c4;
#pragma unroll
    for (int i = 0; i < 16; ++i) v[i] = ld_ok ? __builtin_nontemporal_load((const f32x4*)(src + (size_t)(4 * i) * N)) : (f32x4){0.f, 0.f, 0.f, 0.f};
#pragma unroll
    for (int i = 0; i < 16; ++i) { if (kscale) v[i] = v[i] * kscale[k0 + 4 * i + r4]; v2u w; w.x = pk2(v[i].x, v[i].y); w.y = pk2(v[i].z, v[i].w); *(LAS v2u*)(scr + (4 * i + r4) * TR_SROW + c4 * 2) = w; }
    LDS_WAIT(); asm volatile("" ::: "memory");
    const LAS unsigned char* rb = scr + ((lane >> 2) & 3) * TR_SROW + ((lane >> 4) * 16 + (lane & 3) * 4) * 2;
    v2u o[16];
#pragma unroll
    for (int k4 = 0; k4 < 16; ++k4) { const tr_v4i16 t = __builtin_amdgcn_ds_read_tr16_b64_v4i16((LAS tr_v4i16*)(rb + k4 * 4 * TR_SROW)); o[k4] = __builtin_bit_cast(v2u, t); }
    LDS_WAIT(); asm volatile("" ::: "memory");
    if (lane < ncols) { v4u* dst = (v4u*)(WT + (size_t)(drow0 + lane) * K + k0);
#pragma unroll
        for (int j = 0; j < 8; ++j) dst[j] = (v4u){o[2 * j].x, o[2 * j].y, o[2 * j + 1].x, o[2 * j + 1].y}; }
}
__device__ __forceinline__ int tr_items(int K, int N) { return (K / 64) * ((N + 63) / 64); }
__device__ __forceinline__ void tr_run(const float* W, int K, int N, bf16* WT, int r, LAS unsigned char* scr, int lane, const float* kscale = nullptr) {
    const int nblk = (N + 63) / 64, kb = r / nblk, nb = r % nblk, k0 = kb * 64, n0 = nb * 64;
    transpose_item(W, N, k0, n0, (N - n0) < 64 ? (N - n0) : 64, WT, K, n0, scr, lane, kscale);
}

__device__ __forceinline__ void p0_prologue(Frame& F, const InPtrs& A) {
    {
        LAS float* sv = (LAS float*)F.lds;
        LAS float* red = (LAS float*)(F.lds + 36864);
        bool have = false;
        for (int it = blockIdx.x; it < 96; it += F.G) {
            if (!have) {
                for (int i = F.tid; i < 9 * 1024; i += NTHREADS) { const int r = i >> 10, k = i & 1023; const float v = r < 8 ? A[I_C][r * 1024 + k] : A[I_CCTX][k]; sv[i] = v / (1.0f + __expf(-v)); }
                __syncthreads(); have = true;
            }
            const int layer = it / 24, cb = it % 24, col = cb * 256 + 4 * F.lane, kbase = F.wave * 128;
            const float* W = A[I_ADAW] + (size_t)layer * 1024 * 6144 + col;
            f32x4 acc[9];
#pragma unroll
            for (int r = 0; r < 9; ++r) acc[r] = (f32x4){0.f, 0.f, 0.f, 0.f};
#pragma unroll 4
            for (int k = 0; k < 128; ++k) { const f32x4 w = *(const f32x4*)(W + (size_t)(kbase + k) * 6144);
#pragma unroll
                for (int r = 0; r < 9; ++r) acc[r] += w * sv[r * 1024 + kbase + k]; }
#pragma unroll
            for (int r = 0; r < 9; ++r) *(LAS f32x4*)(red + (F.wave * 9 + r) * 256 + 4 * F.lane) = acc[r];
            __syncthreads();
            float* MODp = (float*)(F.ws + WS_MOD) + (size_t)layer * 9 * 6144;
            for (int o = F.tid; o < 9 * 256; o += NTHREADS) { const int r = o >> 8, cc = o & 255; float s = 0.f;
#pragma unroll
                for (int w = 0; w < 8; ++w) s += red[(w * 9 + r) * 256 + cc];
                MODp[r * 6144 + cb * 256 + cc] = s + A[I_ADAB][layer * 6144 + cb * 256 + cc]; }
            __syncthreads();
        }
        __syncthreads();
    }
    const int gtid = F.vcu * NTHREADS + F.tid, GT = F.G * NTHREADS;
    {
        float* ca = (float*)(F.ws + WS_ROPEA); float* sa = ca + 4096 * 16; float* cb = (float*)(F.ws + WS_ROPEB); float* sb = cb + 4096 * 32;
        for (int i = gtid; i < 4096 * 16; i += GT) { const int t = i >> 4, j = i & 15, f = j & 7; const float pos = (float)(j < 8 ? (t >> 6) : (t & 63));
            const float inv = powf(10000.0f, -(float)f / 8.0f), ang = pos * inv; ca[i] = cosf(ang); sa[i] = sinf(ang); }
        for (int i = gtid; i < 4096 * 32; i += GT) { const int t = i >> 5, j = i & 31, f = j & 15; const float pos = (float)(j < 16 ? (t >> 6) : (t & 63));
            const float inv = powf(10000.0f, -(float)f / 16.0f), ang = pos * inv; cb[i] = cosf(ang); sb[i] = sinf(ang); }
    }
    {
        for (int j = 0; j < 2; ++j) { v4u* z = (v4u*)(F.ws + WS_WNM + j * MLA_W_STRIDE + MLA_WIN + (size_t)800 * 1024 * 2);
            for (int i = gtid; i < 224 * 1024 * 2 / 16; i += GT) z[i] = (v4u){0u, 0u, 0u, 0u}; }
        bf16* wsA = (bf16*)(F.ws + WS_SG_WS); const float* wsrc = A[I_SG_WS];
        for (int i = gtid; i < 8 * 256 * 128 / 2; i += GT) { const int e0 = i * 2, g = e0 >> 15, p = (e0 >> 7) & 255, q = e0 & 127;
            unsigned w = 0u; if (p < 128) { const float* s = wsrc + ((size_t)g * 128 + p) * 128 + q; w = pk2(s[0], s[1]); }
            ((unsigned*)wsA)[i] = w; }
    }
    {
        LAS unsigned char* scr = F.lds + F.wave * TR_WAVE_BYTES;
        const int gw = F.vcu * NWAVES + F.wave, NGW = F.G * NWAVES;
        const int n_win = tr_items(1024, 800), n_wuq = tr_items(512, 1536), n_wukv = tr_items(256, 2048), n_wout = tr_items(1024, 1024);
        const int n_mla = n_win + n_wuq + n_wukv + n_wout;
        const int n_dwin = tr_items(1024, 3072), n_dwout = tr_items(1024, 1024), n_swin = tr_items(1024, 4096), n_swout = tr_items(2048, 1024);
        const int total = 2 * n_mla + n_dwin + n_dwout + n_swin + n_swout;
        for (int it = gw; it < total; it += NGW) {
            int r = it;
            if (r < 2 * n_mla) { const int j = r / n_mla; r -= j * n_mla; unsigned char* wb = F.ws + WS_WNM + j * MLA_W_STRIDE;
                if (r < n_win) { tr_run(A[I_MLA_WIN] + (size_t)j * 1024 * 800, 1024, 800, (bf16*)(wb + MLA_WIN), r, scr, F.lane); continue; } r -= n_win;
                if (r < n_wuq) { tr_run(A[I_MLA_WUQ] + (size_t)j * 512 * 1536, 512, 1536, (bf16*)(wb + MLA_WUQ), r, scr, F.lane, A[I_MLA_QNG] + j * 512); continue; } r -= n_wuq;
                if (r < n_wukv) { tr_run(A[I_MLA_WUKV] + (size_t)j * 256 * 2048, 256, 2048, (bf16*)(wb + MLA_WUKV), r, scr, F.lane, A[I_MLA_KVNG] + j * 256); continue; } r -= n_wukv;
                tr_run(A[I_MLA_WOUT] + (size_t)j * 1024 * 1024, 1024, 1024, (bf16*)(wb + MLA_WOUT), r, scr, F.lane); continue; }
            r -= 2 * n_mla;
            if (r < n_dwin) { tr_run(A[I_DF_WIN], 1024, 3072, (bf16*)(F.ws + WS_DIFF_WIN), r, scr, F.lane); continue; } r -= n_dwin;
            if (r < n_dwout) { tr_run(A[I_DF_WOUT], 1024, 1024, (bf16*)(F.ws + WS_DIFF_WOUT), r, scr, F.lane); continue; } r -= n_dwout;
            if (r < n_swin) { tr_run(A[I_SG_WIN], 1024, 4096, (bf16*)(F.ws + WS_SG_WIN), r, scr, F.lane); continue; } r -= n_swin;
            tr_run(A[I_SG_WOUT], 2048, 1024, (bf16*)(F.ws + WS_SG_WOUT), r, scr, F.lane);
        }
    }
}
__device__ __forceinline__ void moe_weight_item(Frame& F, const InPtrs& A, int layer, int it, LAS unsigned char* scr) {
    constexpr int PER = 16 * 16;
    const int which = it / (16 * PER), r0 = it % (16 * PER), e = r0 / PER, r = r0 % PER, kb = r >> 4, nb = r & 15, k0 = kb * 64, n0 = nb * 64;
    const size_t eoff = ((size_t)layer * 16 + e) * 1024 * 1024;
    if (which == 0) transpose_item(A[I_WGATE] + eoff, 1024, k0, n0, 64, (bf16*)(F.ws + WS_WGU), 1024, e * 2048 + (n0 >> 7) * 256 + (n0 & 127), scr, F.lane);
    else if (which == 1) transpose_item(A[I_WUP] + eoff, 1024, k0, n0, 64, (bf16*)(F.ws + WS_WGU), 1024, e * 2048 + (n0 >> 7) * 256 + 128 + (n0 & 127), scr, F.lane);
    else transpose_item(A[I_WDOWN] + eoff, 1024, k0, n0, 64, (bf16*)(F.ws + WS_WDN), 1024, e * 1024 + n0, scr, F.lane);
}
constexpr int MOE_CONV_ITEMS = 3 * 16 * 16 * 16;
__device__ __forceinline__ void moe_weight_items(Frame& F, const InPtrs& A, int layer) {
    LAS unsigned char* scr = F.lds + F.wave * TR_WAVE_BYTES;
    const int gw = F.vcu * NWAVES + F.wave, NGW = F.G * NWAVES;
    for (int it = gw; it < MOE_CONV_ITEMS; it += NGW) moe_weight_item(F, A, layer, it, scr);
}
constexpr int CONV_LDS_OFF = 69632;
__device__ __forceinline__ int conv_rounds(const Frame& F) { return F.G >= 256 ? 6 : (F.G >= 128 ? 12 : (MOE_CONV_ITEMS + F.G * NWAVES - 1) / (F.G * NWAVES)); }
__device__ __forceinline__ void moe_weight_round(Frame& F, const InPtrs& A, int layer, int round) {
    const int it = round * (F.G * NWAVES) + F.vcu * NWAVES + F.wave;
    Frame Fc = F; { int l_ = F.lane; asm volatile("" : "+v"(l_)); Fc.lane = l_; }
    if (it < MOE_CONV_ITEMS) moe_weight_item(Fc, A, layer, it, F.lds + CONV_LDS_OFF + F.wave * TR_WAVE_BYTES);
}
template <bool FFN, bool FIRST>
__device__ __forceinline__ void norm_phase(Frame& F, const InPtrs& A, int layer, bool combine, int nrows, float cmul = 1.0f) {
    constexpr bool first = FIRST;
    const int gw = F.vcu * NWAVES + F.wave, NGW = F.G * NWAVES, lane = F.lane;
    const float* MOD = (const float*)(F.ws + WS_MOD);
    LAS float* rT = (LAS float*)F.lds;
    if (FFN) {
        const float* R = A[I_ROUTER] + (size_t)layer * 1024 * 16;
        for (int i = F.tid; i < 16 * 1024; i += NTHREADS) { const int k = i >> 4, e = i & 15; rT[e * 1024 + k] = R[i]; }
        __syncthreads();
    }
#define NPC(q) (8 * (64 * ((q) >> 1) + lane) + 4 * ((q) & 1))
    const float* gvec = (FFN ? A[I_NFFN] : A[I_NMIX]) + layer * 1024;
    f32x4 gn[4];
#pragma unroll
    for (int j = 0; j < 4; ++j) gn[j] = *(const f32x4*)(gvec + NPC(j));
    const bf16* YB = (const bf16*)(F.ws + R_YB);
    const int* SLOT = (const int*)(F.ws + WS_SLOT);
    const float* A_x = first ? A[I_X] : nullptr; const float* A_c = first ? A[I_CTX] : nullptr;
    f32x4 xaf[4], xbf[4]; v4u xab[2], xbb[2]; int sla = -1, slb = -1;
    v4u wB[4][2], wC[4][2]; int sB[4] = {-1, -1, -1, -1}, sC[4] = {-1, -1, -1, -1}; unsigned restB = 0u, restC = 0u;
#define NP_LOADX(mm, XF, XB_, SL) do { if (first) { const float* src_ = (mm) < NLAT ? A_x + (size_t)(mm) * D : A_c + (size_t)((mm) - NLAT) * D; \
        _Pragma("unroll") for (int j = 0; j < 4; ++j) XF[j] = *(const f32x4*)(src_ + NPC(j)); } \
      else { const bf16* src_ = xb_row(F, (mm)); _Pragma("unroll") for (int k = 0; k < 2; ++k) XB_[k] = *(const v4u*)(src_ + NPC(2 * k)); } \
      if (combine) SL = SLOT[(size_t)(mm) * 16 + (lane & 15)]; } while (0)
#define NP_LOADW(SL, W, SI, REST) do { unsigned msk_ = (unsigned)(__ballot((SL) >= 0) & 0xffffull); \
        _Pragma("unroll") for (int q = 0; q < 4; ++q) { SI[q] = -1; if (msk_) { const int e_ = __builtin_ctz(msk_); msk_ &= msk_ - 1u; SI[q] = __builtin_amdgcn_readlane((SL), e_); } } \
        REST = msk_; \
        _Pragma("unroll") for (int q = 0; q < 4; ++q) if (SI[q] >= 0) { const bf16* y_ = YB + (size_t)SI[q] * 1024; \
            _Pragma("unroll") for (int k = 0; k < 2; ++k) W[q][k] = *(const v4u*)(y_ + NPC(2 * k)); } } while (0)
    if (gw < nrows) { NP_LOADX(gw, xbf, xbb, slb); }
    if (gw + NGW < nrows) { NP_LOADX(gw + NGW, xaf, xab, sla); }
    if (combine && gw < nrows) { NP_LOADW(slb, wB, sB, restB); }
    for (int m = gw; m < nrows; m += NGW) {
        const bool lat = m < NLAT; const int rr = lat ? (m >> 12) : 8;
        f32x4 v[4]; const int slc = slb;
#pragma unroll
        for (int k = 0; k < 2; ++k) { v[2 * k] = first ? xbf[2 * k] : (f32x4){bflo(xbb[k].x), bfhi(xbb[k].x), bflo(xbb[k].y), bfhi(xbb[k].y)}; v[2 * k + 1] = first ? xbf[2 * k + 1] : (f32x4){bflo(xbb[k].z), bfhi(xbb[k].z), bflo(xbb[k].w), bfhi(xbb[k].w)}; }
#pragma unroll
        for (int q = 0; q < 4; ++q) { sC[q] = sB[q]; wC[q][0] = wB[q][0]; wC[q][1] = wB[q][1]; }
        restC = restB;
#pragma unroll
        for (int j = 0; j < 4; ++j) xbf[j] = xaf[j];
        xbb[0] = xab[0]; xbb[1] = xab[1];
        slb = sla;
        { const int m2 = m + 2 * NGW; if (m2 < nrows) { NP_LOADX(m2, xaf, xab, sla); } }
        if (combine) { if (m + NGW < nrows) { NP_LOADW(slb, wB, sB, restB); } }
        if (combine) {
            f32x4 acc[4];
#pragma unroll
            for (int j = 0; j < 4; ++j) acc[j] = (f32x4){0.f, 0.f, 0.f, 0.f};
#pragma unroll
            for (int q = 0; q < 4; ++q) if (sC[q] >= 0) {
#pragma unroll
                for (int k = 0; k < 2; ++k) { acc[2 * k] += (f32x4){bflo(wC[q][k].x), bfhi(wC[q][k].x), bflo(wC[q][k].y), bfhi(wC[q][k].y)}; acc[2 * k + 1] += (f32x4){bflo(wC[q][k].z), bfhi(wC[q][k].z), bflo(wC[q][k].w), bfhi(wC[q][k].w)}; } }
            while (restC) {
                const int e = __builtin_ctz(restC); restC &= restC - 1u; const int sidx = __builtin_amdgcn_readlane(slc, e);
                const bf16* y = YB + (size_t)sidx * 1024;
#pragma unroll
                for (int k = 0; k < 2; ++k) { const v4u w = *(const v4u*)(y + NPC(2 * k)); acc[2 * k] += (f32x4){bflo(w.x), bfhi(w.x), bflo(w.y), bfhi(w.y)}; acc[2 * k + 1] += (f32x4){bflo(w.z), bfhi(w.z), bflo(w.w), bfhi(w.w)}; }
            }
            const float* g2 = MOD + ((size_t)(layer - 1) * 9 + rr) * 6144 + 5120;
#pragma unroll
            for (int j = 0; j < 4; ++j) v[j] += *(const f32x4*)(g2 + NPC(j)) * acc[j] * cmul;
        }
        if (first || combine) { bf16* dst = xb_row(F, m);
#pragma unroll
            for (int k = 0; k < 2; ++k) { v4u w; w.x = pk2(v[2 * k].x, v[2 * k].y); w.y = pk2(v[2 * k].z, v[2 * k].w); w.z = pk2(v[2 * k + 1].x, v[2 * k + 1].y); w.w = pk2(v[2 * k + 1].z, v[2 * k + 1].w);
                *(v4u*)(dst + NPC(2 * k)) = w;
                v[2 * k] = (f32x4){bflo(w.x), bfhi(w.x), bflo(w.y), bfhi(w.y)}; v[2 * k + 1] = (f32x4){bflo(w.z), bfhi(w.z), bflo(w.w), bfhi(w.w)}; } }
        float ss = 0.f;
#pragma unroll
        for (int j = 0; j < 4; ++j) ss += (v[j].x * v[j].x + v[j].y * v[j].y) + (v[j].z * v[j].z + v[j].w * v[j].w);
        const float r = 1.0f / sqrtf(wave_sum(ss) * (1.0f / D) + EPS);
        const float* mrow = MOD + ((size_t)layer * 9 + rr) * 6144 + (FFN ? 3072 : 0);
        f32x4 h[4];
#pragma unroll
        for (int j = 0; j < 4; ++j) { const f32x4 sh = *(const f32x4*)(mrow + NPC(j)), sc = *(const f32x4*)(mrow + 1024 + NPC(j));
            h[j] = (v[j] * r * gn[j]) * (sc + 1.0f) + sh; }
        bf16* hrow = (bf16*)(F.ws + WS_H) + (size_t)m * D;
#pragma unroll
        for (int k = 0; k < 2; ++k) { v4u w; w.x = pk2(h[2 * k].x, h[2 * k].y); w.y = pk2(h[2 * k].z, h[2 * k].w); w.z = pk2(h[2 * k + 1].x, h[2 * k + 1].y); w.w = pk2(h[2 * k + 1].z, h[2 * k + 1].w); *(v4u*)(hrow + NPC(2 * k)) = w; }
        if (FFN) {
            float lg[16];
            LAS float* rTm = rT + 8 * lane; asm volatile("" : "+v"(rTm));
#pragma unroll
            for (int e = 0; e < 16; ++e) { float s = 0.f;
#pragma unroll
                for (int j = 0; j < 4; ++j) { const f32x4 w = *(const LAS f32x4*)(rTm + e * 1024 + 512 * (j >> 1) + 4 * (j & 1)); s += (h[j].x * w.x + h[j].y * w.y) + (h[j].z * w.z + h[j].w * w.w); }
                lg[e] = wave_sum(s); }
            float mx = lg[0];
#pragma unroll
            for (int e = 1; e < 16; ++e) mx = fmaxf(mx, lg[e]);
            float den = 0.f;
#pragma unroll
            for (int e = 0; e < 16; ++e) { lg[e] = expf(lg[e] - mx); den += lg[e]; }
            float mine = 0.f;
#pragma unroll
            for (int e = 0; e < 16; ++e) mine = (lane == e) ? lg[e] : mine;
            if (lane < 16) { ((float*)(F.ws + WS_AFF))[(size_t)m * 16 + lane] = mine / den; ((int*)(F.ws + WS_SLOT))[(size_t)m * 16 + lane] = -1; }
        }
    }
}
#undef NP_LOADX
#undef NP_LOADW
#undef NPC
__device__ __forceinline__ void final_phase(Frame& F, int layer) {
    const int gw = F.vcu * NWAVES + F.wave, NGW = F.G * NWAVES, lane = F.lane;
    const float* MOD = (const float*)(F.ws + WS_MOD);
    const bf16* YB = (const bf16*)(F.ws + R_YB); const int* SLOT = (const int*)(F.ws + WS_SLOT);
    v2u vn[4]; int sln = -1;
    if (gw < NLAT) { const bf16* src = xb_row(F, gw);
#pragma unroll
        for (int j = 0; j < 4; ++j) vn[j] = *(const v2u*)(src + 4 * (64 * j + lane));
        sln = SLOT[(size_t)gw * 16 + (lane & 15)]; }
    for (int m = gw; m < NLAT; m += NGW) {
        float* xr = F.out + (size_t)m * D; const int rr = m >> 12;
        f32x4 v[4]; const int sl = sln;
#pragma unroll
        for (int j = 0; j < 4; ++j) v[j] = (f32x4){bflo(vn[j].x), bfhi(vn[j].x), bflo(vn[j].y), bfhi(vn[j].y)};
        { const int mn = m + NGW; if (mn < NLAT) { const bf16* src = xb_row(F, mn);
#pragma unroll
            for (int j = 0; j < 4; ++j) vn[j] = *(const v2u*)(src + 4 * (64 * j + lane));
            sln = SLOT[(size_t)mn * 16 + (lane & 15)]; } }
        f32x4 acc[4];
#pragma unroll
        for (int j = 0; j < 4; ++j) acc[j] = (f32x4){0.f, 0.f, 0.f, 0.f};
        unsigned msk = (unsigned)(__ballot(sl >= 0) & 0xffffull);
        while (msk) {
            int sidx[4]; v2u w[4][4];
#pragma unroll
            for (int q = 0; q < 4; ++q) { sidx[q] = -1; if (msk) { const int e = __builtin_ctz(msk); msk &= msk - 1u; sidx[q] = __builtin_amdgcn_readlane(sl, e); } }
#pragma unroll
            for (int q = 0; q < 4; ++q) if (sidx[q] >= 0) { const bf16* y = YB + (size_t)sidx[q] * 1024;
#pragma unroll
                for (int j = 0; j < 4; ++j) w[q][j] = *(const v2u*)(y + 4 * (64 * j + lane)); }
#pragma unroll
            for (int q = 0; q < 4; ++q) if (sidx[q] >= 0) {
#pragma unroll
                for (int j = 0; j < 4; ++j) acc[j] += (f32x4){bflo(w[q][j].x), bfhi(w[q][j].x), bflo(w[q][j].y), bfhi(w[q][j].y)}; }
        }
        const float* g2 = MOD + ((size_t)layer * 9 + rr) * 6144 + 5120;
#pragma unroll
        for (int j = 0; j < 4; ++j) *(f32x4*)(xr + 4 * (64 * j + lane)) = v[j] + *(const f32x4*)(g2 + 4 * (64 * j + lane)) * acc[j];
    }
}
__device__ __forceinline__ void unpack8(const v4u w, float* f) { f[0] = bflo(w.x); f[1] = bfhi(w.x); f[2] = bflo(w.y); f[3] = bfhi(w.y); f[4] = bflo(w.z); f[5] = bfhi(w.z); f[6] = bflo(w.w); f[7] = bfhi(w.w); }
__device__ __forceinline__ v4u pack8(const float* f) { v4u w; w.x = pk2(f[0], f[1]); w.y = pk2(f[2], f[3]); w.z = pk2(f[4], f[5]); w.w = pk2(f[6], f[7]); return w; }
__device__ __forceinline__ void unpack4(const v2u w, float* f) { f[0] = bflo(w.x); f[1] = bfhi(w.x); f[2] = bflo(w.y); f[3] = bfhi(w.y); }
__device__ __forceinline__ v2u pack4(const float* f) { v2u w; w.x = pk2(f[0], f[1]); w.y = pk2(f[2], f[3]); return w; }

struct MfRow { v4u cq; v2u ckv; v4u k0, k1; v2u kr0, kr1; v4u v0, v1; f32x4 cs, sn; };
__device__ __forceinline__ void mf_load(MfRow& R, int m, const bf16* KVPRE, const bf16* DOWN, const float* ca, const float* sa, int lane, int h, int p) {
    const bf16* dr = DOWN + (size_t)m * 1024;
    R.cq = *(const v4u*)(dr + 8 * lane); R.ckv = *(const v2u*)(dr + 512 + 4 * lane);
    const bf16* s = KVPRE + (size_t)m * 2048 + h * 128; const bf16* kr = dr + 768;
    { const v4u* pp = (const v4u*)(s + 16 * p); R.k0 = pp[0]; R.k1 = pp[1]; R.kr0 = *(const v2u*)(kr + 4 * p); R.kr1 = *(const v2u*)(kr + 16 + 4 * p); }
    { const v4u* vs = (const v4u*)(s + 64 + 16 * p); R.v0 = vs[0]; R.v1 = vs[1]; }
    if (m < NLAT) { const int t = m & 4095; R.cs = *(const f32x4*)(ca + t * 16 + 4 * p); R.sn = *(const f32x4*)(sa + t * 16 + 4 * p); }
    else { R.cs = (f32x4){1.f, 1.f, 1.f, 1.f}; R.sn = (f32x4){0.f, 0.f, 0.f, 0.f}; }
}
__device__ __forceinline__ void mla_finish_phase(Frame& F, const InPtrs& A, int j) {
    const int gw = F.vcu * NWAVES + F.wave, NGW = F.G * NWAVES, lane = F.lane, h = lane >> 2, p = lane & 3;
    const bf16* DOWN = (const bf16*)(F.ws + R_DOWN); const bf16* KVPRE = (const bf16*)(F.ws + R_KVPRE);
    bf16* MK = (bf16*)(F.ws + R_MK); bf16* MV = (bf16*)(F.ws + R_MV); float* RQ = (float*)(F.ws + WS_RQ);
    const float* ca = (const float*)(F.ws + WS_ROPEA); const float* sa = ca + 4096 * 16;
    float gk[24];
    { const float* k = A[I_MLA_KN] + j * 96;
#pragma unroll
      for (int i = 0; i < 16; ++i) gk[i] = k[16 * p + i];
#pragma unroll
      for (int i = 0; i < 4; ++i) { gk[16 + i] = k[64 + 4 * p + i]; gk[20 + i] = k[80 + 4 * p + i]; } }
    MfRow N;
    if (gw < MROWS) mf_load(N, gw, KVPRE, DOWN, ca, sa, lane, h, p);
    for (int m = gw; m < MROWS; m += NGW) {
        const MfRow R = N;
        { const int mn = m + NGW; if (mn < MROWS) mf_load(N, mn, KVPRE, DOWN, ca, sa, lane, h, p); }
        const bool lat = m < NLAT; const int b = lat ? (m >> 12) : ((m - NLAT) >> 8), t = lat ? (m & 4095) : ((m - NLAT) & 255);
        float c8[8], c4[4]; unpack8(R.cq, c8); unpack4(R.ckv, c4);
        float sq = 0.f, skv = 0.f;
#pragma unroll
        for (int i = 0; i < 8; ++i) sq += c8[i] * c8[i];
#pragma unroll
        for (int i = 0; i < 4; ++i) skv += c4[i] * c4[i];
        sq = wave_sum(sq); skv = wave_sum(skv);
        const float rq = 1.0f / sqrtf(sq * (1.0f / 512.0f) + EPS), rkv = 1.0f / sqrtf(skv * (1.0f / 256.0f) + EPS);
        if (lane == 0) RQ[m] = rq;
        float v[24]; unpack8(R.k0, v); unpack8(R.k1, v + 8); unpack4(R.kr0, v + 16); unpack4(R.kr1, v + 20);
#pragma unroll
        for (int i = 0; i < 16; ++i) v[i] *= rkv;
        float ss = 0.f;
#pragma unroll
        for (int i = 0; i < 24; ++i) ss += v[i] * v[i];
        ss += shx<1>(ss); ss += shx<2>(ss);
        const float r = 1.0f / sqrtf(ss * (1.0f / 96.0f) + EPS);
#pragma unroll
        for (int i = 0; i < 24; ++i) v[i] = v[i] * r * gk[i];
#pragma unroll
        for (int i = 0; i < 4; ++i) { const float x1 = v[16 + i], x2 = v[20 + i]; v[16 + i] = x1 * R.cs[i] - x2 * R.sn[i]; v[20 + i] = x1 * R.sn[i] + x2 * R.cs[i]; }
        const int key = lat ? 256 + t : t;
        bf16* d = MK + (((size_t)b * 16 + h) * NKEYS + key) * 96;
        { v4u* o = (v4u*)(d + 16 * p); o[0] = pack8(v); o[1] = pack8(v + 8); *(v2u*)(d + 64 + 4 * p) = pack4(v + 16); *(v2u*)(d + 80 + 4 * p) = pack4(v + 20); }
        float vv[16]; unpack8(R.v0, vv); unpack8(R.v1, vv + 8);
#pragma unroll
        for (int i = 0; i < 16; ++i) vv[i] *= rkv;
        v4u* vd = (v4u*)(MV + (((size_t)b * 16 + h) * NKEYS + key) * 64 + 16 * p);
        vd[0] = pack8(vv); vd[1] = pack8(vv + 8);
    }
}
struct DqRow { v4u q0, q1, k0, k1; f32x4 c0, c1, s0, s1; };
__device__ __forceinline__ void dq_load(DqRow& R, int m, const bf16* QKV, const float* cb, const float* sb, int u, int p) {
    const bf16* s = QKV + (size_t)m * 3072 + u * 64;
    R.q0 = *(const v4u*)(s + 8 * p); R.q1 = *(const v4u*)(s + 32 + 8 * p); R.k0 = *(const v4u*)(s + 1024 + 8 * p); R.k1 = *(const v4u*)(s + 1024 + 32 + 8 * p);
    if (m < NLAT) { const int t = m & 4095; R.c0 = *(const f32x4*)(cb + t * 32 + 8 * p); R.c1 = *(const f32x4*)(cb + t * 32 + 8 * p + 4); R.s0 = *(const f32x4*)(sb + t * 32 + 8 * p); R.s1 = *(const f32x4*)(sb + t * 32 + 8 * p + 4); }
    else { R.c0 = R.c1 = (f32x4){1.f, 1.f, 1.f, 1.f}; R.s0 = R.s1 = (f32x4){0.f, 0.f, 0.f, 0.f}; }
}
__device__ __forceinline__ void diff_finish_qk_phase(Frame& F, const InPtrs& A) {
    const int gw = F.vcu * NWAVES + F.wave, NGW = F.G * NWAVES, lane = F.lane, u = lane >> 2, p = lane & 3;
    const bf16* QKV = (const bf16*)(F.ws + R_QKV);
    bf16* DQ = (bf16*)(F.ws + R_DQ); bf16* DQC = (bf16*)(F.ws + R_DQC); bf16* DK = (bf16*)(F.ws + R_DK);
    const float* cb = (const float*)(F.ws + WS_ROPEB); const float* sb = cb + 4096 * 32;
    float gq[16], gk[16];
    { const float* qn = A[I_DF_QN]; const float* kn = A[I_DF_KN];
#pragma unroll
      for (int i = 0; i < 8; ++i) { gq[i] = qn[8 * p + i] * att::Sc<64>::C; gq[8 + i] = qn[32 + 8 * p + i] * att::Sc<64>::C; gk[i] = kn[8 * p + i]; gk[8 + i] = kn[32 + 8 * p + i]; } }
    DqRow N;
    if (gw < MROWS) dq_load(N, gw, QKV, cb, sb, u, p);
    for (int m = gw; m < MROWS; m += NGW) {
        const DqRow R = N;
        { const int mn = m + NGW; if (mn < MROWS) dq_load(N, mn, QKV, cb, sb, u, p); }
        const bool lat = m < NLAT; const int b = lat ? (m >> 12) : ((m - NLAT) >> 8), t = lat ? (m & 4095) : ((m - NLAT) & 255);
        float cs[8], sn[8];
#pragma unroll
        for (int i = 0; i < 4; ++i) { cs[i] = R.c0[i]; cs[4 + i] = R.c1[i]; sn[i] = R.s0[i]; sn[4 + i] = R.s1[i]; }
#pragma unroll
        for (int isk = 0; isk < 2; ++isk) {
            float v[16]; unpack8(isk ? R.k0 : R.q0, v); unpack8(isk ? R.k1 : R.q1, v + 8);
            float ss = 0.f;
#pragma unroll
            for (int i = 0; i < 16; ++i) ss += v[i] * v[i];
            ss += shx<1>(ss); ss += shx<2>(ss);
            const float r = 1.0f / sqrtf(ss * (1.0f / 64.0f) + EPS);
#pragma unroll
            for (int i = 0; i < 16; ++i) v[i] = v[i] * r * (isk ? gk[i] : gq[i]);
#pragma unroll
            for (int i = 0; i < 8; ++i) { const float x1 = v[i], x2 = v[8 + i]; v[i] = x1 * cs[i] - x2 * sn[i]; v[8 + i] = x1 * sn[i] + x2 * cs[i]; }
            bf16* d;
            if (isk) d = DK + (((size_t)b * 16 + u) * NKEYS + (lat ? 256 + t : t)) * 64;
            else d = lat ? DQ + (((size_t)b * 16 + u) * 4096 + t) * 64 : DQC + (((size_t)b * 16 + u) * 256 + t) * 64;
            *(v4u*)(d + 8 * p) = pack8(v); *(v4u*)(d + 32 + 8 * p) = pack8(v + 8);
        }
    }
}
__device__ __forceinline__ void diff_finish_o_phase(Frame& F, const InPtrs& A, float lam_init) {
    const int gw = F.vcu * NWAVES + F.wave, NGW = F.G * NWAVES, lane = F.lane, h = lane >> 3, p = lane & 7;
    const bf16* OB = (const bf16*)(F.ws + R_OB); bf16* AO = (bf16*)(F.ws + R_DAO);
    const float d1 = wave_sum(A[I_DF_LQ1][lane] * A[I_DF_LK1][lane]), d2 = wave_sum(A[I_DF_LQ2][lane] * A[I_DF_LK2][lane]);
    const float lam = expf(d1) - expf(d2) + lam_init, post = 1.0f - lam_init;
    float g[16];
    { const float* sg = A[I_DF_SUBG];
#pragma unroll
      for (int i = 0; i < 16; ++i) g[i] = sg[16 * p + i] * post; }
    v4u n0 = (v4u){0u, 0u, 0u, 0u}, n1 = n0, n2 = n0, n3 = n0;
    if (gw < MROWS) { const bf16* s0 = OB + (size_t)gw * 2048 + (2 * h) * 128 + 16 * p; n0 = ((const v4u*)s0)[0]; n1 = ((const v4u*)s0)[1]; n2 = ((const v4u*)(s0 + 128))[0]; n3 = ((const v4u*)(s0 + 128))[1]; }
    for (int m = gw; m < MROWS; m += NGW) {
        const v4u c0 = n0, c1 = n1, c2 = n2, c3 = n3;
        { const int mn = m + NGW; if (mn < MROWS) { const bf16* s0 = OB + (size_t)mn * 2048 + (2 * h) * 128 + 16 * p; n0 = ((const v4u*)s0)[0]; n1 = ((const v4u*)s0)[1]; n2 = ((const v4u*)(s0 + 128))[0]; n3 = ((const v4u*)(s0 + 128))[1]; } }
        float a[16], c[16];
        unpack8(c0, a); unpack8(c1, a + 8); unpack8(c2, c); unpack8(c3, c + 8);
        float ss = 0.f;
#pragma unroll
        for (int i = 0; i < 16; ++i) { a[i] = a[i] - lam * c[i]; ss += a[i] * a[i]; }
        ss += shx<1>(ss); ss += shx<2>(ss); ss += shx<4>(ss);
        const float r = 1.0f / sqrtf(ss * (1.0f / 128.0f) + EPS);
#pragma unroll
        for (int i = 0; i < 16; ++i) a[i] = a[i] * r * g[i];
        v4u* o = (v4u*)(AO + (size_t)m * 1024 + h * 128 + 16 * p); o[0] = pack8(a); o[1] = pack8(a + 8);
    }
}
__device__ __forceinline__ void sg_ln_item(Frame& F, const InPtrs& A, int chunk, int g_lo, int g_hi) {
    const bf16* Z = (const bf16*)(F.ws + R_Z); bf16* VNT = (bf16*)(F.ws + R_VNT);
    LAS float* st = (LAS float*)F.lds;
    LAS unsigned short* T = (LAS unsigned short*)(F.lds + 1024);
    constexpr int TS = 258;
    const int lane = F.lane, tid = F.tid;
    {
        const bf16* vr0 = Z + ((size_t)chunk * 128 + F.wave * 16) * 4096 + 2048;
        v4u nx[4];
#pragma unroll
        for (int i = 0; i < 4; ++i) nx[i] = *(const v4u*)(vr0 + 8 * (lane + 64 * i));
        for (int qi = 0; qi < 16; ++qi) {
            float x[32];
#pragma unroll
            for (int i = 0; i < 4; ++i) unpack8(nx[i], x + 8 * i);
            if (qi < 15) {
#pragma unroll
                for (int i = 0; i < 4; ++i) nx[i] = *(const v4u*)(vr0 + (size_t)(qi + 1) * 4096 + 8 * (lane + 64 * i)); }
            float s = 0.f;
#pragma unroll
            for (int i = 0; i < 32; ++i) s += x[i];
            const float mean = wave_sum(s) * (1.0f / 2048.0f); float s2 = 0.f;
#pragma unroll
            for (int i = 0; i < 32; ++i) { const float d = x[i] - mean; s2 += d * d; }
            const float rstd = 1.0f / sqrtf(wave_sum(s2) * (1.0f / 2048.0f) + EPS);
            const int q = F.wave * 16 + qi;
            if (lane == 0) { st[2 * q] = mean; st[2 * q + 1] = rstd; }
        }
    }
    __syncthreads();
    for (int g = g_lo; g < g_hi; ++g) {
        v4u xin[8];
#pragma unroll
        for (int i = 0; i < 8; ++i) { const int id = tid + 512 * i, q = id >> 5, c0 = (id & 31) * 8; xin[i] = *(const v4u*)(Z + ((size_t)chunk * 128 + q) * 4096 + 2048 + g * 256 + c0); }
#pragma unroll
        for (int i = 0; i < 8; ++i) { const int id = tid + 512 * i, q = id >> 5, c0 = (id & 31) * 8;
            float x[8]; unpack8(xin[i], x);
            const float mean = st[2 * q], rstd = st[2 * q + 1];
            const float* lg = A[I_SG_LNG] + g * 256 + c0; const float* lb = A[I_SG_LNB] + g * 256 + c0;
#pragma unroll
            for (int k = 0; k < 8; ++k) T[q * TS + c0 + k] = (unsigned short)f2bf((x[k] - mean) * rstd * lg[k] + lb[k]); }
        __syncthreads();
#pragma unroll
        for (int i = 0; i < 8; ++i) { const int id = tid + 512 * i, c = id >> 4, q0 = (id & 15) * 8;
            v4u w; w.x = (unsigned)T[(q0 + 0) * TS + c] | ((unsigned)T[(q0 + 1) * TS + c] << 16); w.y = (unsigned)T[(q0 + 2) * TS + c] | ((unsigned)T[(q0 + 3) * TS + c] << 16);
            w.z = (unsigned)T[(q0 + 4) * TS + c] | ((unsigned)T[(q0 + 5) * TS + c] << 16); w.w = (unsigned)T[(q0 + 6) * TS + c] | ((unsigned)T[(q0 + 7) * TS + c] << 16);
            *(v4u*)(VNT + (((size_t)chunk * 8 + g) * 256 + c) * 128 + q0) = w; }
        __syncthreads();
    }
}
__device__ __forceinline__ void sg_ln_phase(Frame& F, const InPtrs& A) {
    constexpr int NCH = MROWS / 128;
    const int full = (NCH / F.G) * F.G;
    for (int chunk = F.vcu; chunk < full; chunk += F.G) sg_ln_item(F, A, chunk, 0, 8);
    for (int it = F.vcu; it < (NCH - full) * 8; it += F.G) sg_ln_item(F, A, full + (it >> 3), it & 7, (it & 7) + 1);
}
__device__ __forceinline__ void topk_phase(Frame& F, int ngroups) {
    const float* AFF = (const float*)(F.ws + WS_AFF); int* SLOT = (int*)(F.ws + WS_SLOT); float* GATE = (float*)(F.ws + WS_GATE);
    int* ROWSRC = (int*)(F.ws + R_XG);
    LAS unsigned* cnt = (LAS unsigned*)F.lds;
    LAS unsigned* cgt = cnt + 16;
    LAS unsigned* ceq = cnt + 80;
    LAS unsigned* tot = cnt + 144;
    LAS int* selrow = (LAS int*)(cnt + 160);
    const int tid = F.tid, lane = F.lane, wave = F.wave;
    for (int task = blockIdx.x; task < ngroups; task += F.G) {
        const bool lat = task < 128; const int gi = lat ? task : task - 128, b = gi >> 4, e = gi & 15;
        const int N = lat ? 4096 : 256, K = lat ? CAP_LAT : CAP_CTX, row0 = lat ? b * 4096 : NLAT + b * 256;
        const int pbase = e * EROWS + (lat ? b * CAP_LAT : NB * CAP_LAT + b * CAP_CTX);
        unsigned key[8]; bool valid[8];
#pragma unroll
        for (int i = 0; i < 8; ++i) { const int t = tid + 512 * i; valid[i] = t < N; key[i] = valid[i] ? __float_as_uint(AFF[(size_t)(row0 + t) * 16 + e]) : 0u; }
        unsigned prefix = 0u;
        for (int bit = 30; bit >= 0; --bit) {
            const unsigned cand = prefix | (1u << bit); unsigned c = 0;
#pragma unroll
            for (int i = 0; i < 8; ++i) c += (unsigned)__builtin_popcountll(__ballot(valid[i] && key[i] >= cand));
            LAS unsigned* cb = cnt + 8 * (bit & 1);
            if (lane == 0) cb[wave] = c;
            __syncthreads();
            unsigned total = 0;
#pragma unroll
            for (int w = 0; w < 8; ++w) total += cb[w];
            if (total >= (unsigned)K) prefix = cand;
        }
        const unsigned T = prefix;
        unsigned long long bgt[8], beq[8];
#pragma unroll
        for (int i = 0; i < 8; ++i) { bgt[i] = __ballot(valid[i] && key[i] > T); beq[i] = __ballot(valid[i] && key[i] == T);
            if (lane == 0) { cgt[i * 8 + wave] = (unsigned)__builtin_popcountll(bgt[i]); ceq[i * 8 + wave] = (unsigned)__builtin_popcountll(beq[i]); } }
        __syncthreads();
        if (wave == 0) {
            unsigned pa = 0u, pq = 0u, ta = 0u, tq = 0u;
            for (int k = 0; k < 64; ++k) { const unsigned a = cgt[k], q = ceq[k]; ta += a; tq += q; if (k < lane) { pa += a; pq += q; } }
            LDS_WAIT();
            cgt[lane] = pa; ceq[lane] = pq;
            if (lane == 63) { tot[0] = ta; tot[1] = tq; }
        }
        __syncthreads();
        const unsigned n_gt = tot[0], need_eq = (unsigned)K - n_gt;
        const unsigned long long lmask = (1ull << lane) - 1ull;
#pragma unroll
        for (int i = 0; i < 8; ++i) {
            const bool isgt = (bgt[i] >> lane) & 1ull, iseq = (beq[i] >> lane) & 1ull;
            const unsigned pg = cgt[i * 8 + wave] + (unsigned)__builtin_popcountll(bgt[i] & lmask), pe = ceq[i * 8 + wave] + (unsigned)__builtin_popcountll(beq[i] & lmask);
            const bool sel = isgt || (iseq && pe < need_eq);
            if (sel) { const unsigned pos = isgt ? pg : n_gt + pe; const int row = row0 + tid + 512 * i;
                SLOT[(size_t)row * 16 + e] = pbase + (int)pos; GATE[pbase + pos] = __uint_as_float(key[i]); ROWSRC[pbase + pos] = row; }
        }
        __syncthreads();
        __syncthreads();
    }
}

template <int DK> __device__ __forceinline__ float att_bound(const float* gq, const float* gk, int n, int lane) {
    float mq = 0.f, mk = 0.f;
    for (int i = lane; i < n; i += 64) { mq = fmaxf(mq, fabsf(gq[i])); mk = fmaxf(mk, fabsf(gk[i])); }
    mq = fmaxf(mq, shx<1>(mq)); mq = fmaxf(mq, shx<2>(mq)); mq = fmaxf(mq, shx<4>(mq)); mq = fmaxf(mq, shx<8>(mq)); mq = fmaxf(mq, shx<16>(mq));
    mk = fmaxf(mk, shx<1>(mk)); mk = fmaxf(mk, shx<2>(mk)); mk = fmaxf(mk, shx<4>(mk)); mk = fmaxf(mk, shx<8>(mk)); mk = fmaxf(mk, shx<16>(mk));
    mq = fmaxf(__builtin_bit_cast(float, __builtin_amdgcn_readlane(__builtin_bit_cast(int, mq), 0)), __builtin_bit_cast(float, __builtin_amdgcn_readlane(__builtin_bit_cast(int, mq), 32)));
    mk = fmaxf(__builtin_bit_cast(float, __builtin_amdgcn_readlane(__builtin_bit_cast(int, mk), 0)), __builtin_bit_cast(float, __builtin_amdgcn_readlane(__builtin_bit_cast(int, mk), 32)));
    const float bound = sqrtf((float)DK) * mq * mk;
    return __builtin_bit_cast(float, __builtin_amdgcn_readfirstlane(__builtin_bit_cast(int, bound)));
}
__device__ __forceinline__ void mla_attn_phase(Frame& F, const InPtrs& A, int jl, bool do_ctx, int conv_layer) {
    int cround = 0;
    const bf16* QPRE = (const bf16*)(F.ws + R_QPRE); const float* RQ = (const float*)(F.ws + WS_RQ); const bf16* MK = (const bf16*)(F.ws + R_MK); const bf16* MV = (const bf16*)(F.ws + R_MV);
    bf16* AO = (bf16*)(F.ws + R_AO);
    const float* gq = A[I_MLA_QN] + jl * 96; const float* ropeA = (const float*)(F.ws + WS_ROPEA);
    const float bound = att_bound<96>(gq, A[I_MLA_KN] + jl * 96, 96, F.lane);
    const bool use_off = bound > 60.0f;
    const int nunits = 2048 + (do_ctx ? 128 : 0);
    for (int u = F.vcu; u < nunits; u += F.G) {
        const bool lat = u < 2048; const int bh = lat ? (u >> 4) : (u - 2048), qb = lat ? (u & 15) : 0, b = bh >> 4, h = bh & 15;
        const int row0 = lat ? b * 4096 + qb * 256 : NLAT + b * 256;
        const att::QLoadMLA QL{QPRE + (size_t)row0 * 1536 + h * 96, RQ + row0, gq, lat ? ropeA + (size_t)(qb * 256) * 16 : nullptr};
        const bf16* Kp = MK + (size_t)bh * NKEYS * 96; const bf16* Vp = MV + (size_t)bh * NKEYS * 64;
        bf16* Op = AO + (size_t)row0 * 1024 + h * 64;
        if (!use_off) att::body_dma<96, 64, false>(QL, Kp, Kp + 256 * 96, 96, Vp, Vp + 256 * 64, 64, Op, 1024, lat ? NKEYS : 256, 0.f, (char*)F.lds, F.tid);
        else { int bi_ = __builtin_amdgcn_readfirstlane(__builtin_bit_cast(int, bound)); asm volatile("" : "+s"(bi_)); const float nm_ = -fminf(__builtin_bit_cast(float, bi_), 30.0f) * 1.4426950408889634f;     att::body<96, 64, 2, true>(QL, Kp, Kp + 256 * 96, 96, Vp, Vp + 256 * 64, 64, Op, 1024, lat ? NKEYS : 256, nm_, (char*)F.lds, F.tid); }
        if (conv_layer >= 0 && cround < conv_rounds(F)) { moe_weight_round(F, A, conv_layer, cround); ++cround; __syncthreads(); }
    }
    if (conv_layer >= 0) for (; cround < conv_rounds(F); ++cround) moe_weight_round(F, A, conv_layer, cround);
}
__device__ __forceinline__ void diff_attn_phase(Frame& F, const InPtrs& A, bool do_ctx, int conv_layer) {
    int cround = 0;
    const bf16* DQ = (const bf16*)(F.ws + R_DQ); const bf16* DQC = (const bf16*)(F.ws + R_DQC); const bf16* DKp = (const bf16*)(F.ws + R_DK); const bf16* QKV = (const bf16*)(F.ws + R_QKV);
    bf16* OB = (bf16*)(F.ws + R_OB);
    const float bound = att_bound<64>(A[I_DF_QN], A[I_DF_KN], 64, F.lane);
    const bool use_off = bound > 60.0f;
    const int nunits = 2048 + (do_ctx ? 128 : 0);
    for (int u = F.vcu; u < nunits; u += F.G) {
        const bool lat = u < 2048; const int bh = lat ? (u >> 4) : (u - 2048), qb = lat ? (u & 15) : 0, b = bh >> 4, vh = bh & 15, h = vh >> 1;
        const bf16* Qp = lat ? DQ + ((size_t)bh * 4096 + qb * 256) * 64 : DQC + (size_t)bh * 256 * 64;
        const bf16* Kp = DKp + (size_t)bh * NKEYS * 64;
        const bf16* V0 = QKV + (size_t)(NLAT + b * 256) * 3072 + 2048 + h * 128; const bf16* V1 = QKV + (size_t)(b * 4096) * 3072 + 2048 + h * 128;
        bf16* Op = OB + (size_t)(lat ? b * 4096 + qb * 256 : NLAT + b * 256) * 2048 + vh * 128;
        const att::QLoadPlain QL{Qp, 64};
        if (!use_off) att::body_dma<64, 128, false>(QL, Kp, Kp + 256 * 64, 64, V0, V1, 3072, Op, 2048, lat ? NKEYS : 256, 0.f, (char*)F.lds, F.tid);
        else { int bi_ = __builtin_amdgcn_readfirstlane(__builtin_bit_cast(int, bound)); asm volatile("" : "+s"(bi_)); const float nm_ = -fminf(__builtin_bit_cast(float, bi_), 30.0f) * 1.4426950408889634f;     att::body<64, 128, 1, true>(QL, Kp, Kp + 256 * 64, 64, V0, V1, 3072, Op, 2048, lat ? NKEYS : 256, nm_, (char*)F.lds, F.tid); }
        if (conv_layer >= 0 && cround < conv_rounds(F)) { moe_weight_round(F, A, conv_layer, cround); ++cround; __syncthreads(); }
    }
    if (conv_layer >= 0) for (; cround < conv_rounds(F); ++cround) moe_weight_round(F, A, conv_layer, cround);
}

#ifndef PG8_SP2
#define PG8_SP2 true
#endif
#ifndef PG8_ALIGN
#define PG8_ALIGN true
#endif
#define GEMM_CALL(EPI, ORD, g, S, E) pg8::gemm_phase<EPI, ORD, PG8_ALIGN, PG8_SP2>(F.lds, g, S, E, F.tid)

__global__ void __launch_bounds__(NTHREADS, 2) fwd_kernel(Args args) {
    extern __shared__ __attribute__((aligned(16))) unsigned char lds[];
    Frame FM;
    FM.lds = (LAS unsigned char*)lds;
    FM.tid = threadIdx.x; FM.lane = FM.tid & 63; FM.wave = __builtin_amdgcn_readfirstlane(FM.tid >> 6);
    FM.G = gridDim.x; { const int bx = blockIdx.x; FM.vcu = (FM.G % 8 == 0) ? (bx % 8) * (FM.G / 8) + bx / 8 : bx; }
    FM.ws = args.ws; FM.out = args.out;
    volatile LAS unsigned* MISC = (volatile LAS unsigned*)(FM.lds + MISC_OFF);
    if (FM.tid < 16) MISC[FM.tid] = 0u;
    if (FM.tid < 35) { const unsigned long long p = (unsigned long long)args.in[FM.tid]; MISC[16 + 2 * FM.tid] = (unsigned)p; MISC[17 + 2 * FM.tid] = (unsigned)(p >> 32); }
    __syncthreads();
    InPtrs A; A.tab = MISC + 16;
    XcdBarrier bar = xcd_barrier_post((unsigned*)(FM.ws + WS_CTL) + 4096, MISC + 8); bar.wave = FM.wave;
    const int lo = args.ph_lo, hi = args.ph_hi;
    int ph = 0;
#ifndef PHASE_MASK
#define PHASE_MASK 0xFFFFFFFFu
#endif
#define EN(b) ((PHASE_MASK >> (b)) & 1u)
#ifndef REP_MASK
#define REP_MASK 0u
#endif
#ifndef BAR_REP
#define BAR_REP 1
#endif
#define REPN(b) (((REP_MASK >> (b)) & 1u) ? 2 : 1)
#define PH_BEGIN if (ph >= lo && ph < hi) { Frame F = FM; { int t_ = FM.wave * 64 + hw_lane(); asm volatile("" : "+v"(t_)); F.tid = t_; F.lane = t_ & 63; F.wave = __builtin_amdgcn_readfirstlane(t_ >> 6); \
        size_t z_ = 0; asm volatile("" : "+s"(z_), "+s"(F.vcu), "+s"(F.G)); F.ws = FM.ws + z_; F.out = FM.out + z_; } \
        const float* MOD = (const float*)(F.ws + WS_MOD); bf16* H = (bf16*)(F.ws + WS_H); (void)MOD; (void)H;
#define PH_END   if (ph + 1 < hi) { for (int br_ = 0; br_ < BAR_REP; ++br_) xcd_barrier(bar); } } ++ph;

    PH_BEGIN for (int rep_ = 0; rep_ < REPN(0); ++rep_) if (EN(0)) p0_prologue(F, A); PH_END

    for (int layer = 0; layer < DEPTH; ++layer) {
        const int kind = layer % 3, jl = layer / 3;
        const bool last = layer == DEPTH - 1, ctx_out = !last;
        const int rows_out = ctx_out ? MROWS : NLAT;

        PH_BEGIN for (int rep_ = 0; rep_ < REPN(1); ++rep_) if (EN(1)) { if (layer == 0 && rep_ == 0) norm_phase<false, true>(F, A, layer, false, MROWS); else norm_phase<false, false>(F, A, layer, layer > 0, MROWS, rep_ == 0 ? 1.0f : 0.0f); } PH_END

        if (kind == 0) {
            const size_t wboff = WS_WNM + jl * MLA_W_STRIDE;
#define wb (F.ws + wboff)
            PH_BEGIN for (int rep_ = 0; rep_ < REPN(2); ++rep_) if (EN(2)) { pg8::Gemm g{H, (const bf16*)(wb + MLA_WIN), MROWS, 1024, 1024}; pg8::StaticOrder S; S.init(MROWS, 1024, F.G, (int)blockIdx.x);
                pg8::EpiStore<0> E{(bf16*)(F.ws + R_DOWN), 1024}; GEMM_CALL(pg8::EpiStore<0>, pg8::StaticOrder, g, S, E); } PH_END
            PH_BEGIN for (int rep_ = 0; rep_ < REPN(2); ++rep_) if (EN(2)) { { pg8::Gemm g{(const bf16*)(F.ws + R_DOWN), (const bf16*)(wb + MLA_WUQ), rows_out, 1536, 512, 1024}; pg8::StaticOrder S; S.init(rows_out, 1536, F.G, (int)blockIdx.x);
                         pg8::EpiStore<0> E{(bf16*)(F.ws + R_QPRE), 1536}; GEMM_CALL(pg8::EpiStore<0>, pg8::StaticOrder, g, S, E); }
                       __syncthreads();
                       { pg8::Gemm g{(const bf16*)(F.ws + R_DOWN) + 512, (const bf16*)(wb + MLA_WUKV), MROWS, 2048, 256, 1024}; pg8::StaticOrder S;
                         const int r1_ = ((rows_out / 256) * 6) % F.G; S.init(MROWS, 2048, F.G, (F.G % 8 == 0 && r1_ % 8 == 0) ? ((int)blockIdx.x + F.G - r1_) % F.G : (int)blockIdx.x);
                         pg8::EpiStore<0> E{(bf16*)(F.ws + R_KVPRE), 2048}; GEMM_CALL(pg8::EpiStore<0>, pg8::StaticOrder, g, S, E); } } PH_END
            PH_BEGIN for (int rep_ = 0; rep_ < REPN(3); ++rep_) if (EN(3)) mla_finish_phase(F, A, jl); PH_END
            PH_BEGIN for (int rep_ = 0; rep_ < REPN(4); ++rep_) if (EN(4)) mla_attn_phase(F, A, jl, ctx_out, (EN(15) && rep_ == 0) ? layer : -1); PH_END
            PH_BEGIN for (int rep_ = 0; rep_ < REPN(14); ++rep_) if (EN(14)) { pg8::Gemm g{(const bf16*)(F.ws + R_AO), (const bf16*)(wb + MLA_WOUT), rows_out, 1024, 1024}; pg8::StaticOrder S; S.init(rows_out, 1024, F.G, (int)blockIdx.x);
                pg8::EpiResid E{(bf16*)(F.ws + WS_XB), MOD + (size_t)layer * 9 * 6144 + 2048, rep_ == 0 ? 1.0f : 0.0f}; GEMM_CALL(pg8::EpiResid, pg8::StaticOrder, g, S, E); } PH_END
#undef wb
        } else if (kind == 1) {
            PH_BEGIN for (int rep_ = 0; rep_ < REPN(12); ++rep_) if (EN(12)) { pg8::Gemm g{H, (const bf16*)(F.ws + WS_DIFF_WIN), MROWS, 3072, 1024}; pg8::StaticOrder S; S.init(MROWS, 3072, F.G, (int)blockIdx.x);
                pg8::EpiStore<0> E{(bf16*)(F.ws + R_QKV), 3072}; GEMM_CALL(pg8::EpiStore<0>, pg8::StaticOrder, g, S, E); } PH_END
            PH_BEGIN for (int rep_ = 0; rep_ < REPN(5); ++rep_) if (EN(5)) diff_finish_qk_phase(F, A); PH_END
            PH_BEGIN for (int rep_ = 0; rep_ < REPN(6); ++rep_) if (EN(6)) diff_attn_phase(F, A, ctx_out, (EN(15) && rep_ == 0) ? layer : -1); PH_END
            PH_BEGIN for (int rep_ = 0; rep_ < REPN(5); ++rep_) if (EN(5)) diff_finish_o_phase(F, A, 0.8f - 0.6f * expf(-0.3f * (float)layer)); PH_END
            PH_BEGIN for (int rep_ = 0; rep_ < REPN(14); ++rep_) if (EN(14)) { pg8::Gemm g{(const bf16*)(F.ws + R_DAO), (const bf16*)(F.ws + WS_DIFF_WOUT), rows_out, 1024, 1024}; pg8::StaticOrder S; S.init(rows_out, 1024, F.G, (int)blockIdx.x);
                pg8::EpiResid E{(bf16*)(F.ws + WS_XB), MOD + (size_t)layer * 9 * 6144 + 2048, rep_ == 0 ? 1.0f : 0.0f}; GEMM_CALL(pg8::EpiResid, pg8::StaticOrder, g, S, E); } PH_END
        } else {
            PH_BEGIN for (int rep_ = 0; rep_ < REPN(13); ++rep_) if (EN(13)) { pg8::Gemm g{H, (const bf16*)(F.ws + WS_SG_WIN), MROWS, 4096, 1024}; pg8::StaticOrder S; S.init(MROWS, 4096, F.G, (int)blockIdx.x);
                pg8::EpiStore<1> E{(bf16*)(F.ws + R_Z), 4096}; GEMM_CALL(pg8::EpiStore<1>, pg8::StaticOrder, g, S, E); } PH_END
            PH_BEGIN for (int rep_ = 0; rep_ < REPN(7); ++rep_) if (EN(7)) sg_ln_phase(F, A); PH_END
            PH_BEGIN for (int rep_ = 0; rep_ < REPN(13); ++rep_) if (EN(13)) { pg8::Gemm g{(const bf16*)(F.ws + WS_SG_WS), (const bf16*)(F.ws + R_VNT), 2048, 0, 128}; pg8::SpatialOrder S; S.init((MROWS / 128) * 8, F.G, F.vcu);
                pg8::EpiSpatial E{(bf16*)(F.ws + R_UV), (const bf16*)(F.ws + R_Z), A[I_SG_BS]}; GEMM_CALL(pg8::EpiSpatial, pg8::SpatialOrder, g, S, E); } PH_END
            PH_BEGIN for (int rep_ = 0; rep_ < REPN(14); ++rep_) if (EN(14)) { pg8::Gemm g{(const bf16*)(F.ws + R_UV), (const bf16*)(F.ws + WS_SG_WOUT), rows_out, 1024, 2048}; pg8::StaticOrder S; S.init(rows_out, 1024, F.G, (int)blockIdx.x);
                pg8::EpiResid E{(bf16*)(F.ws + WS_XB), MOD + (size_t)layer * 9 * 6144 + 2048, rep_ == 0 ? 1.0f : 0.0f}; GEMM_CALL(pg8::EpiResid, pg8::StaticOrder, g, S, E); } PH_END
        }

        PH_BEGIN { for (int rep_ = 0; rep_ < REPN(8); ++rep_) if (EN(8)) { norm_phase<true, false>(F, A, layer, false, rows_out); __syncthreads(); } for (int rep_ = 0; rep_ < REPN(15); ++rep_) if (EN(15) && kind == 2) { moe_weight_items(F, A, layer); __syncthreads(); } } PH_END
        PH_BEGIN for (int rep_ = 0; rep_ < REPN(9); ++rep_) if (EN(9)) topk_phase(F, ctx_out ? 256 : 128); PH_END
        PH_BEGIN for (int rep_ = 0; rep_ < REPN(10); ++rep_) if (EN(10)) { pg8::Gemm g{H, (const bf16*)(F.ws + WS_WGU), MOE_ROWS, 0, 1024}; pg8::MoeOrder S; S.init(ctx_out ? 17 : 16, 8, F.G, F.vcu);
            pg8::EpiSwiGLU E{(bf16*)(F.ws + R_HID), 8}; pg8::gemm_phase<pg8::EpiSwiGLU, pg8::MoeOrder, PG8_ALIGN, PG8_SP2, true>(F.lds, g, S, E, F.tid, (const int*)(F.ws + R_XG), (LAS int*)(F.lds + RING_BYTES)); } PH_END
        PH_BEGIN for (int rep_ = 0; rep_ < REPN(10); ++rep_) if (EN(10)) { pg8::Gemm g{(const bf16*)(F.ws + R_HID), (const bf16*)(F.ws + WS_WDN), MOE_ROWS, 0, 1024}; pg8::MoeOrder S; S.init(ctx_out ? 17 : 16, 4, F.G, F.vcu);
            pg8::EpiMoeDown E{(bf16*)(F.ws + R_YB), (const float*)(F.ws + WS_GATE)}; GEMM_CALL(pg8::EpiMoeDown, pg8::MoeOrder, g, S, E); } PH_END
    }
    PH_BEGIN for (int rep_ = 0; rep_ < REPN(11); ++rep_) if (EN(11)) final_phase(F, DEPTH - 1); PH_END
#undef PH_BEGIN
#undef PH_END
}
constexpr int N_PHASES = 1 + (1 + 5 + 4) + (1 + 5 + 4) + (1 + 4 + 4) + (1 + 5 + 4) + 1;

extern "C" void kernel_launch(void* const* d_in, const int* in_sizes, int n_in, void* d_out, int out_size, void* d_ws, size_t ws_size, hipStream_t stream) {
    static int grid = 0;
    if (grid == 0) {
        if (n_in != 35 || in_sizes[0] != NLAT * D || out_size != NLAT * D || ws_size < WS_END) {
            fprintf(stderr, "kernel_launch: unexpected shapes: n_in %d in0 %d out %d ws %zu (need >= %zu); nothing launched\n", n_in, n_in > 0 ? in_sizes[0] : -1, out_size, ws_size, (size_t)WS_END); grid = -1; return; }
        int dev = 0, cus = 0, per_cu = 0;
        if (hipGetDevice(&dev) != hipSuccess || hipDeviceGetAttribute(&cus, hipDeviceAttributeMultiprocessorCount, dev) != hipSuccess) { fprintf(stderr, "kernel_launch: device query failed\n"); grid = -1; return; }
        if (hipFuncSetAttribute((const void*)fwd_kernel, hipFuncAttributeMaxDynamicSharedMemorySize, LDS_BYTES) != hipSuccess) { fprintf(stderr, "kernel_launch: hipFuncSetAttribute failed\n"); grid = -1; return; }
        if (hipOccupancyMaxActiveBlocksPerMultiprocessor(&per_cu, (const void*)fwd_kernel, NTHREADS, LDS_BYTES) != hipSuccess || per_cu < 1)
            fprintf(stderr, "kernel_launch: note: occupancy query reports %d workgroups per CU\n", per_cu);
        (void)hipGetLastError();
        grid = cus;
    }
    if (grid < 0) return;
    if (hipMemsetAsync((char*)d_ws + WS_CTL, 0, CTL_ZERO_BYTES, stream) != hipSuccess) { fprintf(stderr, "kernel_launch: memset failed\n"); return; }
    Args a{};
    for (int i = 0; i < 35; ++i) a.in[i] = (const float*)d_in[i];
    a.out = (float*)d_out; a.ws = (unsigned char*)d_ws;
#if MK_PER_PHASE
    for (int p = 0; p < N_PHASES; ++p) { a.ph_lo = p; a.ph_hi = p + 1; hipLaunchKernelGGL(fwd_kernel, dim3(grid), dim3(NTHREADS), LDS_BYTES, stream, a); }
#else
    a.ph_lo = 0; a.ph_hi = N_PHASES;
    hipLaunchKernelGGL(fwd_kernel, dim3(grid), dim3(NTHREADS), LDS_BYTES, stream, a);
#endif
    const hipError_t le = hipPeekAtLastError();
    if (le != hipSuccess) fprintf(stderr, "kernel_launch: launch failed: %s\n", hipGetErrorName(le));
}
```

```cpp
#include <type_traits>
#include <hip/hip_runtime.h>
#include <cstdio>
#include <cstdint>

#ifndef MK_PER_PHASE
#define MK_PER_PHASE 0
#endif

constexpr int D = 1024, NB = 8, SEQ = 4096, CTXL = 256, NLAT = NB * SEQ, NCTX = NB * CTXL, MROWS = NLAT + NCTX;
constexpr int NKEYS = CTXL + SEQ;
constexpr int NE = 16, CAP_LAT = 512, CAP_CTX = 32, EROWS = NB * CAP_LAT + NB * CAP_CTX, MOE_ROWS = NE * EROWS;
constexpr int DEPTH = 4;
constexpr float EPS = 1e-6f;
constexpr int NWAVES = 8, NTHREADS = 512;

constexpr size_t MiB = 1u << 20;
constexpr size_t WS_CTL = 0, CTL_ZERO_BYTES = 1 * MiB;
constexpr size_t WS_MOD = 1 * MiB;
constexpr size_t WS_ROPEA = 2 * MiB;
constexpr size_t WS_ROPEB = 2 * MiB + 512 * 1024;
constexpr size_t WS_WNM = 4 * MiB;
constexpr size_t MLA_W_STRIDE = 7 * MiB, MLA_WIN = 0, MLA_WUQ = 2 * MiB, MLA_WUKV = 3 * MiB + 512 * 1024, MLA_WOUT = 4 * MiB + 512 * 1024;
constexpr size_t WS_DIFF_WIN = 18 * MiB, WS_DIFF_WOUT = 24 * MiB;
constexpr size_t WS_SG_WIN = 26 * MiB, WS_SG_WOUT = 34 * MiB, WS_SG_WS = 38 * MiB;
constexpr size_t WS_WGU = 40 * MiB, WS_WDN = 104 * MiB;
constexpr size_t WS_XCTX = 136 * MiB;
constexpr size_t WS_H = 144 * MiB;
constexpr size_t WS_AFF = 212 * MiB;
constexpr size_t WS_SLOT = 215 * MiB;
constexpr size_t WS_GATE = 218 * MiB;
constexpr size_t WS_RQ = 219 * MiB;
constexpr size_t WS_R = 220 * MiB;
constexpr size_t WS_XB = WS_R + 640 * MiB;
constexpr size_t WS_END = WS_XB + 68 * MiB;
constexpr size_t R_DOWN = WS_R, R_CQN = WS_R + 68 * MiB, R_CKVN = WS_R + 102 * MiB, R_QPRE = WS_R + 120 * MiB, R_KVPRE = WS_R + 222 * MiB;
constexpr size_t R_MQ = WS_R + 358 * MiB, R_MQC = WS_R + 454 * MiB, R_MK = WS_R + 460 * MiB, R_MV = WS_R + 562 * MiB, R_AO = WS_R;
constexpr size_t R_QKV = WS_R, R_DQ = WS_R + 204 * MiB, R_DQC = WS_R + 268 * MiB, R_DK = WS_R + 272 * MiB, R_OB = WS_R + 340 * MiB, R_DAO = WS_R + 476 * MiB;
constexpr size_t R_Z = WS_R, R_VNT = WS_R + 272 * MiB, R_UV = WS_R + 408 * MiB;
constexpr size_t R_XG = WS_R, R_HID = WS_R + 136 * MiB, R_YB = WS_R + 272 * MiB;

constexpr int RING_BYTES = 131072;
constexpr int LDS_BYTES = 147456;
constexpr int MISC_OFF = LDS_BYTES - 512;

#define GAS __attribute__((address_space(1)))
#define LAS __attribute__((address_space(3)))
typedef unsigned short bf16;
typedef unsigned v4u __attribute__((ext_vector_type(4)));
typedef unsigned v2u __attribute__((ext_vector_type(2)));
typedef float f32x4 __attribute__((ext_vector_type(4)));
typedef float f32x2 __attribute__((ext_vector_type(2)));
typedef GAS unsigned gu32;
#define RLX_AGENT __ATOMIC_RELAXED, __HIP_MEMORY_SCOPE_AGENT
#define LDS_WAIT() asm volatile("s_waitcnt lgkmcnt(0)" ::: "memory")
#define VM_WAIT() asm volatile("s_waitcnt vmcnt(0)" ::: "memory")
__device__ __forceinline__ unsigned f2bf(float f) { unsigned u = __builtin_bit_cast(unsigned, f); return (u + 0x7fffu + ((u >> 16) & 1u)) >> 16; }
__device__ __forceinline__ unsigned pk2(float lo, float hi) { return f2bf(lo) | (f2bf(hi) << 16); }
__device__ __forceinline__ float bflo(unsigned w) { return __builtin_bit_cast(float, w << 16); }
__device__ __forceinline__ float bfhi(unsigned w) { return __builtin_bit_cast(float, w & 0xffff0000u); }
template <int M> __device__ __forceinline__ float shx(float v) {
    static_assert(M == 1 || M == 2 || M == 4 || M == 8 || M == 16, "shx: xor mask inside a 32-lane group");
    return __builtin_bit_cast(float, __builtin_amdgcn_ds_swizzle(__builtin_bit_cast(int, v), (M << 10) | 0x1f));
}
__device__ __forceinline__ float wave_sum(float v) {
    v += shx<1>(v); v += shx<2>(v); v += shx<4>(v); v += shx<8>(v); v += shx<16>(v);
    const unsigned a = __builtin_bit_cast(unsigned, v);
    const auto rr = __builtin_amdgcn_permlane32_swap(a, a, false, false);
    const unsigned r0 = rr[0], r1 = rr[1];
    return __uint_as_float(r0) + __uint_as_float(r1);
}
__device__ __forceinline__ int hw_lane() { int l; asm volatile("v_mbcnt_lo_u32_b32 %0, -1, 0\n\tv_mbcnt_hi_u32_b32 %0, -1, %0" : "=v"(l)); return l; }
__device__ __forceinline__ float fast_rcp(float x) { return __builtin_amdgcn_rcpf(x); }
__device__ __forceinline__ float silu_f(float x) { return x * fast_rcp(1.0f + __builtin_amdgcn_exp2f(-1.4426950408889634f * x)); }
__device__ __forceinline__ float gelu_tanh_f(float x) { const float u2 = 1.5957691216057308f * (x + 0.044715f * x * x * x); return x * fast_rcp(1.0f + __builtin_amdgcn_exp2f(-1.4426950408889634f * u2)); }

namespace pg8 {
#define PG8_LAS __attribute__((address_space(3)))
typedef unsigned short bf16_t;
typedef short bf16x8 __attribute__((ext_vector_type(8)));
typedef float f32x4 __attribute__((ext_vector_type(4)));
typedef unsigned u32x4 __attribute__((ext_vector_type(4)));
constexpr int BM = 256, BK = 64, HALF = 128, HTB = HALF * BK * 2  , STAGE_BYTES = 8 * HTB, NXCD = 8, WGM = 8;

__host__ __device__ __forceinline__ int lds_byte(int r, int c) { const int st = (r >> 4) * 2 + (c >> 5), rr = r & 15, cc = c & 31, ob = rr * 64 + cc * 2; return st * 1024 + (ob ^ (((ob >> 9) & 1) << 5)); }
__host__ __device__ __forceinline__ void stage_rc(int b, int& R, int& C) { const int st = b / 1024, sb = b % 1024, swz = sb ^ (((sb >> 9) & 1) << 5); R = (st >> 1) * 16 + swz / 64; C = (st & 1) * 32 + (swz % 64) / 2; }
__host__ __device__ __forceinline__ int perm32(int rho) { const int n = rho >> 4, i = rho & 15; return 8 * (i >> 2) + 4 * n + (i & 3); }

struct Unit { int pm, pn; };
struct Gemm { const bf16_t* A; const bf16_t* Bt; int M, N, K; int lda = 0; };

struct StaticOrder {
    int nM, nN, nwg, G, c;
    __host__ __device__ void init(int M, int N, int G_, int c_) { nM = M / BM; nN = N / BM; nwg = nM * nN; G = G_; c = c_; }
    __host__ __device__ bool next(int i, Unit& u) const {
        const long L = (long)i * G + c; if (L >= nwg) return false;
        int wgid = (int)L; { const int q = nwg / NXCD, r = nwg % NXCD, xcd = wgid % NXCD, off = wgid / NXCD; wgid = (xcd < r ? xcd * (q + 1) : r * (q + 1) + (xcd - r) * q) + off; }
        const int nig = WGM * nN, gid = wgid / nig, fm = gid * WGM, gsz = (nM - fm) < WGM ? (nM - fm) : WGM;
        u.pm = fm + ((wgid % nig) % gsz); u.pn = (wgid % nig) / gsz; return true;
    }
    __device__ __forceinline__ void a_ready(const Unit&) const {}
    __device__ __forceinline__ void done(const Unit&) const {}
};

__device__ __forceinline__ unsigned cvt_pk_bf16(float lo, float hi) { unsigned r; asm volatile("v_cvt_pk_bf16_f32 %0, %1, %2" : "=v"(r) : "v"(lo), "v"(hi)); return r; }
typedef float f32x2 __attribute__((ext_vector_type(2)));

template <int ACT> struct EpiStore {
    static constexpr bool PERM = true, AFTER_DRAIN = false;
    bf16_t* O; int ldc;
    __device__ __forceinline__ void operator()(const f32x4 (&acc)[2][2][4][2], const Unit& u, int wr, int wc, int fr, int fq) const {
        const int row0 = u.pm * BM + wr * 64 + fr, col0 = u.pn * BM + wc * 32 + 8 * fq;
#pragma unroll
        for (int ai = 0; ai < 2; ++ai)
#pragma unroll
            for (int m = 0; m < 4; ++m) { bf16_t* rowp = O + (size_t)(row0 + ai * HALF + m * 16) * ldc + col0;
#pragma unroll
                for (int bj = 0; bj < 2; ++bj) { f32x4 v0 = acc[ai][bj][m][0], v1 = acc[ai][bj][m][1];
                    if (ACT == 1) {
#pragma unroll
                        for (int i = 0; i < 4; ++i) { v0[i] = gelu_tanh_f(v0[i]); v1[i] = gelu_tanh_f(v1[i]); } }
                    u32x4 w; w.x = cvt_pk_bf16(v0[0], v0[1]); w.y = cvt_pk_bf16(v0[2], v0[3]); w.z = cvt_pk_bf16(v1[0], v1[1]); w.w = cvt_pk_bf16(v1[2], v1[3]);
                    *(u32x4*)(rowp + bj * HALF) = w; } }
    }
};
struct EpiResid {
    static constexpr bool PERM = true, AFTER_DRAIN = false;
    bf16_t* xb; const float* gmod; float mul;
    __device__ __forceinline__ void operator()(const f32x4 (&acc)[2][2][4][2], const Unit& u, int wr, int wc, int fr, int fq) const {
        const int rr = u.pm < 128 ? (u.pm >> 4) : 8;
        bf16_t* xbase = xb + (size_t)u.pm * BM * 1024;
        const int col0 = u.pn * BM + wc * 32 + 8 * fq;
        f32x4 gv[2][2];
#pragma unroll
        for (int bj = 0; bj < 2; ++bj)
#pragma unroll
            for (int n = 0; n < 2; ++n) gv[bj][n] = *(const f32x4*)(gmod + rr * 6144 + col0 + bj * HALF + 4 * n) * mul;
#pragma unroll
        for (int ai = 0; ai < 2; ++ai)
#pragma unroll
            for (int m = 0; m < 4; ++m) { bf16_t* rowp = xbase + (size_t)(ai * HALF + wr * 64 + m * 16 + fr) * 1024 + col0;
#pragma unroll
                for (int bj = 0; bj < 2; ++bj) { u32x4* p = (u32x4*)(rowp + bj * HALF); const u32x4 w = *p;
                    const f32x4 x0 = (f32x4){__builtin_bit_cast(float, w.x << 16), __builtin_bit_cast(float, w.x & 0xffff0000u), __builtin_bit_cast(float, w.y << 16), __builtin_bit_cast(float, w.y & 0xffff0000u)};
                    const f32x4 x1 = (f32x4){__builtin_bit_cast(float, w.z << 16), __builtin_bit_cast(float, w.z & 0xffff0000u), __builtin_bit_cast(float, w.w << 16), __builtin_bit_cast(float, w.w & 0xffff0000u)};
                    const f32x4 o0 = x0 + gv[bj][0] * acc[ai][bj][m][0], o1 = x1 + gv[bj][1] * acc[ai][bj][m][1];
                    u32x4 r; r.x = cvt_pk_bf16(o0[0], o0[1]); r.y = cvt_pk_bf16(o0[2], o0[3]); r.z = cvt_pk_bf16(o1[0], o1[1]); r.w = cvt_pk_bf16(o1[2], o1[3]); *p = r; } }
    }
};
struct EpiSwiGLU {
    static constexpr bool PERM = true, AFTER_DRAIN = false;
    bf16_t* O; int nct;
    __device__ __forceinline__ void operator()(const f32x4 (&acc)[2][2][4][2], const Unit& u, int wr, int wc, int fr, int fq) const {
        const int row0 = u.pm * BM + wr * 64 + fr, col0 = (u.pn % nct) * HALF + wc * 32 + 8 * fq;
#pragma unroll
        for (int ai = 0; ai < 2; ++ai)
#pragma unroll
            for (int m = 0; m < 4; ++m) { bf16_t* rowp = O + (size_t)(row0 + ai * HALF + m * 16) * 1024 + col0;
                f32x4 v0, v1;
#pragma unroll
                for (int i = 0; i < 4; ++i) { v0[i] = silu_f(acc[ai][0][m][0][i]) * acc[ai][1][m][0][i]; v1[i] = silu_f(acc[ai][0][m][1][i]) * acc[ai][1][m][1][i]; }
                u32x4 w; w.x = cvt_pk_bf16(v0[0], v0[1]); w.y = cvt_pk_bf16(v0[2], v0[3]); w.z = cvt_pk_bf16(v1[0], v1[1]); w.w = cvt_pk_bf16(v1[2], v1[3]);
                *(u32x4*)rowp = w; }
    }
};
struct EpiMoeDown {
    static constexpr bool PERM = true, AFTER_DRAIN = false;
    bf16_t* O; const float* gate;
    __device__ __forceinline__ void operator()(const f32x4 (&acc)[2][2][4][2], const Unit& u, int wr, int wc, int fr, int fq) const {
        const int row0 = u.pm * BM + wr * 64 + fr, col0 = (u.pn & 3) * BM + wc * 32 + 8 * fq;
#pragma unroll
        for (int ai = 0; ai < 2; ++ai)
#pragma unroll
            for (int m = 0; m < 4; ++m) { const int row = row0 + ai * HALF + m * 16; const float gt = gate[row]; bf16_t* rowp = O + (size_t)row * 1024 + col0;
#pragma unroll
                for (int bj = 0; bj < 2; ++bj) { const f32x4 v0 = acc[ai][bj][m][0] * gt, v1 = acc[ai][bj][m][1] * gt;
                    u32x4 w; w.x = cvt_pk_bf16(v0[0], v0[1]); w.y = cvt_pk_bf16(v0[2], v0[3]); w.z = cvt_pk_bf16(v1[0], v1[1]); w.w = cvt_pk_bf16(v1[2], v1[3]);
                    *(u32x4*)(rowp + bj * HALF) = w; } }
    }
};
struct EpiSpatial {
    static constexpr bool PERM = true, AFTER_DRAIN = false;
    bf16_t* UV; const bf16_t* Z; const float* bs;
    __device__ __forceinline__ void operator()(const f32x4 (&acc)[2][2][4][2], const Unit& u, int wr, int wc, int fr, int fq) const {
        const int g = u.pm, chunk = u.pn >> 3;
#pragma unroll
        for (int m = 0; m < 4; ++m) { const int p = wr * 64 + m * 16 + fr; const float b = bs[g * 128 + p]; const size_t tok = (size_t)chunk * 128 + p;
#pragma unroll
            for (int bj = 0; bj < 2; ++bj) { const int ch = g * 256 + bj * HALF + wc * 32 + 8 * fq;
                const u32x4 uw = *(const u32x4*)(Z + tok * 4096 + ch);
                const f32x4 a0 = acc[0][bj][m][0] + b, a1 = acc[0][bj][m][1] + b;
                u32x4 w;
                w.x = cvt_pk_bf16(a0[0] * __builtin_bit_cast(float, uw.x << 16), a0[1] * __builtin_bit_cast(float, uw.x & 0xffff0000u));
                w.y = cvt_pk_bf16(a0[2] * __builtin_bit_cast(float, uw.y << 16), a0[3] * __builtin_bit_cast(float, uw.y & 0xffff0000u));
                w.z = cvt_pk_bf16(a1[0] * __builtin_bit_cast(float, uw.z << 16), a1[1] * __builtin_bit_cast(float, uw.z & 0xffff0000u));
                w.w = cvt_pk_bf16(a1[2] * __builtin_bit_cast(float, uw.w << 16), a1[3] * __builtin_bit_cast(float, uw.w & 0xffff0000u));
                *(u32x4*)(UV + tok * 2048 + ch) = w; } }
    }
};
struct MoeOrder {
    int nrt, nct, nwg, G, c;
    __device__ void init(int nrt_, int nct_, int G_, int c_) { nrt = nrt_; nct = nct_; nwg = 16 * nrt * nct; G = G_; c = c_; }
    __device__ bool next(int i, Unit& u) const {
        const int L = i * G + c; if (L >= nwg) return false;
        const int per = nrt * nct, e = L / per, r = L % per, j = r / nrt, rt = r % nrt;
        u.pm = e * 17 + rt; u.pn = e * nct + j; return true;
    }
    __device__ __forceinline__ void a_ready(const Unit&) const {}
    __device__ __forceinline__ void done(const Unit&) const {}
};
struct SpatialOrder {
    int nwg, G, c;
    __device__ void init(int nblocks, int G_, int c_) { nwg = nblocks; G = G_; c = c_; }
    __device__ bool next(int i, Unit& u) const { const int L = i * G + c; if (L >= nwg) return false; u.pm = L & 7; u.pn = L; return true; }
    __device__ __forceinline__ void a_ready(const Unit&) const {}
    __device__ __forceinline__ void done(const Unit&) const {}
};
template <class Epi, class Sched, bool ALIGN_EPI = false, bool SP2 = false, bool GATHER = false>
__device__ __forceinline__ void gemm_phase(PG8_LAS unsigned char* lds, const Gemm g, const Sched& S, const Epi& E, int tid_in, const int* rowsrc = nullptr, PG8_LAS int* idx_lds = nullptr) {
    int tid_ = tid_in; asm volatile("" : "+v"(tid_));
    const int tid = tid_, wid = __builtin_amdgcn_readfirstlane(tid >> 6), lane = tid & 63, wr = wid >> 2, wc = wid & 3, fr = lane & 15, fq = lane >> 4;
    const int K = g.K, nt = K / BK, LDA = g.lda ? g.lda : g.K;
    unsigned voffA[2], voffB[2];
#pragma unroll
    for (int i = 0; i < 2; ++i) { int R, C; stage_rc(tid * 16 + i * 8192, R, C); const int Rb = Epi::PERM ? ((R & ~31) + perm32(R & 31)) : R;
        voffA[i] = (unsigned)(R * LDA + C) * 2u; voffB[i] = (unsigned)(Rb * K + C) * 2u; }
    const size_t kstep = (size_t)(BK * 2);
    const size_t hstep = (size_t)HALF * K * 2;
    const size_t tstep = 2 * hstep;
    const size_t hstepA = GATHER ? 0 : (size_t)HALF * LDA * 2, tstepA = 2 * hstepA;
    unsigned gA[2][2], gN[2][2], gS[2][2];
    int gR[2], gC[2];
    if constexpr (GATHER) {
#pragma unroll
        for (int i = 0; i < 2; ++i) { int R, C; stage_rc(tid * 16 + i * 8192, R, C); gR[i] = R; gC[i] = C * 2; }
        Unit u_; for (int i = 0; S.next(i, u_); ++i) if (tid < 256) idx_lds[i * 256 + tid] = rowsrc[u_.pm * BM + tid];
        asm volatile("s_waitcnt vmcnt(0) lgkmcnt(0)" ::: "memory"); __builtin_amdgcn_s_barrier(); asm volatile("" ::: "memory");
    }
#define PG8_GOFF(dst, unit_i) do { _Pragma("unroll") for (int h_ = 0; h_ < 2; ++h_) _Pragma("unroll") for (int i_ = 0; i_ < 2; ++i_) \
        dst[h_][i_] = (unsigned)idx_lds[(unit_i) * 256 + h_ * HALF + gR[i_]] * (unsigned)(LDA * 2) + (unsigned)gC[i_]; } while (0)
#define PG8_OA(h) (GATHER ? gA[h] : voffA)
#define PG8_OS(h) (GATHER ? gS[h] : voffA)
    const unsigned ldsw = (unsigned)wid * 1024u;
    const int aoff = lds_byte(wr * 64 + fr, fq * 8), boff = lds_byte(wc * 32 + fr, fq * 8);
#define PG8_SA(b, h) (((b) * 2 + (h)) * HTB)
#define PG8_SB(b, h) ((4 + (b) * 2 + (h)) * HTB)
#define PG8_STAGE(bufoff, gbase, voff) do { _Pragma("unroll") for (int _i = 0; _i < 2; ++_i) \
        __builtin_amdgcn_global_load_lds((const unsigned*)((const char*)(gbase) + (voff)[_i]), (PG8_LAS unsigned*)(lds + (bufoff) + ldsw + _i * 8192), 16, 0, 0); } while (0)
#define PG8_LDA(dst, b, h) do { _Pragma("unroll") for (int m = 0; m < 4; ++m) _Pragma("unroll") for (int k = 0; k < 2; ++k) dst[m][k] = *(const PG8_LAS bf16x8*)(lds + PG8_SA(b, h) + aoff + m * 2048 + k * 1024); } while (0)
#define PG8_LDB(dst, b, h) do { _Pragma("unroll") for (int n = 0; n < 2; ++n) _Pragma("unroll") for (int k = 0; k < 2; ++k) dst[n][k] = *(const PG8_LAS bf16x8*)(lds + PG8_SB(b, h) + boff + n * 2048 + k * 1024); } while (0)
#define PG8_MMA(ai, bj, At, Bt) do { __builtin_amdgcn_s_setprio(1); _Pragma("unroll") for (int m = 0; m < 4; ++m) _Pragma("unroll") for (int n = 0; n < 2; ++n) _Pragma("unroll") for (int k = 0; k < 2; ++k) \
        acc[ai][bj][m][n] = __builtin_amdgcn_mfma_f32_16x16x32_bf16(Bt[n][k], At[m][k], acc[ai][bj][m][n], 0, 0, 0); __builtin_amdgcn_s_setprio(0); } while (0)
#define PG8_WAIT_V(n) asm volatile("s_waitcnt vmcnt(" #n ")" ::: "memory")
#define PG8_WAIT_L(n) asm volatile("s_waitcnt lgkmcnt(" #n ")" ::: "memory")
#define PG8_BAR __builtin_amdgcn_s_barrier()
#define PG8_SCHED __builtin_amdgcn_sched_barrier(0)
    Unit cur, nxt; int ui = 0;
    if (!S.next(0, cur)) return;
    if constexpr (GATHER) { PG8_GOFF(gA, 0); }
    f32x4 acc[2][2][4][2];
#pragma unroll
    for (int a = 0; a < 2; ++a)
#pragma unroll
        for (int b = 0; b < 2; ++b)
#pragma unroll
            for (int m = 0; m < 4; ++m)
#pragma unroll
                for (int n = 0; n < 2; ++n) acc[a][b][m][n] = (f32x4){0.f, 0.f, 0.f, 0.f};
    bf16x8 At[4][2], B0[2][2], B1[2][2];
    const char* cA = (const char*)g.A + (size_t)cur.pm * tstepA; const char* cB = (const char*)g.Bt + (size_t)cur.pn * tstep;
    S.a_ready(cur);
    if constexpr (SP2) {
        PG8_STAGE(PG8_SB(0, 0), cB, voffB); PG8_STAGE(PG8_SB(0, 1), cB + hstep, voffB); PG8_STAGE(PG8_SA(0, 0), cA, PG8_OA(0)); PG8_STAGE(PG8_SA(0, 1), cA + hstepA, PG8_OA(1));
        if (wr == 1) PG8_BAR;
        PG8_WAIT_V(2); PG8_BAR;
        PG8_STAGE(PG8_SB(1, 0), cB + kstep, voffB); PG8_STAGE(PG8_SA(1, 0), cA + kstep, PG8_OA(0)); PG8_STAGE(PG8_SB(1, 1), cB + hstep + kstep, voffB);
        PG8_WAIT_V(6); PG8_BAR;
    } else {
        PG8_STAGE(PG8_SB(0, 0), cB, voffB); PG8_STAGE(PG8_SA(0, 0), cA, PG8_OA(0)); PG8_STAGE(PG8_SB(0, 1), cB + hstep, voffB); PG8_STAGE(PG8_SA(0, 1), cA + hstepA, PG8_OA(1));
        if (wr == 1) PG8_BAR;
        PG8_WAIT_V(4); PG8_BAR;
        PG8_STAGE(PG8_SB(1, 0), cB + kstep, voffB); PG8_STAGE(PG8_SA(1, 0), cA + kstep, PG8_OA(0)); PG8_STAGE(PG8_SB(1, 1), cB + hstep + kstep, voffB);
        PG8_WAIT_V(6); PG8_BAR;
    }
    for (;;) {
        const bool has_next = S.next(ui + 1, nxt);
        if constexpr (GATHER) { if (has_next) { PG8_GOFF(gN, ui + 1); } else {
#pragma unroll
            for (int h_ = 0; h_ < 2; ++h_) { gN[h_][0] = gA[h_][0]; gN[h_][1] = gA[h_][1]; } } }
        const char* nA = has_next ? (const char*)g.A + (size_t)nxt.pm * tstepA : cA; const char* nB = has_next ? (const char*)g.Bt + (size_t)nxt.pn * tstep : cB;
        for (int t = 0; t < nt; t += 2) {
            const bool last = (t == nt - 2);
            if constexpr (GATHER) {
#pragma unroll
                for (int h_ = 0; h_ < 2; ++h_) { gS[h_][0] = last ? gN[h_][0] : gA[h_][0]; gS[h_][1] = last ? gN[h_][1] : gA[h_][1]; } }
            const char* a1 = cA + (size_t)(t + 1) * kstep;
            const char* a2 = last ? nA : cA + (size_t)(t + 2) * kstep; const char* b2 = last ? nB : cB + (size_t)(t + 2) * kstep;
            const char* a3 = a2 + kstep; const char* b3 = b2 + kstep;
            if (last && has_next) S.a_ready(nxt);
            if constexpr (SP2) {
            PG8_LDB(B0, 0, 0); PG8_LDB(B1, 0, 1); PG8_SCHED; PG8_LDA(At, 0, 0); PG8_STAGE(PG8_SA(1, 1), a1 + hstepA, PG8_OA(1));
            PG8_WAIT_V(8); PG8_WAIT_L(0); PG8_BAR; PG8_MMA(0, 0, At, B0); PG8_MMA(0, 1, At, B1); PG8_BAR; PG8_SCHED;
            PG8_LDA(At, 0, 1); PG8_STAGE(PG8_SB(0, 0), b2, voffB); PG8_STAGE(PG8_SB(0, 1), b2 + hstep, voffB); PG8_STAGE(PG8_SA(0, 0), a2, PG8_OS(0));
            PG8_WAIT_V(8); PG8_WAIT_L(0); PG8_BAR; PG8_MMA(1, 0, At, B0); PG8_MMA(1, 1, At, B1); PG8_BAR; PG8_SCHED;
            PG8_LDB(B0, 1, 0); PG8_LDB(B1, 1, 1); PG8_SCHED; PG8_LDA(At, 1, 0); PG8_STAGE(PG8_SA(0, 1), a2 + hstepA, PG8_OS(1));
            PG8_WAIT_V(8); PG8_WAIT_L(0); PG8_BAR; PG8_MMA(0, 0, At, B0); PG8_MMA(0, 1, At, B1); PG8_BAR; PG8_SCHED;
            PG8_LDA(At, 1, 1); PG8_STAGE(PG8_SB(1, 0), b3, voffB); PG8_STAGE(PG8_SB(1, 1), b3 + hstep, voffB); PG8_STAGE(PG8_SA(1, 0), a3, PG8_OS(0));
            PG8_WAIT_V(8); PG8_WAIT_L(0); PG8_BAR; PG8_MMA(1, 0, At, B0); PG8_MMA(1, 1, At, B1); PG8_BAR; PG8_SCHED;
            } else {
            PG8_LDB(B0, 0, 0); PG8_SCHED; PG8_LDA(At, 0, 0); PG8_STAGE(PG8_SA(1, 1), a1 + hstepA, PG8_OA(1));
            PG8_WAIT_L(8); PG8_BAR; PG8_WAIT_L(0); PG8_MMA(0, 0, At, B0); PG8_BAR; PG8_SCHED;
            PG8_LDB(B1, 0, 1); PG8_STAGE(PG8_SB(0, 0), b2, voffB);
            PG8_BAR; PG8_WAIT_L(0); PG8_MMA(0, 1, At, B1); PG8_BAR;
            PG8_LDA(At, 0, 1); PG8_STAGE(PG8_SA(0, 0), a2, PG8_OS(0));
            PG8_BAR; PG8_WAIT_L(0); PG8_MMA(1, 0, At, B0); PG8_BAR; PG8_SCHED;
            PG8_STAGE(PG8_SB(0, 1), b2 + hstep, voffB);
            PG8_WAIT_V(6); PG8_BAR; PG8_MMA(1, 1, At, B1); PG8_BAR;
            PG8_LDB(B0, 1, 0); PG8_SCHED; PG8_LDA(At, 1, 0); PG8_STAGE(PG8_SA(0, 1), a2 + hstepA, PG8_OS(1));
            PG8_WAIT_L(8); PG8_BAR; PG8_WAIT_L(0); PG8_MMA(0, 0, At, B0); PG8_BAR; PG8_SCHED;
            PG8_LDB(B1, 1, 1); PG8_STAGE(PG8_SB(1, 0), b3, voffB);
            PG8_BAR; PG8_WAIT_L(0); PG8_MMA(0, 1, At, B1); PG8_BAR;
            PG8_LDA(At, 1, 1); PG8_STAGE(PG8_SA(1, 0), a3, PG8_OS(0));
            PG8_BAR; PG8_WAIT_L(0); PG8_MMA(1, 0, At, B0); PG8_BAR; PG8_SCHED;
            PG8_STAGE(PG8_SB(1, 1), b3 + hstep, voffB);
            PG8_WAIT_V(6); PG8_BAR; PG8_MMA(1, 1, At, B1); PG8_BAR;
            }
        }
        if constexpr (ALIGN_EPI) { if (wr == 0) PG8_BAR; }
        if constexpr (!Epi::AFTER_DRAIN) { E(acc, cur, wr, wc, fr, fq); S.done(cur); }
        if (!has_next) break;
#pragma unroll
        for (int a = 0; a < 2; ++a)
#pragma unroll
            for (int b = 0; b < 2; ++b)
#pragma unroll
                for (int m = 0; m < 4; ++m)
#pragma unroll
                    for (int n = 0; n < 2; ++n) acc[a][b][m][n] = (f32x4){0.f, 0.f, 0.f, 0.f};
        cur = nxt; cA = nA; cB = nB; ++ui;
        if constexpr (GATHER) {
#pragma unroll
            for (int h_ = 0; h_ < 2; ++h_) { gA[h_][0] = gN[h_][0]; gA[h_][1] = gN[h_][1]; } }
        if constexpr (ALIGN_EPI) { if (wr == 1) PG8_BAR; }
    }
    PG8_WAIT_V(0);
    if constexpr (!ALIGN_EPI) { if (wr == 0) PG8_BAR; }
    PG8_BAR;
    if constexpr (Epi::AFTER_DRAIN) { E.fused(acc, cur, wr, wc, fr, fq, lds, wid, lane); S.done(cur); }
#undef PG8_SA
#undef PG8_GOFF
#undef PG8_OA
#undef PG8_OS
#undef PG8_SB
#undef PG8_STAGE
#undef PG8_LDA
#undef PG8_LDB
#undef PG8_MMA
#undef PG8_WAIT_V
#undef PG8_WAIT_L
#undef PG8_BAR
#undef PG8_SCHED
}
}

namespace att {
using bf16x8 = __attribute__((ext_vector_type(8))) short;
using s16x4  = __attribute__((ext_vector_type(4))) short;
using f32x16 = __attribute__((ext_vector_type(16))) float;
using u32x4  = __attribute__((ext_vector_type(4))) unsigned;
constexpr int NW = 8, QBLK = 32, KVBLK = 64, KROWB = 256;
constexpr float THR = 8.f;
#define ATT_KSWZ(row, colB) ((row) * 256 + ((colB) ^ (((row) & 7) << 4)))
#define ATT_SBAR() __builtin_amdgcn_sched_barrier(0)
__device__ __forceinline__ int crow(int r, int hi) { return (r & 3) + 8 * (r >> 2) + 4 * hi; }
__device__ __forceinline__ unsigned cvtpk(float lo, float hi) { unsigned r; asm volatile("v_cvt_pk_bf16_f32 %0, %1, %2" : "=v"(r) : "v"(lo), "v"(hi)); return r; }
template <int DK> struct Sc { static constexpr float SCALE = (DK == 96) ? 0.10206207261596575f : 0.125f; static constexpr float C = SCALE * 1.4426950408889634f; };

template <int DK, bool OFF>
__device__ __forceinline__ void partialSM(f32x16& p0, f32x16& p1, float negMC) {
  if constexpr (OFF) {
#pragma unroll
    for (int r = 0; r < 16; ++r) p0[r] += negMC;
#pragma unroll
    for (int r = 0; r < 16; ++r) p1[r] += negMC;
  }
#pragma unroll
  for (int r = 0; r < 16; ++r) p0[r] = __builtin_amdgcn_exp2f(p0[r]);
}
__device__ __forceinline__ void finishSM(f32x16& p0, f32x16& p1, float& l_reg, bf16x8& pa0, bf16x8& pa1, bf16x8& pa2, bf16x8& pa3) {
#pragma unroll
  for (int r = 0; r < 16; ++r) p1[r] = __builtin_amdgcn_exp2f(p1[r]);
  float ps = 0;
#pragma unroll
  for (int r = 0; r < 16; ++r) ps += p0[r];
#pragma unroll
  for (int r = 0; r < 16; ++r) ps += p1[r];
  l_reg += ps;
#define ATT_PK4(P, BASE, OUT) do { unsigned a0 = cvtpk(P[BASE + 0], P[BASE + 1]), a1 = cvtpk(P[BASE + 2], P[BASE + 3]);   \
    unsigned b0 = cvtpk(P[BASE + 4], P[BASE + 5]), b1 = cvtpk(P[BASE + 6], P[BASE + 7]);                              \
    auto r0 = __builtin_amdgcn_permlane32_swap(a0, b0, false, false); auto r1 = __builtin_amdgcn_permlane32_swap(a1, b1, false, false); \
    u32x4 w = {r0[0], r1[0], r0[1], r1[1]}; OUT = *reinterpret_cast<bf16x8*>(&w); } while (0)
  ATT_PK4(p0, 0, pa0); ATT_PK4(p0, 8, pa1); ATT_PK4(p1, 0, pa2); ATT_PK4(p1, 8, pa3);
#undef ATT_PK4
}
template <int DK>
__device__ __forceinline__ void qkt(f32x16& p0, f32x16& p1, const char* Ks, const bf16x8* qr, int r32, int hi) {
  p0 = f32x16{}; p1 = f32x16{};
#pragma unroll
  for (int d0 = 0; d0 < DK / 16; ++d0) { const int cb = (d0 * 16 + hi * 8) * 2;
    const bf16x8 b0 = *reinterpret_cast<const bf16x8*>(Ks + ATT_KSWZ(r32, cb));
    const bf16x8 b1 = *reinterpret_cast<const bf16x8*>(Ks + ATT_KSWZ(32 + r32, cb));
    p0 = __builtin_amdgcn_mfma_f32_32x32x16_bf16(b0, qr[d0], p0, 0, 0, 0);
    p1 = __builtin_amdgcn_mfma_f32_32x32x16_bf16(b1, qr[d0], p1, 0, 0, 0);
  }
}
template <int DV> __device__ __forceinline__ int v_st(int k, int c) { const int kk = (k & ~0xC) | ((k & 4) << 1) | ((k & 8) >> 1); return ((kk >> 3) * (DV / 32) + (c >> 5)) * 512 + ((kk & 7) * 32 + (c & 31)) * 2; }
__device__ __forceinline__ int v_rd_base(int lane) { return ((lane & 3) << 3) | (((lane >> 2) & 3) << 6) | (((lane >> 4) & 1) << 5) | (((lane >> 5) & 1) << 8); }
template <int DV> constexpr int v_rd_off(int d0, int ks, int half) { return d0 * 512 + ks * (2 * (DV / 32) * 512) + half * ((DV / 32) * 512); }
template <int OFF> __device__ __forceinline__ s16x4 tr_read(int vb) {
  s16x4 r; asm volatile("ds_read_b64_tr_b16 %0, %1 offset:%2" : "=&v"(r) : "v"(vb), "i"(OFF) : "memory"); return r;
}
template <int DV, int D0> __device__ __forceinline__ void pv_one(f32x16& od, int vb, bf16x8 pa0, bf16x8 pa1, bf16x8 pa2, bf16x8 pa3) {
  const s16x4 l0 = tr_read<v_rd_off<DV>(D0, 0, 0)>(vb), h0 = tr_read<v_rd_off<DV>(D0, 0, 1)>(vb), l1 = tr_read<v_rd_off<DV>(D0, 1, 0)>(vb), h1 = tr_read<v_rd_off<DV>(D0, 1, 1)>(vb);
  const s16x4 l2 = tr_read<v_rd_off<DV>(D0, 2, 0)>(vb), h2 = tr_read<v_rd_off<DV>(D0, 2, 1)>(vb), l3 = tr_read<v_rd_off<DV>(D0, 3, 0)>(vb), h3 = tr_read<v_rd_off<DV>(D0, 3, 1)>(vb);
  asm volatile("s_waitcnt lgkmcnt(0)" ::: "memory"); ATT_SBAR();
#define ATT_PK(L, H) (bf16x8){L[0], L[1], L[2], L[3], H[0], H[1], H[2], H[3]}
  od = __builtin_amdgcn_mfma_f32_32x32x16_bf16(pa0, ATT_PK(l0, h0), od, 0, 0, 0);
  od = __builtin_amdgcn_mfma_f32_32x32x16_bf16(pa1, ATT_PK(l1, h1), od, 0, 0, 0);
  od = __builtin_amdgcn_mfma_f32_32x32x16_bf16(pa2, ATT_PK(l2, h2), od, 0, 0, 0);
  od = __builtin_amdgcn_mfma_f32_32x32x16_bf16(pa3, ATT_PK(l3, h3), od, 0, 0, 0);
#undef ATT_PK
}
template <int DV> __device__ __forceinline__ void pv_all(f32x16* o, int vb, bf16x8 pa0, bf16x8 pa1, bf16x8 pa2, bf16x8 pa3) {
  pv_one<DV, 0>(o[0], vb, pa0, pa1, pa2, pa3); pv_one<DV, 1>(o[1], vb, pa0, pa1, pa2, pa3);
  if constexpr (DV == 128) { pv_one<DV, 2>(o[2], vb, pa0, pa1, pa2, pa3); pv_one<DV, 3>(o[3], vb, pa0, pa1, pa2, pa3); }
}
__device__ __forceinline__ float half_pair_sum(float v) { const unsigned a = __float_as_uint(v); auto rr = __builtin_amdgcn_permlane32_swap(a, a, false, false); const unsigned r0 = rr[0], r1 = rr[1]; return __uint_as_float(r0) + __uint_as_float(r1); }
__device__ __forceinline__ void unpack_bf8(const bf16x8 w, float* f) {
#pragma unroll
  for (int i = 0; i < 8; ++i) f[i] = __uint_as_float((unsigned)(unsigned short)w[i] << 16); }
__device__ __forceinline__ bf16x8 pack_bf8(const float* f) { u32x4 w = {cvtpk(f[0], f[1]), cvtpk(f[2], f[3]), cvtpk(f[4], f[5]), cvtpk(f[6], f[7])}; return *reinterpret_cast<bf16x8*>(&w); }
struct QLoadMLA {
  const bf16* qpre;
  const float* rq;
  const float* gq;
  const float* cosA;
  __device__ __forceinline__ void load(bf16x8 (&qr)[6], int r, int hi) const {
    const bf16* src = qpre + (long)r * 1536 + hi * 8; float v[6][8]; float ss = 0.f;
#pragma unroll
    for (int d0 = 0; d0 < 6; ++d0) { unpack_bf8(*reinterpret_cast<const bf16x8*>(src + d0 * 16), v[d0]);
#pragma unroll
      for (int j = 0; j < 8; ++j) ss += v[d0][j] * v[d0][j]; }
    ss = half_pair_sum(ss);
    const float rqv = rq[r], f = Sc<96>::C * rqv / sqrtf(rqv * rqv * ss * (1.0f / 96.0f) + EPS);
#pragma unroll
    for (int d0 = 0; d0 < 6; ++d0) { const f32x4 g0 = *(const f32x4*)(gq + d0 * 16 + hi * 8), g1 = *(const f32x4*)(gq + d0 * 16 + hi * 8 + 4);
#pragma unroll
      for (int j = 0; j < 4; ++j) { v[d0][j] *= f * g0[j]; v[d0][4 + j] *= f * g1[j]; } }
    if (cosA) { const float* c = cosA + (long)r * 16 + hi * 8; const float* sn = c + 4096 * 16;
#pragma unroll
      for (int j = 0; j < 8; ++j) { const float x1 = v[4][j], x2 = v[5][j], cs = c[j], si = sn[j]; v[4][j] = x1 * cs - x2 * si; v[5][j] = x1 * si + x2 * cs; } }
#pragma unroll
    for (int d0 = 0; d0 < 6; ++d0) qr[d0] = pack_bf8(v[d0]);
  }
};
struct QLoadPlain {
  const bf16* q; int ldq;
  template <int NQ> __device__ __forceinline__ void load(bf16x8 (&qr)[NQ], int r, int hi) const {
    const bf16* src = q + (long)r * ldq + hi * 8;
#pragma unroll
    for (int d0 = 0; d0 < NQ; ++d0) qr[d0] = *reinterpret_cast<const bf16x8*>(src + d0 * 16);
  }
};
template <int DK, int DV> struct Geo {
  static constexpr int SHM_V = KVBLK * DV * 2, SHM_K = KVBLK * KROWB, SHM = 2 * SHM_V + 2 * SHM_K + NW * 64 * 4;
  static constexpr int KCPR = DK / 8, VCPR = DV / 8;
  static constexpr int NKC = KVBLK * KCPR, NVC = KVBLK * VCPR;
  static constexpr int KN = (NKC + 511) / 512, VN = NVC / 512;
  static_assert(NVC % 512 == 0 && SHM <= 131072, "attention geometry");
};

template <int DK, int DV, int SD, bool OFF, class QLoader>
__device__ __forceinline__ void body(const QLoader& QL, const bf16* __restrict__ K0, const bf16* __restrict__ K1, int ldk,
                                     const bf16* __restrict__ V0, const bf16* __restrict__ V1, int ldv, bf16* __restrict__ Ob, int ldo, int nkeys, float negMC, char* lds, int tid_in) {
  using G = Geo<DK, DV>;
  constexpr int SHM_V = G::SHM_V, SHM_K = G::SHM_K, KN = G::KN, VN = G::VN, ND = DV / 32;
  int tid_ = tid_in; asm volatile("" : "+v"(tid_));
  const int tid = tid_, wid = tid >> 6, lane = tid & 63, r32 = lane & 31, hi = lane >> 5;
  char* V_lds = lds; char* K_lds = lds + 2 * SHM_V;
  float* ws = (float*)(lds + 2 * SHM_V + 2 * SHM_K) + wid * 64; float* li_l = ws;
  float l_reg = 0; f32x16 o[ND];
#pragma unroll
  for (int d = 0; d < ND; ++d) o[d] = f32x16{};
  bf16x8 qr[DK / 16];
  QL.load(qr, wid * QBLK + r32, hi);
  int kofs[KN], kdst[KN], vofs[VN], vdst[VN];
#pragma unroll
  for (int i = 0; i < KN; ++i) { const int c = tid + 512 * i, row = (c / G::KCPR) & 63, col = (c % G::KCPR) * 8; kofs[i] = (row * ldk + col) * 2; kdst[i] = ATT_KSWZ(row, col * 2); }
#pragma unroll
  for (int i = 0; i < VN; ++i) { const int c = tid + 512 * i, row = c / G::VCPR, col = (c % G::VCPR) * 8; vofs[i] = (row * ldv + col) * 2; vdst[i] = v_st<DV>(row, col); }
  const bool k_last_ok = (tid + 512 * (KN - 1)) < G::NKC;
  const int vb0 = (int)(uintptr_t)V_lds + v_rd_base(lane);
  struct Slot { bf16x8 k[KN], v[VN]; } sr_[SD];
#define ATT_TBASE(k0, ld, P0, P1) (((k0) < 256) ? ((P0) + (long)(k0) * (ld)) : ((P1) + (long)((k0) - 256) * (ld)))
#define ATT_LD(base, ofs) (*reinterpret_cast<const bf16x8*>((const char*)(base) + (unsigned)(ofs)))
#define ATT_SLOAD(i, k0) do { const bf16* vb_ = ATT_TBASE(k0, ldv, V0, V1); const bf16* kb_ = ATT_TBASE(k0, ldk, K0, K1); \
    _Pragma("unroll") for (int _s = 0; _s < VN; ++_s) sr_[i].v[_s] = ATT_LD(vb_, vofs[_s]); \
    _Pragma("unroll") for (int _s = 0; _s < KN; ++_s) if (_s < KN - 1 || k_last_ok) sr_[i].k[_s] = ATT_LD(kb_, kofs[_s]); } while (0)
#define ATT_SWRITE(b, i) do { \
    _Pragma("unroll") for (int _s = 0; _s < VN; ++_s) *reinterpret_cast<bf16x8*>(V_lds + (b) * SHM_V + vdst[_s]) = sr_[i].v[_s]; \
    _Pragma("unroll") for (int _s = 0; _s < KN; ++_s) if (_s < KN - 1 || k_last_ok) *reinterpret_cast<bf16x8*>(K_lds + (b) * SHM_K + kdst[_s]) = sr_[i].k[_s]; } while (0)
#define ATT_SWAIT() asm volatile("s_waitcnt vmcnt(%0)" :: "n"(SD == 2 ? KN + VN : 0) : "memory")
  f32x16 pA0, pA1, pB0, pB1; bf16x8 pa0, pa1, pa2, pa3; const int NT = nkeys / KVBLK;
  constexpr int SE = 0, SO = SD - 1;
  ATT_SLOAD(SE, 0); asm volatile("s_waitcnt vmcnt(0)" ::: "memory"); ATT_SWRITE(0, SE); __syncthreads();
  qkt<DK>(pA0, pA1, K_lds, qr, r32, hi); partialSM<DK, OFF>(pA0, pA1, negMC);
  ATT_SLOAD(SO, KVBLK); if constexpr (SD == 2) { if (2 < NT) ATT_SLOAD(SE, 2 * KVBLK); }
  ATT_SWAIT(); ATT_SWRITE(1, SO); __syncthreads();
  for (int j = 1; j + 1 < NT; j += 2) {
    ATT_SBAR(); qkt<DK>(pB0, pB1, K_lds + SHM_K, qr, r32, hi);
    finishSM(pA0, pA1, l_reg, pa0, pa1, pa2, pa3); ATT_SBAR();
    ATT_SLOAD(SO, (j + SD) * KVBLK); ATT_SBAR();
    pv_all<DV>(o, vb0, pa0, pa1, pa2, pa3); partialSM<DK, OFF>(pB0, pB1, negMC);
    __syncthreads(); ATT_SWAIT(); ATT_SWRITE(0, SE);
    __syncthreads();
    ATT_SBAR(); qkt<DK>(pA0, pA1, K_lds, qr, r32, hi);
    finishSM(pB0, pB1, l_reg, pa0, pa1, pa2, pa3); ATT_SBAR();
    if (SD == 1 || j + 3 < NT) ATT_SLOAD(SE, (j + 1 + SD) * KVBLK); ATT_SBAR();
    pv_all<DV>(o, vb0 + SHM_V, pa0, pa1, pa2, pa3); partialSM<DK, OFF>(pA0, pA1, negMC);
    __syncthreads(); ATT_SWAIT(); ATT_SWRITE(1, SO);
    __syncthreads();
  }
  ATT_SBAR(); qkt<DK>(pB0, pB1, K_lds + SHM_K, qr, r32, hi);
  finishSM(pA0, pA1, l_reg, pa0, pa1, pa2, pa3); ATT_SBAR();
  pv_all<DV>(o, vb0, pa0, pa1, pa2, pa3); partialSM<DK, OFF>(pB0, pB1, negMC);
  __syncthreads();
  finishSM(pB0, pB1, l_reg, pa0, pa1, pa2, pa3); ATT_SBAR();
  pv_all<DV>(o, vb0 + SHM_V, pa0, pa1, pa2, pa3);
  { auto rr = __builtin_amdgcn_permlane32_swap(__float_as_uint(l_reg), __float_as_uint(l_reg), false, false);
    l_reg = __uint_as_float(rr[0]) + __uint_as_float(rr[1]); }
  if (hi == 0) li_l[r32] = l_reg; asm volatile("s_waitcnt lgkmcnt(0)" ::: "memory");
  float rli[16];
#pragma unroll
  for (int r = 0; r < 16; ++r) rli[r] = __builtin_amdgcn_rcpf(li_l[crow(r, hi)]);
  bf16* Ow = Ob + (long)(wid * QBLK) * ldo;
#pragma unroll
  for (int r = 0; r < 16; ++r) { const int orow = crow(r, hi);
#pragma unroll
    for (int d0 = 0; d0 < ND; ++d0) Ow[(long)orow * ldo + d0 * 32 + r32] = (bf16)f2bf(o[d0][r] * rli[r]); }
  __syncthreads();
#undef ATT_TBASE
#undef ATT_LD
#undef ATT_SLOAD
#undef ATT_SWRITE
#undef ATT_SWAIT
}
template <int I, int N, class F> __device__ __forceinline__ void sfor(F&& f) { if constexpr (I < N) { f(std::integral_constant<int, I>{}); sfor<I + 1, N>(f); } }
template <int N> __device__ __forceinline__ void lgkm_wait8(s16x4* v) { asm volatile("s_waitcnt lgkmcnt(%8)" : "+v"(v[0]), "+v"(v[1]), "+v"(v[2]), "+v"(v[3]), "+v"(v[4]), "+v"(v[5]), "+v"(v[6]), "+v"(v[7]) : "n"(N) : "memory"); }
template <int DV, int GRP> __device__ __forceinline__ void v_group_read(s16x4* vf, int vb) {
  sfor<0, 8>([&](auto ic) { constexpr int j = decltype(ic)::value; vf[j] = tr_read<v_rd_off<DV>(GRP, j / 2, j % 2)>(vb); });
}
__device__ __forceinline__ void pv_group(f32x16& od, const s16x4* vf, bf16x8 pa0, bf16x8 pa1, bf16x8 pa2, bf16x8 pa3) {
#define ATT_PK(L, H) (bf16x8){L[0], L[1], L[2], L[3], H[0], H[1], H[2], H[3]}
  od = __builtin_amdgcn_mfma_f32_32x32x16_bf16(pa0, ATT_PK(vf[0], vf[1]), od, 0, 0, 0);
  od = __builtin_amdgcn_mfma_f32_32x32x16_bf16(pa1, ATT_PK(vf[2], vf[3]), od, 0, 0, 0);
  od = __builtin_amdgcn_mfma_f32_32x32x16_bf16(pa2, ATT_PK(vf[4], vf[5]), od, 0, 0, 0);
  od = __builtin_amdgcn_mfma_f32_32x32x16_bf16(pa3, ATT_PK(vf[6], vf[7]), od, 0, 0, 0);
#undef ATT_PK
}
template <int DV> __device__ __forceinline__ void pv_all_pipe(f32x16* o, int vb, bf16x8 pa0, bf16x8 pa1, bf16x8 pa2, bf16x8 pa3) {
  s16x4 va[8], vc[8];
  v_group_read<DV, 0>(va, vb); v_group_read<DV, 1>(vc, vb);
  lgkm_wait8<8>(va); pv_group(o[0], va, pa0, pa1, pa2, pa3);
  if constexpr (DV == 128) {
    s16x4 vd[8], ve[8];
    v_group_read<DV, 2>(vd, vb);
    lgkm_wait8<8>(vc); pv_group(o[1], vc, pa0, pa1, pa2, pa3);
    v_group_read<DV, 3>(ve, vb);
    lgkm_wait8<8>(vd); pv_group(o[2], vd, pa0, pa1, pa2, pa3);
    lgkm_wait8<0>(ve); pv_group(o[3], ve, pa0, pa1, pa2, pa3);
  } else { lgkm_wait8<0>(vc); pv_group(o[1], vc, pa0, pa1, pa2, pa3); }
}

template <int DK, int DV, bool OFF, class QLoader>
__device__ __forceinline__ void body_dma(const QLoader& QL, const bf16* __restrict__ K0, const bf16* __restrict__ K1, int ldk,
                                         const bf16* __restrict__ V0, const bf16* __restrict__ V1, int ldv, bf16* __restrict__ Ob, int ldo, int nkeys, float negMC, char* lds, int tid_in) {
  using G = Geo<DK, DV>;
  constexpr int SHM_V = G::SHM_V, SHM_K = G::SHM_K, ND = DV / 32, NSL = 4;
  constexpr int KPW = (SHM_K / 1024) / NW, VPW = (SHM_V / 1024) / NW, NPW = KPW + VPW;
  static_assert(KPW == 2 && (VPW == 1 || VPW == 2) && NSL * (SHM_V + SHM_K) + NW * 256 <= 135168, "DMA geometry");
  int tid_ = tid_in; asm volatile("" : "+v"(tid_));
  const int tid = tid_, wid = __builtin_amdgcn_readfirstlane(tid >> 6), lane = tid & 63, r32 = lane & 31, hi = lane >> 5;
  char* V_lds = lds; char* K_lds = lds + NSL * SHM_V;
  float* ws = (float*)(lds + NSL * (SHM_V + SHM_K)) + wid * 64; float* li_l = ws;
  float l_reg = 0; f32x16 o[ND];
#pragma unroll
  for (int d = 0; d < ND; ++d) o[d] = f32x16{};
  bf16x8 qr[DK / 16];
  QL.load(qr, wid * QBLK + r32, hi);
  asm volatile("s_waitcnt vmcnt(0)" ::: "memory");
  unsigned koff[KPW], voff[VPW];
#pragma unroll
  for (int i = 0; i < (DK == 64 ? 1 : KPW); ++i) { const int row = (wid * KPW + i) * 4 + (lane >> 4); int c = (lane & 15) ^ (row & 7); c = (c < DK / 8) ? c : (c & 7); koff[i] = (unsigned)((row * ldk) * 2 + c * 16); }
#pragma unroll
  for (int i = 0; i < 1; ++i) { const int sidx = (wid * VPW + i) * 2 + (lane >> 5), kg = sidx / ND, st = sidx % ND, kk = kg * 8 + ((lane & 31) >> 2);
    const int k = (kk & ~0xC) | ((kk & 4) << 1) | ((kk & 8) >> 1), c = st * 32 + (lane & 3) * 8; voff[i] = (unsigned)((k * ldv + c) * 2); }
  const int vb0 = (int)(uintptr_t)V_lds + v_rd_base(lane);
  LAS unsigned* const ldsK = (LAS unsigned*)(LAS char*)K_lds + (wid * KPW) * 256; LAS unsigned* const ldsV = (LAS unsigned*)(LAS char*)V_lds + (wid * VPW) * 256;
#define ATT_TBASE(k0, ld, P0, P1) (((k0) < 256) ? ((P0) + (long)(k0) * (ld)) : ((P1) + (long)((k0) - 256) * (ld)))
#define DMA_TILE(t, slot) do { const int k0_ = (t) * KVBLK; const char* kb_ = (const char*)ATT_TBASE(k0_, ldk, K0, K1); const char* vb_ = (const char*)ATT_TBASE(k0_, ldv, V0, V1); \
    __builtin_amdgcn_global_load_lds((const unsigned*)(kb_ + koff[0]), ldsK + (slot) * (SHM_K / 4), 16, 0, 0); \
    if constexpr (DK == 64) __builtin_amdgcn_global_load_lds((const unsigned*)(kb_ + 4 * 64 * 2 + (koff[0] ^ 64u)), ldsK + (slot) * (SHM_K / 4) + 256, 16, 0, 0);     \
    else __builtin_amdgcn_global_load_lds((const unsigned*)(kb_ + koff[1]), ldsK + (slot) * (SHM_K / 4) + 256, 16, 0, 0); \
    __builtin_amdgcn_global_load_lds((const unsigned*)(vb_ + voff[0]), ldsV + (slot) * (SHM_V / 4), 16, 0, 0); \
    if constexpr (VPW == 2) __builtin_amdgcn_global_load_lds((const unsigned*)(vb_ + 128 + voff[0]), ldsV + (slot) * (SHM_V / 4) + 256, 16, 0, 0);     } while (0)
#define DMA_WAIT(last) do { if (last) asm volatile("s_waitcnt vmcnt(0)" ::: "memory"); else asm volatile("s_waitcnt vmcnt(%0)" :: "n"(NPW) : "memory"); } while (0)
  f32x16 pA0, pA1, pB0, pB1; bf16x8 pa0, pa1, pa2, pa3; const int NT = nkeys / KVBLK;
  DMA_TILE(0, 0); DMA_TILE(1, 1); DMA_WAIT(false); __syncthreads(); if (2 < NT) DMA_TILE(2, 2);
  qkt<DK>(pA0, pA1, K_lds, qr, r32, hi); partialSM<DK, OFF>(pA0, pA1, negMC);
#define DMA_ITER(j, PN0, PN1, PO0, PO1, KS, VS, DS) do { \
    DMA_WAIT((j) + 1 >= NT); __syncthreads(); if ((j) + 2 < NT) DMA_TILE((j) + 2, DS); \
    qkt<DK>(PN0, PN1, K_lds + (KS) * SHM_K, qr, r32, hi); \
    finishSM(PO0, PO1, l_reg, pa0, pa1, pa2, pa3); \
    pv_all_pipe<DV>(o, vb0 + (VS) * SHM_V, pa0, pa1, pa2, pa3); partialSM<DK, OFF>(PN0, PN1, negMC); } while (0)
  for (int j = 1; j < NT; j += 4) {
    DMA_ITER(j, pB0, pB1, pA0, pA1, 1, 0, 3);
    if (j + 1 < NT) DMA_ITER(j + 1, pA0, pA1, pB0, pB1, 2, 1, 0);
    if (j + 2 < NT) DMA_ITER(j + 2, pB0, pB1, pA0, pA1, 3, 2, 1);
    if (j + 3 < NT) DMA_ITER(j + 3, pA0, pA1, pB0, pB1, 0, 3, 2);
  }
  finishSM(pB0, pB1, l_reg, pa0, pa1, pa2, pa3); ATT_SBAR();
  pv_all_pipe<DV>(o, vb0 + 3 * SHM_V, pa0, pa1, pa2, pa3);
  { auto rr = __builtin_amdgcn_permlane32_swap(__float_as_uint(l_reg), __float_as_uint(l_reg), false, false);
    const unsigned r0 = rr[0], r1 = rr[1]; l_reg = __uint_as_float(r0) + __uint_as_float(r1); }
  const int lane_e = hw_lane(), r32e = lane_e & 31, hie = lane_e >> 5;
  if (hie == 0) li_l[r32e] = l_reg; asm volatile("s_waitcnt lgkmcnt(0)" ::: "memory");
  float rli[16];
#pragma unroll
  for (int r = 0; r < 16; ++r) rli[r] = __builtin_amdgcn_rcpf(li_l[crow(r, hie)]);
  bf16* Ow = Ob + (long)(wid * QBLK) * ldo;
#pragma unroll
  for (int r = 0; r < 16; ++r) { const int orow = crow(r, hie);
#pragma unroll
    for (int d0 = 0; d0 < ND; ++d0) Ow[(long)orow * ldo + d0 * 32 + r32e] = (bf16)f2bf(o[d0][r] * rli[r]); }
  __syncthreads();
#undef ATT_TBASE
#undef DMA_TILE
#undef DMA_WAIT
#undef DMA_ITER
}
}

#define XB_TMO      128
#define XB_XCNT(j)  (256  + 64 * (j))
#define XB_XSUB(j)  (1280 + 64 * (j))
#define XB_XGEN(j)  (2304 + 64 * (j))
#define XB_TOP      3328
#define XB_TOPGEN   3392
#define XCD_BAR_WORDS 3456
#define XB_SPIN_CAP (1u << 18)

__device__ __forceinline__ unsigned xb_ld(unsigned* p)              { return __hip_atomic_load(p, __ATOMIC_RELAXED, __HIP_MEMORY_SCOPE_AGENT); }
__device__ __forceinline__ unsigned xb_add(unsigned* p, unsigned v) { return __hip_atomic_fetch_add(p, v, __ATOMIC_RELAXED, __HIP_MEMORY_SCOPE_AGENT); }
__device__ __forceinline__ unsigned xb_xcc_id() { return (unsigned)__builtin_amdgcn_s_getreg((3 << 11) | 20) & 0xFu; }
#define XB_SPIN(cond, bar) do { unsigned _sp = 0; while (cond) { __builtin_amdgcn_s_sleep(1); \
    if ((++_sp & 255u) == 0u) { if (xb_ld(&(bar)[XB_TMO])) break; if (_sp > XB_SPIN_CAP) { atomicAdd(&(bar)[XB_TMO], 1u); break; } } } } while (0)

struct XcdBarrier {
    int wave;
    unsigned* bar; unsigned x;
    volatile LAS unsigned* st;
};

__device__ __forceinline__ XcdBarrier xcd_barrier_post(unsigned* bar, volatile LAS unsigned* st) {
    XcdBarrier b; b.wave = 0; b.bar = bar; b.x = xb_xcc_id(); b.st = st;
    if (threadIdx.x == 0) (void)xb_add(&bar[XB_XCNT(b.x)], 1u);
    return b;
}
__device__ __forceinline__ void xcd_barrier_complete(unsigned* bar, unsigned x, unsigned& nloc, unsigned& nx) {
    const unsigned G = gridDim.x * gridDim.y * gridDim.z;
    unsigned sum, cnt, mine, sp = 0u;
    for (;;) {
        sum = 0u; cnt = 0u; mine = 0u;
#pragma unroll
        for (unsigned j = 0; j < 16; ++j) { const unsigned c = xb_ld(&bar[XB_XCNT(j)]); sum += c; cnt += (c > 0u) ? 1u : 0u; mine = (j == x) ? c : mine; }
        if (sum == G) break;
        __builtin_amdgcn_s_sleep(1);
        if ((++sp & 255u) == 0u) { if (xb_ld(&bar[XB_TMO])) break; if (sp > XB_SPIN_CAP) { atomicAdd(&bar[XB_TMO], 1u); break; } }
    }
    nloc = mine > 0u ? mine : 1u; nx = cnt > 0u ? cnt : 1u;
}

__device__ __forceinline__ void xcd_barrier(const XcdBarrier& b) {
    asm volatile("s_waitcnt vmcnt(0)" ::: "memory");
    __syncthreads();
    if (b.wave == 0 && hw_lane() == 0) {
        size_t zb_ = 0; asm volatile("" : "+s"(zb_));
        unsigned* bar = b.bar + zb_;
        __builtin_amdgcn_s_waitcnt(0);
        unsigned nloc = b.st[0], nx = b.st[1];
        if (nloc == 0u) { xcd_barrier_complete(bar, b.x, nloc, nx); b.st[0] = nloc; b.st[1] = nx; }
        const unsigned old = xb_add(&bar[XB_XSUB(b.x)], 1u);
        const unsigned gen = old / nloc;
        if (old + 1u == (gen + 1u) * nloc) {
            __builtin_amdgcn_fence(__ATOMIC_RELEASE, "agent");
            asm volatile("s_waitcnt vmcnt(0)" ::: "memory");
            const unsigned og = xb_add(&bar[XB_TOP], 1u);
            const unsigned tg = og / nx;
            if (og + 1u == (tg + 1u) * nx) xb_add(&bar[XB_TOPGEN], 1u);
            else XB_SPIN(xb_ld(&bar[XB_TOPGEN]) == tg, bar);
            __builtin_amdgcn_fence(__ATOMIC_ACQUIRE, "agent");
            xb_add(&bar[XB_XGEN(b.x)], 1u);
            asm volatile("s_waitcnt vmcnt(0)" ::: "memory");
        } else {
            XB_SPIN(xb_ld(&bar[XB_XGEN(b.x)]) == gen, bar);
            __builtin_amdgcn_fence(__ATOMIC_ACQUIRE, "agent");
            asm volatile("s_waitcnt vmcnt(0)" ::: "memory");
        }
    }
    __syncthreads();
}

struct Args { const float* in[35]; float* out; unsigned char* ws; int ph_lo, ph_hi; };
enum { I_X = 0, I_C, I_CTX, I_CCTX, I_ADAW, I_ADAB, I_NMIX, I_NFFN, I_MLA_WIN, I_MLA_QNG, I_MLA_WUQ, I_MLA_KVNG, I_MLA_WUKV, I_MLA_QN, I_MLA_KN, I_MLA_WOUT,
       I_DF_WIN, I_DF_QN, I_DF_KN, I_DF_LQ1, I_DF_LK1, I_DF_LQ2, I_DF_LK2, I_DF_SUBG, I_DF_WOUT, I_SG_WIN, I_SG_LNG, I_SG_LNB, I_SG_WS, I_SG_BS, I_SG_WOUT,
       I_ROUTER, I_WGATE, I_WUP, I_WDOWN };
struct Frame {
    LAS unsigned char* lds;
    int tid, lane, wave, vcu, G;
    unsigned char* ws; float* out;
};
struct InPtrs {
    volatile LAS unsigned* tab;
    __device__ __forceinline__ const float* operator[](int i) const {
        const unsigned lo = __builtin_amdgcn_readfirstlane(tab[2 * i]), hi = __builtin_amdgcn_readfirstlane(tab[2 * i + 1]);
        return (const float*)(const GAS float*)(((unsigned long long)hi << 32) | lo);
    }
};
__device__ __forceinline__ bf16* xb_row(const Frame& F, int row) { return (bf16*)(F.ws + WS_XB) + (size_t)row * D; }

constexpr int TR_SROW = 136, TR_WAVE_BYTES = 64 * TR_SROW;
typedef short tr_v4i16 __attribute__((ext_vector_type(4)));
__device__ __forceinline__ void transpose_item(const float* W, int N, int k0, int n0, int ncols  , bf16* WT, int K, int drow0, LAS unsigned char* scr, int lane, const float* kscale = nullptr  ) {
    const int r4 = lane >> 4, c4 = (lane & 15) * 4;
    const bool ld_ok = c4 < ncols;
    f32x4 v[16];
    const float* src = W + (size_t)(k0 + r4) * N + n0 + c4;
#pragma unroll
    for (int i = 0; i < 16; ++i) v[i] = ld_ok ? __builtin_nontemporal_load((const f32x4*)(src + (size_t)(4 * i) * N)) : (f32x4){0.f, 0.f, 0.f, 0.f};
#pragma unroll
    for (int i = 0; i < 16; ++i) { if (kscale) v[i] = v[i] * kscale[k0 + 4 * i + r4]; v2u w; w.x = pk2(v[i].x, v[i].y); w.y = pk2(v[i].z, v[i].w); *(LAS v2u*)(scr + (4 * i + r4) * TR_SROW + c4 * 2) = w; }
    LDS_WAIT(); asm volatile("" ::: "memory");
    const LAS unsigned char* rb = scr + ((lane >> 2) & 3) * TR_SROW + ((lane >> 4) * 16 + (lane & 3) * 4) * 2;
    v2u o[16];
#pragma unroll
    for (int k4 = 0; k4 < 16; ++k4) { const tr_v4i16 t = __builtin_amdgcn_ds_read_tr16_b64_v4i16((LAS tr_v4i16*)(rb + k4 * 4 * TR_SROW)); o[k4] = __builtin_bit_cast(v2u, t); }
    LDS_WAIT(); asm volatile("" ::: "memory");
    if (lane < ncols) { v4u* dst = (v4u*)(WT + (size_t)(drow0 + lane) * K + k0);
#pragma unroll
        for (int j = 0; j < 8; ++j) dst[j] = (v4u){o[2 * j].x, o[2 * j].y, o[2 * j + 1].x, o[2 * j + 1].y}; }
}
__device__ __forceinline__ int tr_items(int K, int N) { return (K / 64) * ((N + 63) / 64); }
__device__ __forceinline__ void tr_run(const float* W, int K, int N, bf16* WT, int r, LAS unsigned char* scr, int lane, const float* kscale = nullptr) {
    const int nblk = (N + 63) / 64, kb = r / nblk, nb = r % nblk, k0 = kb * 64, n0 = nb * 64;
    transpose_item(W, N, k0, n0, (N - n0) < 64 ? (N - n0) : 64, WT, K, n0, scr, lane, kscale);
}

__device__ __forceinline__ void p0_prologue(Frame& F, const InPtrs& A) {
    {
        LAS float* sv = (LAS float*)F.lds;
        LAS float* red = (LAS float*)(F.lds + 36864);
        bool have = false;
        for (int it = blockIdx.x; it < 96; it += F.G) {
            if (!have) {
                for (int i = F.tid; i < 9 * 1024; i += NTHREADS) { const int r = i >> 10, k = i & 1023; const float v = r < 8 ? A[I_C][r * 1024 + k] : A[I_CCTX][k]; sv[i] = v / (1.0f + __expf(-v)); }
                __syncthreads(); have = true;
            }
            const int layer = it / 24, cb = it % 24, col = cb * 256 + 4 * F.lane, kbase = F.wave * 128;
            const float* W = A[I_ADAW] + (size_t)layer * 1024 * 6144 + col;
            f32x4 acc[9];
#pragma unroll
            for (int r = 0; r < 9; ++r) acc[r] = (f32x4){0.f, 0.f, 0.f, 0.f};
#pragma unroll 4
            for (int k = 0; k < 128; ++k) { const f32x4 w = *(const f32x4*)(W + (size_t)(kbase + k) * 6144);
#pragma unroll
                for (int r = 0; r < 9; ++r) acc[r] += w * sv[r * 1024 + kbase + k]; }
#pragma unroll
            for (int r = 0; r < 9; ++r) *(LAS f32x4*)(red + (F.wave * 9 + r) * 256 + 4 * F.lane) = acc[r];
            __syncthreads();
            float* MODp = (float*)(F.ws + WS_MOD) + (size_t)layer * 9 * 6144;
            for (int o = F.tid; o < 9 * 256; o += NTHREADS) { const int r = o >> 8, cc = o & 255; float s = 0.f;
#pragma unroll
                for (int w = 0; w < 8; ++w) s += red[(w * 9 + r) * 256 + cc];
                MODp[r * 6144 + cb * 256 + cc] = s + A[I_ADAB][layer * 6144 + cb * 256 + cc]; }
            __syncthreads();
        }
        __syncthreads();
    }
    const int gtid = F.vcu * NTHREADS + F.tid, GT = F.G * NTHREADS;
    {
        float* ca = (float*)(F.ws + WS_ROPEA); float* sa = ca + 4096 * 16; float* cb = (float*)(F.ws + WS_ROPEB); float* sb = cb + 4096 * 32;
        for (int i = gtid; i < 4096 * 16; i += GT) { const int t = i >> 4, j = i & 15, f = j & 7; const float pos = (float)(j < 8 ? (t >> 6) : (t & 63));
            const float inv = powf(10000.0f, -(float)f / 8.0f), ang = pos * inv; ca[i] = cosf(ang); sa[i] = sinf(ang); }
        for (int i = gtid; i < 4096 * 32; i += GT) { const int t = i >> 5, j = i & 31, f = j & 15; const float pos = (float)(j < 16 ? (t >> 6) : (t & 63));
            const float inv = powf(10000.0f, -(float)f / 16.0f), ang = pos * inv; cb[i] = cosf(ang); sb[i] = sinf(ang); }
    }
    {
        for (int j = 0; j < 2; ++j) { v4u* z = (v4u*)(F.ws + WS_WNM + j * MLA_W_STRIDE + MLA_WIN + (size_t)800 * 1024 * 2);
            for (int i = gtid; i < 224 * 1024 * 2 / 16; i += GT) z[i] = (v4u){0u, 0u, 0u, 0u}; }
        bf16* wsA = (bf16*)(F.ws + WS_SG_WS); const float* wsrc = A[I_SG_WS];
        for (int i = gtid; i < 8 * 256 * 128 / 2; i += GT) { const int e0 = i * 2, g = e0 >> 15, p = (e0 >> 7) & 255, q = e0 & 127;
            unsigned w = 0u; if (p < 128) { const float* s = wsrc + ((size_t)g * 128 + p) * 128 + q; w = pk2(s[0], s[1]); }
            ((unsigned*)wsA)[i] = w; }
    }
    {
        LAS unsigned char* scr = F.lds + F.wave * TR_WAVE_BYTES;
        const int gw = F.vcu * NWAVES + F.wave, NGW = F.G * NWAVES;
        const int n_win = tr_items(1024, 800), n_wuq = tr_items(512, 1536), n_wukv = tr_items(256, 2048), n_wout = tr_items(1024, 1024);
        const int n_mla = n_win + n_wuq + n_wukv + n_wout;
        const int n_dwin = tr_items(1024, 3072), n_dwout = tr_items(1024, 1024), n_swin = tr_items(1024, 4096), n_swout = tr_items(2048, 1024);
        const int total = 2 * n_mla + n_dwin + n_dwout + n_swin + n_swout;
        for (int it = gw; it < total; it += NGW) {
            int r = it;
            if (r < 2 * n_mla) { const int j = r / n_mla; r -= j * n_mla; unsigned char* wb = F.ws + WS_WNM + j * MLA_W_STRIDE;
                if (r < n_win) { tr_run(A[I_MLA_WIN] + (size_t)j * 1024 * 800, 1024, 800, (bf16*)(wb + MLA_WIN), r, scr, F.lane); continue; } r -= n_win;
                if (r < n_wuq) { tr_run(A[I_MLA_WUQ] + (size_t)j * 512 * 1536, 512, 1536, (bf16*)(wb + MLA_WUQ), r, scr, F.lane, A[I_MLA_QNG] + j * 512); continue; } r -= n_wuq;
                if (r < n_wukv) { tr_run(A[I_MLA_WUKV] + (size_t)j * 256 * 2048, 256, 2048, (bf16*)(wb + MLA_WUKV), r, scr, F.lane, A[I_MLA_KVNG] + j * 256); continue; } r -= n_wukv;
                tr_run(A[I_MLA_WOUT] + (size_t)j * 1024 * 1024, 1024, 1024, (bf16*)(wb + MLA_WOUT), r, scr, F.lane); continue; }
            r -= 2 * n_mla;
            if (r < n_dwin) { tr_run(A[I_DF_WIN], 1024, 3072, (bf16*)(F.ws + WS_DIFF_WIN), r, scr, F.lane); continue; } r -= n_dwin;
            if (r < n_dwout) { tr_run(A[I_DF_WOUT], 1024, 1024, (bf16*)(F.ws + WS_DIFF_WOUT), r, scr, F.lane); continue; } r -= n_dwout;
            if (r < n_swin) { tr_run(A[I_SG_WIN], 1024, 4096, (bf16*)(F.ws + WS_SG_WIN), r, scr, F.lane); continue; } r -= n_swin;
            tr_run(A[I_SG_WOUT], 2048, 1024, (bf16*)(F.ws + WS_SG_WOUT), r, scr, F.lane);
        }
    }
}
__device__ __forceinline__ void moe_weight_item(Frame& F, const InPtrs& A, int layer, int it, LAS unsigned char* scr) {
    constexpr int PER = 16 * 16;
    const int which = it / (16 * PER), r0 = it % (16 * PER), e = r0 / PER, r = r0 % PER, kb = r >> 4, nb = r & 15, k0 = kb * 64, n0 = nb * 64;
    const size_t eoff = ((size_t)layer * 16 + e) * 1024 * 1024;
    if (which == 0) transpose_item(A[I_WGATE] + eoff, 1024, k0, n0, 64, (bf16*)(F.ws + WS_WGU), 1024, e * 2048 + (n0 >> 7) * 256 + (n0 & 127), scr, F.lane);
    else if (which == 1) transpose_item(A[I_WUP] + eoff, 1024, k0, n0, 64, (bf16*)(F.ws + WS_WGU), 1024, e * 2048 + (n0 >> 7) * 256 + 128 + (n0 & 127), scr, F.lane);
    else transpose_item(A[I_WDOWN] + eoff, 1024, k0, n0, 64, (bf16*)(F.ws + WS_WDN), 1024, e * 1024 + n0, scr, F.lane);
}
constexpr int MOE_CONV_ITEMS = 3 * 16 * 16 * 16;
__device__ __forceinline__ void moe_weight_items(Frame& F, const InPtrs& A, int layer) {
    LAS unsigned char* scr = F.lds + F.wave * TR_WAVE_BYTES;
    const int gw = F.vcu * NWAVES + F.wave, NGW = F.G * NWAVES;
    for (int it = gw; it < MOE_CONV_ITEMS; it += NGW) moe_weight_item(F, A, layer, it, scr);
}
constexpr int CONV_LDS_OFF = 69632;
__device__ __forceinline__ int conv_rounds(const Frame& F) { return F.G >= 256 ? 6 : (F.G >= 128 ? 12 : (MOE_CONV_ITEMS + F.G * NWAVES - 1) / (F.G * NWAVES)); }
__device__ __forceinline__ void moe_weight_round(Frame& F, const InPtrs& A, int layer, int round) {
    const int it = round * (F.G * NWAVES) + F.vcu * NWAVES + F.wave;
    Frame Fc = F; { int l_ = F.lane; asm volatile("" : "+v"(l_)); Fc.lane = l_; }
    if (it < MOE_CONV_ITEMS) moe_weight_item(Fc, A, layer, it, F.lds + CONV_LDS_OFF + F.wave * TR_WAVE_BYTES);
}
template <bool FFN, bool FIRST>
__device__ __forceinline__ void norm_phase(Frame& F, const InPtrs& A, int layer, bool combine, int nrows, float cmul = 1.0f) {
    constexpr bool first = FIRST;
    const int gw = F.vcu * NWAVES + F.wave, NGW = F.G * NWAVES, lane = F.lane;
    const float* MOD = (const float*)(F.ws + WS_MOD);
    LAS float* rT = (LAS float*)F.lds;
    if (FFN) {
        const float* R = A[I_ROUTER] + (size_t)layer * 1024 * 16;
        for (int i = F.tid; i < 16 * 1024; i += NTHREADS) { const int k = i >> 4, e = i & 15; rT[e * 1024 + k] = R[i]; }
        __syncthreads();
    }
#define NPC(q) (8 * (64 * ((q) >> 1) + lane) + 4 * ((q) & 1))
    const float* gvec = (FFN ? A[I_NFFN] : A[I_NMIX]) + layer * 1024;
    f32x4 gn[4];
#pragma unroll
    for (int j = 0; j < 4; ++j) gn[j] = *(const f32x4*)(gvec + NPC(j));
    const bf16* YB = (const bf16*)(F.ws + R_YB);
    const int* SLOT = (const int*)(F.ws + WS_SLOT);
    const float* A_x = first ? A[I_X] : nullptr; const float* A_c = first ? A[I_CTX] : nullptr;
    f32x4 xaf[4], xbf[4]; v4u xab[2], xbb[2]; int sla = -1, slb = -1;
    v4u wB[4][2], wC[4][2]; int sB[4] = {-1, -1, -1, -1}, sC[4] = {-1, -1, -1, -1}; unsigned restB = 0u, restC = 0u;
#define NP_LOADX(mm, XF, XB_, SL) do { if (first) { const float* src_ = (mm) < NLAT ? A_x + (size_t)(mm) * D : A_c + (size_t)((mm) - NLAT) * D; \
        _Pragma("unroll") for (int j = 0; j < 4; ++j) XF[j] = *(const f32x4*)(src_ + NPC(j)); } \
      else { const bf16* src_ = xb_row(F, (mm)); _Pragma("unroll") for (int k = 0; k < 2; ++k) XB_[k] = *(const v4u*)(src_ + NPC(2 * k)); } \
      if (combine) SL = SLOT[(size_t)(mm) * 16 + (lane & 15)]; } while (0)
#define NP_LOADW(SL, W, SI, REST) do { unsigned msk_ = (unsigned)(__ballot((SL) >= 0) & 0xffffull); \
        _Pragma("unroll") for (int q = 0; q < 4; ++q) { SI[q] = -1; if (msk_) { const int e_ = __builtin_ctz(msk_); msk_ &= msk_ - 1u; SI[q] = __builtin_amdgcn_readlane((SL), e_); } } \
        REST = msk_; \
        _Pragma("unroll") for (int q = 0; q < 4; ++q) if (SI[q] >= 0) { const bf16* y_ = YB + (size_t)SI[q] * 1024; \
            _Pragma("unroll") for (int k = 0; k < 2; ++k) W[q][k] = *(const v4u*)(y_ + NPC(2 * k)); } } while (0)
    if (gw < nrows) { NP_LOADX(gw, xbf, xbb, slb); }
    if (gw + NGW < nrows) { NP_LOADX(gw + NGW, xaf, xab, sla); }
    if (combine && gw < nrows) { NP_LOADW(slb, wB, sB, restB); }
    for (int m = gw; m < nrows; m += NGW) {
        const bool lat = m < NLAT; const int rr = lat ? (m >> 12) : 8;
        f32x4 v[4]; const int slc = slb;
#pragma unroll
        for (int k = 0; k < 2; ++k) { v[2 * k] = first ? xbf[2 * k] : (f32x4){bflo(xbb[k].x), bfhi(xbb[k].x), bflo(xbb[k].y), bfhi(xbb[k].y)}; v[2 * k + 1] = first ? xbf[2 * k + 1] : (f32x4){bflo(xbb[k].z), bfhi(xbb[k].z), bflo(xbb[k].w), bfhi(xbb[k].w)}; }
#pragma unroll
        for (int q = 0; q < 4; ++q) { sC[q] = sB[q]; wC[q][0] = wB[q][0]; wC[q][1] = wB[q][1]; }
        restC = restB;
#pragma unroll
        for (int j = 0; j < 4; ++j) xbf[j] = xaf[j];
        xbb[0] = xab[0]; xbb[1] = xab[1];
        slb = sla;
        { const int m2 = m + 2 * NGW; if (m2 < nrows) { NP_LOADX(m2, xaf, xab, sla); } }
        if (combine) { if (m + NGW < nrows) { NP_LOADW(slb, wB, sB, restB); } }
        if (combine) {
            f32x4 acc[4];
#pragma unroll
            for (int j = 0; j < 4; ++j) acc[j] = (f32x4){0.f, 0.f, 0.f, 0.f};
#pragma unroll
            for (int q = 0; q < 4; ++q) if (sC[q] >= 0) {
#pragma unroll
                for (int k = 0; k < 2; ++k) { acc[2 * k] += (f32x4){bflo(wC[q][k].x), bfhi(wC[q][k].x), bflo(wC[q][k].y), bfhi(wC[q][k].y)}; acc[2 * k + 1] += (f32x4){bflo(wC[q][k].z), bfhi(wC[q][k].z), bflo(wC[q][k].w), bfhi(wC[q][k].w)}; } }
            while (restC) {
                const int e = __builtin_ctz(restC); restC &= restC - 1u; const int sidx = __builtin_amdgcn_readlane(slc, e);
                const bf16* y = YB + (size_t)sidx * 1024;
#pragma unroll
                for (int k = 0; k < 2; ++k) { const v4u w = *(const v4u*)(y + NPC(2 * k)); acc[2 * k] += (f32x4){bflo(w.x), bfhi(w.x), bflo(w.y), bfhi(w.y)}; acc[2 * k + 1] += (f32x4){bflo(w.z), bfhi(w.z), bflo(w.w), bfhi(w.w)}; }
            }
            const float* g2 = MOD + ((size_t)(layer - 1) * 9 + rr) * 6144 + 5120;
#pragma unroll
            for (int j = 0; j < 4; ++j) v[j] += *(const f32x4*)(g2 + NPC(j)) * acc[j] * cmul;
        }
        if (first || combine) { bf16* dst = xb_row(F, m);
#pragma unroll
            for (int k = 0; k < 2; ++k) { v4u w; w.x = pk2(v[2 * k].x, v[2 * k].y); w.y = pk2(v[2 * k].z, v[2 * k].w); w.z = pk2(v[2 * k + 1].x, v[2 * k + 1].y); w.w = pk2(v[2 * k + 1].z, v[2 * k + 1].w);
                *(v4u*)(dst + NPC(2 * k)) = w;
                v[2 * k] = (f32x4){bflo(w.x), bfhi(w.x), bflo(w.y), bfhi(w.y)}; v[2 * k + 1] = (f32x4){bflo(w.z), bfhi(w.z), bflo(w.w), bfhi(w.w)}; } }
        float ss = 0.f;
#pragma unroll
        for (int j = 0; j < 4; ++j) ss += (v[j].x * v[j].x + v[j].y * v[j].y) + (v[j].z * v[j].z + v[j].w * v[j].w);
        const float r = 1.0f / sqrtf(wave_sum(ss) * (1.0f / D) + EPS);
        const float* mrow = MOD + ((size_t)layer * 9 + rr) * 6144 + (FFN ? 3072 : 0);
        f32x4 h[4];
#pragma unroll
        for (int j = 0; j < 4; ++j) { const f32x4 sh = *(const f32x4*)(mrow + NPC(j)), sc = *(const f32x4*)(mrow + 1024 + NPC(j));
            h[j] = (v[j] * r * gn[j]) * (sc + 1.0f) + sh; }
        bf16* hrow = (bf16*)(F.ws + WS_H) + (size_t)m * D;
#pragma unroll
        for (int k = 0; k < 2; ++k) { v4u w; w.x = pk2(h[2 * k].x, h[2 * k].y); w.y = pk2(h[2 * k].z, h[2 * k].w); w.z = pk2(h[2 * k + 1].x, h[2 * k + 1].y); w.w = pk2(h[2 * k + 1].z, h[2 * k + 1].w); *(v4u*)(hrow + NPC(2 * k)) = w; }
        if (FFN) {
            float lg[16];
            LAS float* rTm = rT + 8 * lane; asm volatile("" : "+v"(rTm));
#pragma unroll
            for (int e = 0; e < 16; ++e) { float s = 0.f;
#pragma unroll
                for (int j = 0; j < 4; ++j) { const f32x4 w = *(const LAS f32x4*)(rTm + e * 1024 + 512 * (j >> 1) + 4 * (j & 1)); s += (h[j].x * w.x + h[j].y * w.y) + (h[j].z * w.z + h[j].w * w.w); }
                lg[e] = s; }
            float t8[8], u4[4];
#pragma unroll
            for (int e = 0; e < 8; ++e) { const auto rr = __builtin_amdgcn_permlane32_swap(__float_as_uint(lg[e]), __float_as_uint(lg[e + 8]), false, false); const unsigned r0 = rr[0], r1 = rr[1]; t8[e] = __uint_as_float(r0) + __uint_as_float(r1); }
#pragma unroll
            for (int e = 0; e < 4; ++e) { const auto rr = __builtin_amdgcn_permlane16_swap(__float_as_uint(t8[e]), __float_as_uint(t8[e + 4]), false, false); const unsigned r0 = rr[0], r1 = rr[1]; u4[e] = __uint_as_float(r0) + __uint_as_float(r1); }
            const bool b3 = (lane & 8) != 0, b2 = (lane & 4) != 0;
            const float w0 = (b3 ? u4[2] : u4[0]) + shx<8>(b3 ? u4[0] : u4[2]), w1 = (b3 ? u4[3] : u4[1]) + shx<8>(b3 ? u4[1] : u4[3]);
            float x = (b2 ? w1 : w0) + shx<4>(b2 ? w0 : w1);
            x += shx<2>(x); x += shx<1>(x);
            float mx = fmaxf(x, shx<4>(x)); mx = fmaxf(mx, shx<8>(mx)); mx = fmaxf(mx, shx<16>(mx));
            { const auto rr = __builtin_amdgcn_permlane32_swap(__float_as_uint(mx), __float_as_uint(mx), false, false); const unsigned r0 = rr[0], r1 = rr[1]; mx = fmaxf(__uint_as_float(r0), __uint_as_float(r1)); }
            const float pe = expf(x - mx);
            float den = pe + shx<4>(pe); den += shx<8>(den); den += shx<16>(den);
            { const auto rr = __builtin_amdgcn_permlane32_swap(__float_as_uint(den), __float_as_uint(den), false, false); const unsigned r0 = rr[0], r1 = rr[1]; den = __uint_as_float(r0) + __uint_as_float(r1); }
            if ((lane & 3) == 0) { ((float*)(F.ws + WS_AFF))[(size_t)m * 16 + (lane >> 2)] = pe / den; ((int*)(F.ws + WS_SLOT))[(size_t)m * 16 + (lane >> 2)] = -1; }
        }
    }
}
#undef NP_LOADX
#undef NP_LOADW
#undef NPC
__device__ __forceinline__ void final_phase(Frame& F, int layer) {
    const int gw = F.vcu * NWAVES + F.wave, NGW = F.G * NWAVES, lane = F.lane;
    const float* MOD = (const float*)(F.ws + WS_MOD);
    const bf16* YB = (const bf16*)(F.ws + R_YB); const int* SLOT = (const int*)(F.ws + WS_SLOT);
    v2u vn[4]; int sln = -1;
    if (gw < NLAT) { const bf16* src = xb_row(F, gw);
#pragma unroll
        for (int j = 0; j < 4; ++j) vn[j] = *(const v2u*)(src + 4 * (64 * j + lane));
        sln = SLOT[(size_t)gw * 16 + (lane & 15)]; }
    for (int m = gw; m < NLAT; m += NGW) {
        float* xr = F.out + (size_t)m * D; const int rr = m >> 12;
        f32x4 v[4]; const int sl = sln;
#pragma unroll
        for (int j = 0; j < 4; ++j) v[j] = (f32x4){bflo(vn[j].x), bfhi(vn[j].x), bflo(vn[j].y), bfhi(vn[j].y)};
        { const int mn = m + NGW; if (mn < NLAT) { const bf16* src = xb_row(F, mn);
#pragma unroll
            for (int j = 0; j < 4; ++j) vn[j] = *(const v2u*)(src + 4 * (64 * j + lane));
            sln = SLOT[(size_t)mn * 16 + (lane & 15)]; } }
        f32x4 acc[4];
#pragma unroll
        for (int j = 0; j < 4; ++j) acc[j] = (f32x4){0.f, 0.f, 0.f, 0.f};
        unsigned msk = (unsigned)(__ballot(sl >= 0) & 0xffffull);
        while (msk) {
            int sidx[4]; v2u w[4][4];
#pragma unroll
            for (int q = 0; q < 4; ++q) { sidx[q] = -1; if (msk) { const int e = __builtin_ctz(msk); msk &= msk - 1u; sidx[q] = __builtin_amdgcn_readlane(sl, e); } }
#pragma unroll
            for (int q = 0; q < 4; ++q) if (sidx[q] >= 0) { const bf16* y = YB + (size_t)sidx[q] * 1024;
#pragma unroll
                for (int j = 0; j < 4; ++j) w[q][j] = *(const v2u*)(y + 4 * (64 * j + lane)); }
#pragma unroll
            for (int q = 0; q < 4; ++q) if (sidx[q] >= 0) {
#pragma unroll
                for (int j = 0; j < 4; ++j) acc[j] += (f32x4){bflo(w[q][j].x), bfhi(w[q][j].x), bflo(w[q][j].y), bfhi(w[q][j].y)}; }
        }
        const float* g2 = MOD + ((size_t)layer * 9 + rr) * 6144 + 5120;
#pragma unroll
        for (int j = 0; j < 4; ++j) *(f32x4*)(xr + 4 * (64 * j + lane)) = v[j] + *(const f32x4*)(g2 + 4 * (64 * j + lane)) * acc[j];
    }
}
__device__ __forceinline__ void unpack8(const v4u w, float* f) { f[0] = bflo(w.x); f[1] = bfhi(w.x); f[2] = bflo(w.y); f[3] = bfhi(w.y); f[4] = bflo(w.z); f[5] = bfhi(w.z); f[6] = bflo(w.w); f[7] = bfhi(w.w); }
__device__ __forceinline__ v4u pack8(const float* f) { v4u w; w.x = pk2(f[0], f[1]); w.y = pk2(f[2], f[3]); w.z = pk2(f[4], f[5]); w.w = pk2(f[6], f[7]); return w; }
__device__ __forceinline__ void unpack4(const v2u w, float* f) { f[0] = bflo(w.x); f[1] = bfhi(w.x); f[2] = bflo(w.y); f[3] = bfhi(w.y); }
__device__ __forceinline__ v2u pack4(const float* f) { v2u w; w.x = pk2(f[0], f[1]); w.y = pk2(f[2], f[3]); return w; }

struct MfRow { v4u cq; v2u ckv; v4u k0, k1; v2u kr0, kr1; v4u v0, v1; f32x4 cs, sn; };
__device__ __forceinline__ void mf_load(MfRow& R, int m, const bf16* KVPRE, const bf16* DOWN, const float* ca, const float* sa, int lane, int h, int p) {
    const bf16* dr = DOWN + (size_t)m * 1024;
    R.cq = *(const v4u*)(dr + 8 * lane); R.ckv = *(const v2u*)(dr + 512 + 4 * lane);
    const bf16* s = KVPRE + (size_t)m * 2048 + h * 128; const bf16* kr = dr + 768;
    { const v4u* pp = (const v4u*)(s + 16 * p); R.k0 = pp[0]; R.k1 = pp[1]; R.kr0 = *(const v2u*)(kr + 4 * p); R.kr1 = *(const v2u*)(kr + 16 + 4 * p); }
    { const v4u* vs = (const v4u*)(s + 64 + 16 * p); R.v0 = vs[0]; R.v1 = vs[1]; }
    if (m < NLAT) { const int t = m & 4095; R.cs = *(const f32x4*)(ca + t * 16 + 4 * p); R.sn = *(const f32x4*)(sa + t * 16 + 4 * p); }
    else { R.cs = (f32x4){1.f, 1.f, 1.f, 1.f}; R.sn = (f32x4){0.f, 0.f, 0.f, 0.f}; }
}
__device__ __forceinline__ void mla_finish_phase(Frame& F, const InPtrs& A, int j) {
    const int gw = F.vcu * NWAVES + F.wave, NGW = F.G * NWAVES, lane = F.lane, h = lane >> 2, p = lane & 3;
    const bf16* DOWN = (const bf16*)(F.ws + R_DOWN); const bf16* KVPRE = (const bf16*)(F.ws + R_KVPRE);
    bf16* MK = (bf16*)(F.ws + R_MK); bf16* MV = (bf16*)(F.ws + R_MV); float* RQ = (float*)(F.ws + WS_RQ);
    const float* ca = (const float*)(F.ws + WS_ROPEA); const float* sa = ca + 4096 * 16;
    float gk[24];
    { const float* k = A[I_MLA_KN] + j * 96;
#pragma unroll
      for (int i = 0; i < 16; ++i) gk[i] = k[16 * p + i];
#pragma unroll
      for (int i = 0; i < 4; ++i) { gk[16 + i] = k[64 + 4 * p + i]; gk[20 + i] = k[80 + 4 * p + i]; } }
    MfRow N;
    if (gw < MROWS) mf_load(N, gw, KVPRE, DOWN, ca, sa, lane, h, p);
    for (int m = gw; m < MROWS; m += NGW) {
        const MfRow R = N;
        { const int mn = m + NGW; if (mn < MROWS) mf_load(N, mn, KVPRE, DOWN, ca, sa, lane, h, p); }
        const bool lat = m < NLAT; const int b = lat ? (m >> 12) : ((m - NLAT) >> 8), t = lat ? (m & 4095) : ((m - NLAT) & 255);
        float c8[8], c4[4]; unpack8(R.cq, c8); unpack4(R.ckv, c4);
        float sq = 0.f, skv = 0.f;
#pragma unroll
        for (int i = 0; i < 8; ++i) sq += c8[i] * c8[i];
#pragma unroll
        for (int i = 0; i < 4; ++i) skv += c4[i] * c4[i];
        sq = wave_sum(sq); skv = wave_sum(skv);
        const float rq = 1.0f / sqrtf(sq * (1.0f / 512.0f) + EPS), rkv = 1.0f / sqrtf(skv * (1.0f / 256.0f) + EPS);
        if (lane == 0) RQ[m] = rq;
        float v[24]; unpack8(R.k0, v); unpack8(R.k1, v + 8); unpack4(R.kr0, v + 16); unpack4(R.kr1, v + 20);
#pragma unroll
        for (int i = 0; i < 16; ++i) v[i] *= rkv;
        float ss = 0.f;
#pragma unroll
        for (int i = 0; i < 24; ++i) ss += v[i] * v[i];
        ss += shx<1>(ss); ss += shx<2>(ss);
        const float r = 1.0f / sqrtf(ss * (1.0f / 96.0f) + EPS);
#pragma unroll
        for (int i = 0; i < 24; ++i) v[i] = v[i] * r * gk[i];
#pragma unroll
        for (int i = 0; i < 4; ++i) { const float x1 = v[16 + i], x2 = v[20 + i]; v[16 + i] = x1 * R.cs[i] - x2 * R.sn[i]; v[20 + i] = x1 * R.sn[i] + x2 * R.cs[i]; }
        const int key = lat ? 256 + t : t;
        bf16* d = MK + (((size_t)b * 16 + h) * NKEYS + key) * 96;
        { v4u* o = (v4u*)(d + 16 * p); o[0] = pack8(v); o[1] = pack8(v + 8); *(v2u*)(d + 64 + 4 * p) = pack4(v + 16); *(v2u*)(d + 80 + 4 * p) = pack4(v + 20); }
        float vv[16]; unpack8(R.v0, vv); unpack8(R.v1, vv + 8);
#pragma unroll
        for (int i = 0; i < 16; ++i) vv[i] *= rkv;
        v4u* vd = (v4u*)(MV + (((size_t)b * 16 + h) * NKEYS + key) * 64 + 16 * p);
        vd[0] = pack8(vv); vd[1] = pack8(vv + 8);
    }
}
struct DqRow { v4u q0, q1, k0, k1; f32x4 c0, c1, s0, s1; };
__device__ __forceinline__ void dq_load(DqRow& R, int m, const bf16* QKV, const float* cb, const float* sb, int u, int p) {
    const bf16* s = QKV + (size_t)m * 3072 + u * 64;
    R.q0 = *(const v4u*)(s + 8 * p); R.q1 = *(const v4u*)(s + 32 + 8 * p); R.k0 = *(const v4u*)(s + 1024 + 8 * p); R.k1 = *(const v4u*)(s + 1024 + 32 + 8 * p);
    if (m < NLAT) { const int t = m & 4095; R.c0 = *(const f32x4*)(cb + t * 32 + 8 * p); R.c1 = *(const f32x4*)(cb + t * 32 + 8 * p + 4); R.s0 = *(const f32x4*)(sb + t * 32 + 8 * p); R.s1 = *(const f32x4*)(sb + t * 32 + 8 * p + 4); }
    else { R.c0 = R.c1 = (f32x4){1.f, 1.f, 1.f, 1.f}; R.s0 = R.s1 = (f32x4){0.f, 0.f, 0.f, 0.f}; }
}
__device__ __forceinline__ void diff_finish_qk_phase(Frame& F, const InPtrs& A) {
    const int gw = F.vcu * NWAVES + F.wave, NGW = F.G * NWAVES, lane = F.lane, u = lane >> 2, p = lane & 3;
    const bf16* QKV = (const bf16*)(F.ws + R_QKV);
    bf16* DQ = (bf16*)(F.ws + R_DQ); bf16* DQC = (bf16*)(F.ws + R_DQC); bf16* DK = (bf16*)(F.ws + R_DK);
    const float* cb = (const float*)(F.ws + WS_ROPEB); const float* sb = cb + 4096 * 32;
    float gq[16], gk[16];
    { const float* qn = A[I_DF_QN]; const float* kn = A[I_DF_KN];
#pragma unroll
      for (int i = 0; i < 8; ++i) { gq[i] = qn[8 * p + i] * att::Sc<64>::C; gq[8 + i] = qn[32 + 8 * p + i] * att::Sc<64>::C; gk[i] = kn[8 * p + i]; gk[8 + i] = kn[32 + 8 * p + i]; } }
    DqRow N;
    if (gw < MROWS) dq_load(N, gw, QKV, cb, sb, u, p);
    for (int m = gw; m < MROWS; m += NGW) {
        const DqRow R = N;
        { const int mn = m + NGW; if (mn < MROWS) dq_load(N, mn, QKV, cb, sb, u, p); }
        const bool lat = m < NLAT; const int b = lat ? (m >> 12) : ((m - NLAT) >> 8), t = lat ? (m & 4095) : ((m - NLAT) & 255);
        float cs[8], sn[8];
#pragma unroll
        for (int i = 0; i < 4; ++i) { cs[i] = R.c0[i]; cs[4 + i] = R.c1[i]; sn[i] = R.s0[i]; sn[4 + i] = R.s1[i]; }
#pragma unroll
        for (int isk = 0; isk < 2; ++isk) {
            float v[16]; unpack8(isk ? R.k0 : R.q0, v); unpack8(isk ? R.k1 : R.q1, v + 8);
            float ss = 0.f;
#pragma unroll
            for (int i = 0; i < 16; ++i) ss += v[i] * v[i];
            ss += shx<1>(ss); ss += shx<2>(ss);
            const float r = 1.0f / sqrtf(ss * (1.0f / 64.0f) + EPS);
#pragma unroll
            for (int i = 0; i < 16; ++i) v[i] = v[i] * r * (isk ? gk[i] : gq[i]);
#pragma unroll
            for (int i = 0; i < 8; ++i) { const float x1 = v[i], x2 = v[8 + i]; v[i] = x1 * cs[i] - x2 * sn[i]; v[8 + i] = x1 * sn[i] + x2 * cs[i]; }
            bf16* d;
            if (isk) d = DK + (((size_t)b * 16 + u) * NKEYS + (lat ? 256 + t : t)) * 64;
            else d = lat ? DQ + (((size_t)b * 16 + u) * 4096 + t) * 64 : DQC + (((size_t)b * 16 + u) * 256 + t) * 64;
            *(v4u*)(d + 8 * p) = pack8(v); *(v4u*)(d + 32 + 8 * p) = pack8(v + 8);
        }
    }
}
__device__ __forceinline__ void diff_finish_o_phase(Frame& F, const InPtrs& A, float lam_init) {
    const int gw = F.vcu * NWAVES + F.wave, NGW = F.G * NWAVES, lane = F.lane, h = lane >> 3, p = lane & 7;
    const bf16* OB = (const bf16*)(F.ws + R_OB); bf16* AO = (bf16*)(F.ws + R_DAO);
    const float d1 = wave_sum(A[I_DF_LQ1][lane] * A[I_DF_LK1][lane]), d2 = wave_sum(A[I_DF_LQ2][lane] * A[I_DF_LK2][lane]);
    const float lam = expf(d1) - expf(d2) + lam_init, post = 1.0f - lam_init;
    float g[16];
    { const float* sg = A[I_DF_SUBG];
#pragma unroll
      for (int i = 0; i < 16; ++i) g[i] = sg[16 * p + i] * post; }
    v4u n0 = (v4u){0u, 0u, 0u, 0u}, n1 = n0, n2 = n0, n3 = n0;
    if (gw < MROWS) { const bf16* s0 = OB + (size_t)gw * 2048 + (2 * h) * 128 + 16 * p; n0 = ((const v4u*)s0)[0]; n1 = ((const v4u*)s0)[1]; n2 = ((const v4u*)(s0 + 128))[0]; n3 = ((const v4u*)(s0 + 128))[1]; }
    for (int m = gw; m < MROWS; m += NGW) {
        const v4u c0 = n0, c1 = n1, c2 = n2, c3 = n3;
        { const int mn = m + NGW; if (mn < MROWS) { const bf16* s0 = OB + (size_t)mn * 2048 + (2 * h) * 128 + 16 * p; n0 = ((const v4u*)s0)[0]; n1 = ((const v4u*)s0)[1]; n2 = ((const v4u*)(s0 + 128))[0]; n3 = ((const v4u*)(s0 + 128))[1]; } }
        float a[16], c[16];
        unpack8(c0, a); unpack8(c1, a + 8); unpack8(c2, c); unpack8(c3, c + 8);
        float ss = 0.f;
#pragma unroll
        for (int i = 0; i < 16; ++i) { a[i] = a[i] - lam * c[i]; ss += a[i] * a[i]; }
        ss += shx<1>(ss); ss += shx<2>(ss); ss += shx<4>(ss);
        const float r = 1.0f / sqrtf(ss * (1.0f / 128.0f) + EPS);
#pragma unroll
        for (int i = 0; i < 16; ++i) a[i] = a[i] * r * g[i];
        v4u* o = (v4u*)(AO + (size_t)m * 1024 + h * 128 + 16 * p); o[0] = pack8(a); o[1] = pack8(a + 8);
    }
}
__device__ __forceinline__ void sg_ln_item(Frame& F, const InPtrs& A, int chunk, int g_lo, int g_hi) {
    const bf16* Z = (const bf16*)(F.ws + R_Z); bf16* VNT = (bf16*)(F.ws + R_VNT);
    LAS float* st = (LAS float*)F.lds;
    LAS unsigned short* T = (LAS unsigned short*)(F.lds + 1024);
    constexpr int TS = 258;
    const int lane = F.lane, tid = F.tid;
    {
        const bf16* vr0 = Z + ((size_t)chunk * 128 + F.wave * 16) * 4096 + 2048;
        v4u nx[4];
#pragma unroll
        for (int i = 0; i < 4; ++i) nx[i] = *(const v4u*)(vr0 + 8 * (lane + 64 * i));
        for (int qi = 0; qi < 16; ++qi) {
            float x[32];
#pragma unroll
            for (int i = 0; i < 4; ++i) unpack8(nx[i], x + 8 * i);
            if (qi < 15) {
#pragma unroll
                for (int i = 0; i < 4; ++i) nx[i] = *(const v4u*)(vr0 + (size_t)(qi + 1) * 4096 + 8 * (lane + 64 * i)); }
            float s = 0.f;
#pragma unroll
            for (int i = 0; i < 32; ++i) s += x[i];
            const float mean = wave_sum(s) * (1.0f / 2048.0f); float s2 = 0.f;
#pragma unroll
            for (int i = 0; i < 32; ++i) { const float d = x[i] - mean; s2 += d * d; }
            const float rstd = 1.0f / sqrtf(wave_sum(s2) * (1.0f / 2048.0f) + EPS);
            const int q = F.wave * 16 + qi;
            if (lane == 0) { st[2 * q] = mean; st[2 * q + 1] = rstd; }
        }
    }
    __syncthreads();
    for (int g = g_lo; g < g_hi; ++g) {
        v4u xin[8];
#pragma unroll
        for (int i = 0; i < 8; ++i) { const int id = tid + 512 * i, q = id >> 5, c0 = (id & 31) * 8; xin[i] = *(const v4u*)(Z + ((size_t)chunk * 128 + q) * 4096 + 2048 + g * 256 + c0); }
#pragma unroll
        for (int i = 0; i < 8; ++i) { const int id = tid + 512 * i, q = id >> 5, c0 = (id & 31) * 8;
            float x[8]; unpack8(xin[i], x);
            const float mean = st[2 * q], rstd = st[2 * q + 1];
            const float* lg = A[I_SG_LNG] + g * 256 + c0; const float* lb = A[I_SG_LNB] + g * 256 + c0;
#pragma unroll
            for (int k = 0; k < 8; ++k) T[q * TS + c0 + k] = (unsigned short)f2bf((x[k] - mean) * rstd * lg[k] + lb[k]); }
        __syncthreads();
#pragma unroll
        for (int i = 0; i < 8; ++i) { const int id = tid + 512 * i, c = id >> 4, q0 = (id & 15) * 8;
            v4u w; w.x = (unsigned)T[(q0 + 0) * TS + c] | ((unsigned)T[(q0 + 1) * TS + c] << 16); w.y = (unsigned)T[(q0 + 2) * TS + c] | ((unsigned)T[(q0 + 3) * TS + c] << 16);
            w.z = (unsigned)T[(q0 + 4) * TS + c] | ((unsigned)T[(q0 + 5) * TS + c] << 16); w.w = (unsigned)T[(q0 + 6) * TS + c] | ((unsigned)T[(q0 + 7) * TS + c] << 16);
            *(v4u*)(VNT + (((size_t)chunk * 8 + g) * 256 + c) * 128 + q0) = w; }
        __syncthreads();
    }
}
__device__ __forceinline__ void sg_ln_phase(Frame& F, const InPtrs& A) {
    constexpr int NCH = MROWS / 128;
    const int full = (NCH / F.G) * F.G;
    for (int chunk = F.vcu; chunk < full; chunk += F.G) sg_ln_item(F, A, chunk, 0, 8);
    for (int it = F.vcu; it < (NCH - full) * 8; it += F.G) sg_ln_item(F, A, full + (it >> 3), it & 7, (it & 7) + 1);
}
__device__ __forceinline__ void topk_phase(Frame& F, int ngroups) {
    const float* AFF = (const float*)(F.ws + WS_AFF); int* SLOT = (int*)(F.ws + WS_SLOT); float* GATE = (float*)(F.ws + WS_GATE);
    int* ROWSRC = (int*)(F.ws + R_XG);
    LAS unsigned* cnt = (LAS unsigned*)F.lds;
    LAS unsigned* cgt = cnt + 16;
    LAS unsigned* ceq = cnt + 80;
    LAS unsigned* tot = cnt + 144;
    LAS int* selrow = (LAS int*)(cnt + 160);
    const int tid = F.tid, lane = F.lane, wave = F.wave;
    for (int task = blockIdx.x; task < ngroups; task += F.G) {
        const bool lat = task < 128; const int gi = lat ? task : task - 128, b = gi >> 4, e = gi & 15;
        const int N = lat ? 4096 : 256, K = lat ? CAP_LAT : CAP_CTX, row0 = lat ? b * 4096 : NLAT + b * 256;
        const int pbase = e * EROWS + (lat ? b * CAP_LAT : NB * CAP_LAT + b * CAP_CTX);
        unsigned key[8]; bool valid[8];
#pragma unroll
        for (int i = 0; i < 8; ++i) { const int t = tid + 512 * i; valid[i] = t < N; key[i] = valid[i] ? __float_as_uint(AFF[(size_t)(row0 + t) * 16 + e]) : 0u; }
        unsigned prefix = 0u;
        for (int bit = 30; bit >= 0; --bit) {
            const unsigned cand = prefix | (1u << bit); unsigned c = 0;
#pragma unroll
            for (int i = 0; i < 8; ++i) c += (unsigned)__builtin_popcountll(__ballot(valid[i] && key[i] >= cand));
            LAS unsigned* cb = cnt + 8 * (bit & 1);
            if (lane == 0) cb[wave] = c;
            __syncthreads();
            unsigned total = 0;
#pragma unroll
            for (int w = 0; w < 8; ++w) total += cb[w];
            if (total >= (unsigned)K) prefix = cand;
        }
        const unsigned T = prefix;
        unsigned long long bgt[8], beq[8];
#pragma unroll
        for (int i = 0; i < 8; ++i) { bgt[i] = __ballot(valid[i] && key[i] > T); beq[i] = __ballot(valid[i] && key[i] == T);
            if (lane == 0) { cgt[i * 8 + wave] = (unsigned)__builtin_popcountll(bgt[i]); ceq[i * 8 + wave] = (unsigned)__builtin_popcountll(beq[i]); } }
        __syncthreads();
        if (wave == 0) {
            unsigned pa = 0u, pq = 0u, ta = 0u, tq = 0u;
            for (int k = 0; k < 64; ++k) { const unsigned a = cgt[k], q = ceq[k]; ta += a; tq += q; if (k < lane) { pa += a; pq += q; } }
            LDS_WAIT();
            cgt[lane] = pa; ceq[lane] = pq;
            if (lane == 63) { tot[0] = ta; tot[1] = tq; }
        }
        __syncthreads();
        const unsigned n_gt = tot[0], need_eq = (unsigned)K - n_gt;
        const unsigned long long lmask = (1ull << lane) - 1ull;
#pragma unroll
        for (int i = 0; i < 8; ++i) {
            const bool isgt = (bgt[i] >> lane) & 1ull, iseq = (beq[i] >> lane) & 1ull;
            const unsigned pg = cgt[i * 8 + wave] + (unsigned)__builtin_popcountll(bgt[i] & lmask), pe = ceq[i * 8 + wave] + (unsigned)__builtin_popcountll(beq[i] & lmask);
            const bool sel = isgt || (iseq && pe < need_eq);
            if (sel) { const unsigned pos = isgt ? pg : n_gt + pe; const int row = row0 + tid + 512 * i;
                SLOT[(size_t)row * 16 + e] = pbase + (int)pos; GATE[pbase + pos] = __uint_as_float(key[i]); ROWSRC[pbase + pos] = row; }
        }
        __syncthreads();
        __syncthreads();
    }
}

template <int DK> __device__ __forceinline__ float att_bound(const float* gq, const float* gk, int n, int lane) {
    float mq = 0.f, mk = 0.f;
    for (int i = lane; i < n; i += 64) { mq = fmaxf(mq, fabsf(gq[i])); mk = fmaxf(mk, fabsf(gk[i])); }
    mq = fmaxf(mq, shx<1>(mq)); mq = fmaxf(mq, shx<2>(mq)); mq = fmaxf(mq, shx<4>(mq)); mq = fmaxf(mq, shx<8>(mq)); mq = fmaxf(mq, shx<16>(mq));
    mk = fmaxf(mk, shx<1>(mk)); mk = fmaxf(mk, shx<2>(mk)); mk = fmaxf(mk, shx<4>(mk)); mk = fmaxf(mk, shx<8>(mk)); mk = fmaxf(mk, shx<16>(mk));
    mq = fmaxf(__builtin_bit_cast(float, __builtin_amdgcn_readlane(__builtin_bit_cast(int, mq), 0)), __builtin_bit_cast(float, __builtin_amdgcn_readlane(__builtin_bit_cast(int, mq), 32)));
    mk = fmaxf(__builtin_bit_cast(float, __builtin_amdgcn_readlane(__builtin_bit_cast(int, mk), 0)), __builtin_bit_cast(float, __builtin_amdgcn_readlane(__builtin_bit_cast(int, mk), 32)));
    const float bound = sqrtf((float)DK) * mq * mk;
    return __builtin_bit_cast(float, __builtin_amdgcn_readfirstlane(__builtin_bit_cast(int, bound)));
}
__device__ __forceinline__ void mla_attn_phase(Frame& F, const InPtrs& A, int jl, bool do_ctx, int conv_layer) {
    int cround = 0;
    const bf16* QPRE = (const bf16*)(F.ws + R_QPRE); const float* RQ = (const float*)(F.ws + WS_RQ); const bf16* MK = (const bf16*)(F.ws + R_MK); const bf16* MV = (const bf16*)(F.ws + R_MV);
    bf16* AO = (bf16*)(F.ws + R_AO);
    const float* gq = A[I_MLA_QN] + jl * 96; const float* ropeA = (const float*)(F.ws + WS_ROPEA);
    const float bound = att_bound<96>(gq, A[I_MLA_KN] + jl * 96, 96, F.lane);
    const bool use_off = bound > 60.0f;
    const int nunits = 2048 + (do_ctx ? 128 : 0);
    for (int u = F.vcu; u < nunits; u += F.G) {
        const bool lat = u < 2048; const int bh = lat ? (u >> 4) : (u - 2048), qb = lat ? (u & 15) : 0, b = bh >> 4, h = bh & 15;
        const int row0 = lat ? b * 4096 + qb * 256 : NLAT + b * 256;
        const att::QLoadMLA QL{QPRE + (size_t)row0 * 1536 + h * 96, RQ + row0, gq, lat ? ropeA + (size_t)(qb * 256) * 16 : nullptr};
        const bf16* Kp = MK + (size_t)bh * NKEYS * 96; const bf16* Vp = MV + (size_t)bh * NKEYS * 64;
        bf16* Op = AO + (size_t)row0 * 1024 + h * 64;
        if (!use_off) att::body_dma<96, 64, false>(QL, Kp, Kp + 256 * 96, 96, Vp, Vp + 256 * 64, 64, Op, 1024, lat ? NKEYS : 256, 0.f, (char*)F.lds, F.tid);
        else { int bi_ = __builtin_amdgcn_readfirstlane(__builtin_bit_cast(int, bound)); asm volatile("" : "+s"(bi_)); const float nm_ = -fminf(__builtin_bit_cast(float, bi_), 30.0f) * 1.4426950408889634f;     att::body<96, 64, 2, true>(QL, Kp, Kp + 256 * 96, 96, Vp, Vp + 256 * 64, 64, Op, 1024, lat ? NKEYS : 256, nm_, (char*)F.lds, F.tid); }
        if (conv_layer >= 0 && cround < conv_rounds(F)) { moe_weight_round(F, A, conv_layer, cround); ++cround; __syncthreads(); }
    }
    if (conv_layer >= 0) for (; cround < conv_rounds(F); ++cround) moe_weight_round(F, A, conv_layer, cround);
}
__device__ __forceinline__ void diff_attn_phase(Frame& F, const InPtrs& A, bool do_ctx, int conv_layer) {
    int cround = 0;
    const bf16* DQ = (const bf16*)(F.ws + R_DQ); const bf16* DQC = (const bf16*)(F.ws + R_DQC); const bf16* DKp = (const bf16*)(F.ws + R_DK); const bf16* QKV = (const bf16*)(F.ws + R_QKV);
    bf16* OB = (bf16*)(F.ws + R_OB);
    const float bound = att_bound<64>(A[I_DF_QN], A[I_DF_KN], 64, F.lane);
    const bool use_off = bound > 60.0f;
    const int nunits = 2048 + (do_ctx ? 128 : 0);
    for (int u = F.vcu; u < nunits; u += F.G) {
        const bool lat = u < 2048; const int bh = lat ? (u >> 4) : (u - 2048), qb = lat ? (u & 15) : 0, b = bh >> 4, vh = bh & 15, h = vh >> 1;
        const bf16* Qp = lat ? DQ + ((size_t)bh * 4096 + qb * 256) * 64 : DQC + (size_t)bh * 256 * 64;
        const bf16* Kp = DKp + (size_t)bh * NKEYS * 64;
        const bf16* V0 = QKV + (size_t)(NLAT + b * 256) * 3072 + 2048 + h * 128; const bf16* V1 = QKV + (size_t)(b * 4096) * 3072 + 2048 + h * 128;
        bf16* Op = OB + (size_t)(lat ? b * 4096 + qb * 256 : NLAT + b * 256) * 2048 + vh * 128;
        const att::QLoadPlain QL{Qp, 64};
        if (!use_off) att::body_dma<64, 128, false>(QL, Kp, Kp + 256 * 64, 64, V0, V1, 3072, Op, 2048, lat ? NKEYS : 256, 0.f, (char*)F.lds, F.tid);
        else { int bi_ = __builtin_amdgcn_readfirstlane(__builtin_bit_cast(int, bound)); asm volatile("" : "+s"(bi_)); const float nm_ = -fminf(__builtin_bit_cast(float, bi_), 30.0f) * 1.4426950408889634f;     att::body<64, 128, 1, true>(QL, Kp, Kp + 256 * 64, 64, V0, V1, 3072, Op, 2048, lat ? NKEYS : 256, nm_, (char*)F.lds, F.tid); }
        if (conv_layer >= 0 && cround < conv_rounds(F)) { moe_weight_round(F, A, conv_layer, cround); ++cround; __syncthreads(); }
    }
    if (conv_layer >= 0) for (; cround < conv_rounds(F); ++cround) moe_weight_round(F, A, conv_layer, cround);
}

#ifndef PG8_SP2
#define PG8_SP2 true
#endif
#ifndef PG8_ALIGN
#define PG8_ALIGN true
#endif
#define GEMM_CALL(EPI, ORD, g, S, E) pg8::gemm_phase<EPI, ORD, PG8_ALIGN, PG8_SP2>(F.lds, g, S, E, F.tid)

__global__ void __launch_bounds__(NTHREADS, 2) fwd_kernel(Args args) {
    extern __shared__ __attribute__((aligned(16))) unsigned char lds[];
    Frame FM;
    FM.lds = (LAS unsigned char*)lds;
    FM.tid = threadIdx.x; FM.lane = FM.tid & 63; FM.wave = __builtin_amdgcn_readfirstlane(FM.tid >> 6);
    FM.G = gridDim.x; { const int bx = blockIdx.x; FM.vcu = (FM.G % 8 == 0) ? (bx % 8) * (FM.G / 8) + bx / 8 : bx; }
    FM.ws = args.ws; FM.out = args.out;
    volatile LAS unsigned* MISC = (volatile LAS unsigned*)(FM.lds + MISC_OFF);
    if (FM.tid < 16) MISC[FM.tid] = 0u;
    if (FM.tid < 35) { const unsigned long long p = (unsigned long long)args.in[FM.tid]; MISC[16 + 2 * FM.tid] = (unsigned)p; MISC[17 + 2 * FM.tid] = (unsigned)(p >> 32); }
    __syncthreads();
    InPtrs A; A.tab = MISC + 16;
    XcdBarrier bar = xcd_barrier_post((unsigned*)(FM.ws + WS_CTL) + 4096, MISC + 8); bar.wave = FM.wave;
    const int lo = args.ph_lo, hi = args.ph_hi;
    int ph = 0;
#ifndef PHASE_MASK
#define PHASE_MASK 0xFFFFFFFFu
#endif
#define EN(b) ((PHASE_MASK >> (b)) & 1u)
#ifndef REP_MASK
#define REP_MASK 0u
#endif
#ifndef BAR_REP
#define BAR_REP 1
#endif
#define REPN(b) (((REP_MASK >> (b)) & 1u) ? 2 : 1)
#define PH_BEGIN if (ph >= lo && ph < hi) { Frame F = FM; { int t_ = FM.wave * 64 + hw_lane(); asm volatile("" : "+v"(t_)); F.tid = t_; F.lane = t_ & 63; F.wave = __builtin_amdgcn_readfirstlane(t_ >> 6); \
        size_t z_ = 0; asm volatile("" : "+s"(z_), "+s"(F.vcu), "+s"(F.G)); F.ws = FM.ws + z_; F.out = FM.out + z_; } \
        const float* MOD = (const float*)(F.ws + WS_MOD); bf16* H = (bf16*)(F.ws + WS_H); (void)MOD; (void)H;
#define PH_END   if (ph + 1 < hi) { for (int br_ = 0; br_ < BAR_REP; ++br_) xcd_barrier(bar); } } ++ph;

    PH_BEGIN for (int rep_ = 0; rep_ < REPN(0); ++rep_) if (EN(0)) p0_prologue(F, A); PH_END

    for (int layer = 0; layer < DEPTH; ++layer) {
        const int kind = layer % 3, jl = layer / 3;
        const bool last = layer == DEPTH - 1, ctx_out = !last;
        const int rows_out = ctx_out ? MROWS : NLAT;

        PH_BEGIN for (int rep_ = 0; rep_ < REPN(1); ++rep_) if (EN(1)) { if (layer == 0 && rep_ == 0) norm_phase<false, true>(F, A, layer, false, MROWS); else norm_phase<false, false>(F, A, layer, layer > 0, MROWS, rep_ == 0 ? 1.0f : 0.0f); } PH_END

        if (kind == 0) {
            const size_t wboff = WS_WNM + jl * MLA_W_STRIDE;
#define wb (F.ws + wboff)
            PH_BEGIN for (int rep_ = 0; rep_ < REPN(2); ++rep_) if (EN(2)) { pg8::Gemm g{H, (const bf16*)(wb + MLA_WIN), MROWS, 1024, 1024}; pg8::StaticOrder S; S.init(MROWS, 1024, F.G, (int)blockIdx.x);
                pg8::EpiStore<0> E{(bf16*)(F.ws + R_DOWN), 1024}; GEMM_CALL(pg8::EpiStore<0>, pg8::StaticOrder, g, S, E); } PH_END
            PH_BEGIN for (int rep_ = 0; rep_ < REPN(2); ++rep_) if (EN(2)) { { pg8::Gemm g{(const bf16*)(F.ws + R_DOWN), (const bf16*)(wb + MLA_WUQ), rows_out, 1536, 512, 1024}; pg8::StaticOrder S; S.init(rows_out, 1536, F.G, (int)blockIdx.x);
                         pg8::EpiStore<0> E{(bf16*)(F.ws + R_QPRE), 1536}; GEMM_CALL(pg8::EpiStore<0>, pg8::StaticOrder, g, S, E); }
                       __syncthreads();
                       { pg8::Gemm g{(const bf16*)(F.ws + R_DOWN) + 512, (const bf16*)(wb + MLA_WUKV), MROWS, 2048, 256, 1024}; pg8::StaticOrder S;
                         const int r1_ = ((rows_out / 256) * 6) % F.G; S.init(MROWS, 2048, F.G, (F.G % 8 == 0 && r1_ % 8 == 0) ? ((int)blockIdx.x + F.G - r1_) % F.G : (int)blockIdx.x);
                         pg8::EpiStore<0> E{(bf16*)(F.ws + R_KVPRE), 2048}; GEMM_CALL(pg8::EpiStore<0>, pg8::StaticOrder, g, S, E); } } PH_END
            PH_BEGIN for (int rep_ = 0; rep_ < REPN(3); ++rep_) if (EN(3)) mla_finish_phase(F, A, jl); PH_END
            PH_BEGIN for (int rep_ = 0; rep_ < REPN(4); ++rep_) if (EN(4)) mla_attn_phase(F, A, jl, ctx_out, (EN(15) && rep_ == 0) ? layer : -1); PH_END
            PH_BEGIN for (int rep_ = 0; rep_ < REPN(14); ++rep_) if (EN(14)) { pg8::Gemm g{(const bf16*)(F.ws + R_AO), (const bf16*)(wb + MLA_WOUT), rows_out, 1024, 1024}; pg8::StaticOrder S; S.init(rows_out, 1024, F.G, (int)blockIdx.x);
                pg8::EpiResid E{(bf16*)(F.ws + WS_XB), MOD + (size_t)layer * 9 * 6144 + 2048, rep_ == 0 ? 1.0f : 0.0f}; GEMM_CALL(pg8::EpiResid, pg8::StaticOrder, g, S, E); } PH_END
#undef wb
        } else if (kind == 1) {
            PH_BEGIN for (int rep_ = 0; rep_ < REPN(12); ++rep_) if (EN(12)) { pg8::Gemm g{H, (const bf16*)(F.ws + WS_DIFF_WIN), MROWS, 3072, 1024}; pg8::StaticOrder S; S.init(MROWS, 3072, F.G, (int)blockIdx.x);
                pg8::EpiStore<0> E{(bf16*)(F.ws + R_QKV), 3072}; GEMM_CALL(pg8::EpiStore<0>, pg8::StaticOrder, g, S, E); } PH_END
            PH_BEGIN for (int rep_ = 0; rep_ < REPN(5); ++rep_) if (EN(5)) diff_finish_qk_phase(F, A); PH_END
            PH_BEGIN for (int rep_ = 0; rep_ < REPN(6); ++rep_) if (EN(6)) diff_attn_phase(F, A, ctx_out, (EN(15) && rep_ == 0) ? layer : -1); PH_END
            PH_BEGIN for (int rep_ = 0; rep_ < REPN(5); ++rep_) if (EN(5)) diff_finish_o_phase(F, A, 0.8f - 0.6f * expf(-0.3f * (float)layer)); PH_END
            PH_BEGIN for (int rep_ = 0; rep_ < REPN(14); ++rep_) if (EN(14)) { pg8::Gemm g{(const bf16*)(F.ws + R_DAO), (const bf16*)(F.ws + WS_DIFF_WOUT), rows_out, 1024, 1024}; pg8::StaticOrder S; S.init(rows_out, 1024, F.G, (int)blockIdx.x);
                pg8::EpiResid E{(bf16*)(F.ws + WS_XB), MOD + (size_t)layer * 9 * 6144 + 2048, rep_ == 0 ? 1.0f : 0.0f}; GEMM_CALL(pg8::EpiResid, pg8::StaticOrder, g, S, E); } PH_END
        } else {
            PH_BEGIN for (int rep_ = 0; rep_ < REPN(13); ++rep_) if (EN(13)) { pg8::Gemm g{H, (const bf16*)(F.ws + WS_SG_WIN), MROWS, 4096, 1024}; pg8::StaticOrder S; S.init(MROWS, 4096, F.G, (int)blockIdx.x);
                pg8::EpiStore<1> E{(bf16*)(F.ws + R_Z), 4096}; GEMM_CALL(pg8::EpiStore<1>, pg8::StaticOrder, g, S, E); } PH_END
            PH_BEGIN for (int rep_ = 0; rep_ < REPN(7); ++rep_) if (EN(7)) sg_ln_phase(F, A); PH_END
            PH_BEGIN for (int rep_ = 0; rep_ < REPN(13); ++rep_) if (EN(13)) { pg8::Gemm g{(const bf16*)(F.ws + WS_SG_WS), (const bf16*)(F.ws + R_VNT), 2048, 0, 128}; pg8::SpatialOrder S; S.init((MROWS / 128) * 8, F.G, F.vcu);
                pg8::EpiSpatial E{(bf16*)(F.ws + R_UV), (const bf16*)(F.ws + R_Z), A[I_SG_BS]}; GEMM_CALL(pg8::EpiSpatial, pg8::SpatialOrder, g, S, E); } PH_END
            PH_BEGIN for (int rep_ = 0; rep_ < REPN(14); ++rep_) if (EN(14)) { pg8::Gemm g{(const bf16*)(F.ws + R_UV), (const bf16*)(F.ws + WS_SG_WOUT), rows_out, 1024, 2048}; pg8::StaticOrder S; S.init(rows_out, 1024, F.G, (int)blockIdx.x);
                pg8::EpiResid E{(bf16*)(F.ws + WS_XB), MOD + (size_t)layer * 9 * 6144 + 2048, rep_ == 0 ? 1.0f : 0.0f}; GEMM_CALL(pg8::EpiResid, pg8::StaticOrder, g, S, E); } PH_END
        }

        PH_BEGIN { for (int rep_ = 0; rep_ < REPN(8); ++rep_) if (EN(8)) { norm_phase<true, false>(F, A, layer, false, rows_out); __syncthreads(); } for (int rep_ = 0; rep_ < REPN(15); ++rep_) if (EN(15) && kind == 2) { moe_weight_items(F, A, layer); __syncthreads(); } } PH_END
        PH_BEGIN for (int rep_ = 0; rep_ < REPN(9); ++rep_) if (EN(9)) topk_phase(F, ctx_out ? 256 : 128); PH_END
        PH_BEGIN for (int rep_ = 0; rep_ < REPN(10); ++rep_) if (EN(10)) { pg8::Gemm g{H, (const bf16*)(F.ws + WS_WGU), MOE_ROWS, 0, 1024}; pg8::MoeOrder S; S.init(ctx_out ? 17 : 16, 8, F.G, F.vcu);
            pg8::EpiSwiGLU E{(bf16*)(F.ws + R_HID), 8}; pg8::gemm_phase<pg8::EpiSwiGLU, pg8::MoeOrder, PG8_ALIGN, PG8_SP2, true>(F.lds, g, S, E, F.tid, (const int*)(F.ws + R_XG), (LAS int*)(F.lds + RING_BYTES)); } PH_END
        PH_BEGIN for (int rep_ = 0; rep_ < REPN(10); ++rep_) if (EN(10)) { pg8::Gemm g{(const bf16*)(F.ws + R_HID), (const bf16*)(F.ws + WS_WDN), MOE_ROWS, 0, 1024}; pg8::MoeOrder S; S.init(ctx_out ? 17 : 16, 4, F.G, F.vcu);
            pg8::EpiMoeDown E{(bf16*)(F.ws + R_YB), (const float*)(F.ws + WS_GATE)}; GEMM_CALL(pg8::EpiMoeDown, pg8::MoeOrder, g, S, E); } PH_END
    }
    PH_BEGIN for (int rep_ = 0; rep_ < REPN(11); ++rep_) if (EN(11)) final_phase(F, DEPTH - 1); PH_END
#undef PH_BEGIN
#undef PH_END
}
constexpr int N_PHASES = 1 + (1 + 5 + 4) + (1 + 5 + 4) + (1 + 4 + 4) + (1 + 5 + 4) + 1;

extern "C" void kernel_launch(void* const* d_in, const int* in_sizes, int n_in, void* d_out, int out_size, void* d_ws, size_t ws_size, hipStream_t stream) {
    static int grid = 0;
    if (grid == 0) {
        if (n_in != 35 || in_sizes[0] != NLAT * D || out_size != NLAT * D || ws_size < WS_END) {
            fprintf(stderr, "kernel_launch: unexpected shapes: n_in %d in0 %d out %d ws %zu (need >= %zu); nothing launched\n", n_in, n_in > 0 ? in_sizes[0] : -1, out_size, ws_size, (size_t)WS_END); grid = -1; return; }
        int dev = 0, cus = 0, per_cu = 0;
        if (hipGetDevice(&dev) != hipSuccess || hipDeviceGetAttribute(&cus, hipDeviceAttributeMultiprocessorCount, dev) != hipSuccess) { fprintf(stderr, "kernel_launch: device query failed\n"); grid = -1; return; }
        if (hipFuncSetAttribute((const void*)fwd_kernel, hipFuncAttributeMaxDynamicSharedMemorySize, LDS_BYTES) != hipSuccess) { fprintf(stderr, "kernel_launch: hipFuncSetAttribute failed\n"); grid = -1; return; }
        if (hipOccupancyMaxActiveBlocksPerMultiprocessor(&per_cu, (const void*)fwd_kernel, NTHREADS, LDS_BYTES) != hipSuccess || per_cu < 1)
            fprintf(stderr, "kernel_launch: note: occupancy query reports %d workgroups per CU\n", per_cu);
        (void)hipGetLastError();
        grid = cus;
    }
    if (grid < 0) return;
    if (hipMemsetAsync((char*)d_ws + WS_CTL, 0, CTL_ZERO_BYTES, stream) != hipSuccess) { fprintf(stderr, "kernel_launch: memset failed\n"); return; }
    Args a{};
    for (int i = 0; i < 35; ++i) a.in[i] = (const float*)d_in[i];
    a.out = (float*)d_out; a.ws = (unsigned char*)d_ws;
#if MK_PER_PHASE
    for (int p = 0; p < N_PHASES; ++p) { a.ph_lo = p; a.ph_hi = p + 1; hipLaunchKernelGGL(fwd_kernel, dim3(grid), dim3(NTHREADS), LDS_BYTES, stream, a); }
#else
    a.ph_lo = 0; a.ph_hi = N_PHASES;
    hipLaunchKernelGGL(fwd_kernel, dim3(grid), dim3(NTHREADS), LDS_BYTES, stream, a);
#endif
    const hipError_t le = hipPeekAtLastError();
    if (le != hipSuccess) fprintf(stderr, "kernel_launch: launch failed: %s\n", hipGetErrorName(le));
}
```
